# Optimizing an MI355X kernel written in HIP

```python
import jax, jax.numpy as jnp
from jax import lax
import numpy as np

D_MODEL = 1024
BATCH = 8
SEQ = 4096
DEPTH = 2
DEC_BATCH = 32
DEC_SEQ = 2048
PAST_LEN = 128

N_META = 16
BLOCK = 128
WINDOW = 128
N_HEADS = 8
N_KV_HEADS = 2
GQA_GROUP = N_HEADS // N_KV_HEADS
HEAD_DIM = 64
Q_DIM = N_HEADS * HEAD_DIM
KV_DIM = N_KV_HEADS * HEAD_DIM
POOL_DIM = D_MODEL // 2
POOL_WINDOWS = (2, 4, 8, 16)
N_POOL_GROUPS = len(POOL_WINDOWS)
POOL_GROUP = POOL_DIM // N_POOL_GROUPS
IN_DIM = Q_DIM + 2 * KV_DIM + POOL_DIM
MIX_DIM = Q_DIM + POOL_DIM
N_FOURIER_GROUPS = 4
FOURIER_GROUP = D_MODEL // N_FOURIER_GROUPS
D_FF = 2816
N_EVEN = (DEPTH + 1) // 2
N_ODD = DEPTH // 2
EPS = 1e-6
NEG_INF = -1e30

kernel_name = "hybrid_bidir_swa_pool_fnet_encoder"


def rms_norm(x, g):
    xf = x.astype(jnp.float32)
    y = xf * lax.rsqrt(jnp.mean(xf * xf, axis=-1, keepdims=True) + EPS)
    return (y * g.astype(jnp.float32)).astype(x.dtype)


def swiglu(x, w_gate, w_up, w_down):
    return (jax.nn.silu(x @ w_gate) * (x @ w_up)) @ w_down


def alibi_slopes():
    h = jnp.arange(1, N_HEADS + 1, dtype=jnp.float32)
    return jnp.exp2(-8.0 * h / N_HEADS)


def window_attention(q, k, v, sink):
    B, L = q.shape[:2]
    pad_front = BLOCK - N_META
    Lp = L + pad_front
    nb = Lp // BLOCK
    qp = jnp.pad(q, ((0, 0), (pad_front, 0), (0, 0), (0, 0)))
    qp = qp.reshape(B, nb, BLOCK, N_KV_HEADS, GQA_GROUP, HEAD_DIM)

    def kv_windows(a):
        ap = jnp.pad(a, ((0, 0), (pad_front + BLOCK, BLOCK), (0, 0), (0, 0)))
        ap = ap.reshape(B, nb + 2, BLOCK, N_KV_HEADS, HEAD_DIM)
        return jnp.concatenate([ap[:, :-2], ap[:, 1:-1], ap[:, 2:]], axis=2)

    kw = kv_windows(k)
    vw = kv_windows(v)
    scale = HEAD_DIM ** -0.5
    s = jnp.einsum('bnqkgd,bnskd->bnkgqs', qp, kw).astype(jnp.float32) * scale

    qpos = jnp.arange(nb)[:, None] * BLOCK + jnp.arange(BLOCK)[None, :]
    kpos = (jnp.arange(nb)[:, None] - 1) * BLOCK + jnp.arange(3 * BLOCK)[None, :]
    dist = jnp.abs(qpos[:, :, None] - kpos[:, None, :])
    valid = (dist <= WINDOW) & (kpos[:, None, :] >= pad_front) & (kpos[:, None, :] < Lp)
    slopes = alibi_slopes().reshape(N_KV_HEADS, GQA_GROUP)
    bias = -slopes[None, :, :, None, None] * dist[:, None, None].astype(jnp.float32)
    s = jnp.where(valid[:, None, None], s + bias[None], NEG_INF)

    sk = sink.astype(jnp.float32).reshape(N_KV_HEADS, GQA_GROUP)[None, None, :, :, None]
    m = jnp.maximum(jnp.max(s, axis=-1), sk)
    p = jnp.exp(s - m[..., None])
    denom = jnp.sum(p, axis=-1) + jnp.exp(sk - m)
    o = jnp.einsum('bnkgqs,bnskd->bnkgqd', p.astype(v.dtype), vw).astype(jnp.float32)
    o = (o / denom[..., None]).astype(q.dtype)
    o = o.transpose(0, 1, 4, 2, 3, 5).reshape(B, Lp, Q_DIM)
    return o[:, pad_front:]


def multiscale_pool(u, w_pool, pool_scale):
    B, L, _ = u.shape
    uf = u.astype(jnp.float32).reshape(B, L, N_POOL_GROUPS, POOL_GROUP)
    c = jnp.concatenate([jnp.zeros((B, 1, N_POOL_GROUPS, POOL_GROUP), jnp.float32),
                         jnp.cumsum(uf, axis=1)], axis=1)
    t = jnp.arange(L)
    outs = []
    for g, w in enumerate(POOL_WINDOWS):
        lo = jnp.clip(t - w // 2, 0, L)
        hi = jnp.clip(t + w - w // 2, 0, L)
        cnt = (hi - lo).astype(jnp.float32)[None, :, None]
        outs.append((c[:, hi, g] - c[:, lo, g]) / cnt)
    pooled = (jnp.stack(outs, axis=2) - uf).astype(u.dtype)
    y = jnp.einsum('blgc,gcd->blgd', pooled, w_pool).reshape(B, L, POOL_DIM)
    return y * pool_scale


def even_mixer(h, w_in, sink, w_pool, pool_scale, w_out):
    B, L, _ = h.shape
    z = h @ w_in
    q, k, v, u = jnp.split(z, [Q_DIM, Q_DIM + KV_DIM, Q_DIM + 2 * KV_DIM], axis=-1)
    q = q.reshape(B, L, N_HEADS, HEAD_DIM)
    k = k.reshape(B, L, N_KV_HEADS, HEAD_DIM)
    v = v.reshape(B, L, N_KV_HEADS, HEAD_DIM)
    a = window_attention(q, k, v, sink)
    p = multiscale_pool(u, w_pool, pool_scale)
    return jnp.concatenate([a, p], axis=-1) @ w_out


def fourier_mixer(h, w_out):
    B, L, _ = h.shape
    hf = h.astype(jnp.float32).reshape(B, L, N_FOURIER_GROUPS, FOURIER_GROUP)
    f = jnp.fft.fft2(hf, axes=(1, 3), norm='ortho').real.astype(h.dtype).reshape(B, L, D_MODEL)
    return f @ w_out


def trunk(x, meta_tokens, norm_ffn1, ffn1_w_gate, ffn1_w_up, ffn1_w_down, norm_mix,
          w_in_ap, attn_sink, pool_w, pool_scale, w_out_ap, w_out_fourier,
          norm_ffn2, ffn2_w_gate, ffn2_w_up, ffn2_w_down, norm_final):
    B = x.shape[0]
    meta = jnp.broadcast_to(meta_tokens[None].astype(x.dtype), (B, N_META, D_MODEL))
    h = jnp.concatenate([meta, x], axis=1)
    for layer in range(DEPTH):
        h = h + 0.5 * swiglu(rms_norm(h, norm_ffn1[layer]), ffn1_w_gate[layer],
                             ffn1_w_up[layer], ffn1_w_down[layer])
        hn = rms_norm(h, norm_mix[layer])
        if layer % 2 == 0:
            i = layer // 2
            h = h + even_mixer(hn, w_in_ap[i], attn_sink[i], pool_w[i], pool_scale[i], w_out_ap[i])
        else:
            h = h + fourier_mixer(hn, w_out_fourier[layer // 2])
        h = h + 0.5 * swiglu(rms_norm(h, norm_ffn2[layer]), ffn2_w_gate[layer],
                             ffn2_w_up[layer], ffn2_w_down[layer])
    return rms_norm(h, norm_final)[:, N_META:]


def setup_inputs(seed: int = 0) -> dict:
    key = jax.random.key(seed)
    ks = jax.random.split(key, 20)
    f32 = jnp.float32

    def nrm(k, shape, scale):
        return jax.random.normal(k, shape, f32) * scale

    def gain(k, shape):
        return 1.0 + 0.02 * jax.random.normal(k, shape, f32)

    return {
        "x_prompt": nrm(ks[0], (BATCH, SEQ, D_MODEL), 1.0),
        "x_sample": nrm(ks[1], (DEC_BATCH, DEC_SEQ, D_MODEL), 1.0),
        "meta_tokens": nrm(ks[2], (N_META, D_MODEL), 1.0),
        "norm_ffn1": gain(ks[3], (DEPTH, D_MODEL)),
        "ffn1_w_gate": nrm(ks[4], (DEPTH, D_MODEL, D_FF), D_MODEL ** -0.5),
        "ffn1_w_up": nrm(ks[5], (DEPTH, D_MODEL, D_FF), D_MODEL ** -0.5),
        "ffn1_w_down": nrm(ks[6], (DEPTH, D_FF, D_MODEL), D_FF ** -0.5),
        "norm_mix": gain(ks[7], (DEPTH, D_MODEL)),
        "w_in_ap": nrm(ks[8], (N_EVEN, D_MODEL, IN_DIM), D_MODEL ** -0.5),
        "attn_sink": nrm(ks[9], (N_EVEN, N_HEADS), 0.5),
        "pool_w": nrm(ks[10], (N_EVEN, N_POOL_GROUPS, POOL_GROUP, POOL_GROUP), POOL_GROUP ** -0.5),
        "pool_scale": gain(ks[11], (N_EVEN, POOL_DIM)),
        "w_out_ap": nrm(ks[12], (N_EVEN, MIX_DIM, D_MODEL), MIX_DIM ** -0.5),
        "w_out_fourier": nrm(ks[13], (N_ODD, D_MODEL, D_MODEL), D_MODEL ** -0.5),
        "norm_ffn2": gain(ks[14], (DEPTH, D_MODEL)),
        "ffn2_w_gate": nrm(ks[15], (DEPTH, D_MODEL, D_FF), D_MODEL ** -0.5),
        "ffn2_w_up": nrm(ks[16], (DEPTH, D_MODEL, D_FF), D_MODEL ** -0.5),
        "ffn2_w_down": nrm(ks[17], (DEPTH, D_FF, D_MODEL), D_FF ** -0.5),
        "norm_final": gain(ks[18], (D_MODEL,)),
    }


def reference(x_prompt, x_sample, meta_tokens, norm_ffn1, ffn1_w_gate, ffn1_w_up, ffn1_w_down,
              norm_mix, w_in_ap, attn_sink, pool_w, pool_scale, w_out_ap, w_out_fourier,
              norm_ffn2, ffn2_w_gate, ffn2_w_up, ffn2_w_down, norm_final):
    y_prompt = trunk(x_prompt, meta_tokens, norm_ffn1, ffn1_w_gate, ffn1_w_up, ffn1_w_down,
                     norm_mix, w_in_ap, attn_sink, pool_w, pool_scale, w_out_ap, w_out_fourier,
                     norm_ffn2, ffn2_w_gate, ffn2_w_up, ffn2_w_down, norm_final)
    y_sample = trunk(x_sample, meta_tokens, norm_ffn1, ffn1_w_gate, ffn1_w_up, ffn1_w_down,
                     norm_mix, w_in_ap, attn_sink, pool_w, pool_scale, w_out_ap, w_out_fourier,
                     norm_ffn2, ffn2_w_gate, ffn2_w_up, ffn2_w_down, norm_final)
    return (y_prompt, y_sample)
```

```cpp
#include <hip/hip_runtime.h>
#include <hip/hip_cooperative_groups.h>
#include <cstdio>
namespace cg = cooperative_groups;
namespace pg8 {
#define PG8_LAS __attribute__((address_space(3)))
typedef unsigned short bf16_t;
typedef short bf16x8 __attribute__((ext_vector_type(8)));
typedef float f32x4 __attribute__((ext_vector_type(4)));
typedef unsigned u32x4 __attribute__((ext_vector_type(4)));
constexpr int BM = 256, BK = 64, HALF = 128, HTB = HALF * BK * 2  , STAGE_BYTES = 8 * HTB, NXCD = 8, WGM = 8;

__host__ __device__ __forceinline__ int lds_byte(int r, int c) { const int st = (r >> 4) * 2 + (c >> 5), rr = r & 15, cc = c & 31, ob = rr * 64 + cc * 2; return st * 1024 + (ob ^ (((ob >> 9) & 1) << 5)); }
__host__ __device__ __forceinline__ void stage_rc(int b, int& R, int& C) { const int st = b / 1024, sb = b % 1024, swz = sb ^ (((sb >> 9) & 1) << 5); R = (st >> 1) * 16 + swz / 64; C = (st & 1) * 32 + (swz % 64) / 2; }
__host__ __device__ __forceinline__ int perm32(int rho) { const int n = rho >> 4, i = rho & 15; return 8 * (i >> 2) + 4 * n + (i & 3); }

struct Unit { int pm, pn; };
struct Gemm { const bf16_t* A; const bf16_t* Bt; int M, N, K; };

struct StaticOrder {
    int nM, nN, nwg, G, c;
    __host__ __device__ void init(int M, int N, int G_, int c_) { nM = M / BM; nN = N / BM; nwg = nM * nN; G = G_; c = c_; }
    __host__ __device__ bool next(int i, Unit& u) const {
        const long L = (long)i * G + c; if (L >= nwg) return false;
        int wgid = (int)L; { const int q = nwg / NXCD, r = nwg % NXCD, xcd = wgid % NXCD, off = wgid / NXCD; wgid = (xcd < r ? xcd * (q + 1) : r * (q + 1) + (xcd - r) * q) + off; }
        const int nig = WGM * nN, gid = wgid / nig, fm = gid * WGM, gsz = (nM - fm) < WGM ? (nM - fm) : WGM;
        u.pm = fm + ((wgid % nig) % gsz); u.pn = (wgid % nig) / gsz; return true;
    }
    __device__ __forceinline__ void a_ready(const Unit&) const {}
    __device__ __forceinline__ void done(const Unit&) const {}
};
__device__ __forceinline__ unsigned cvt_pk_bf16(float lo, float hi) { unsigned r; asm volatile("v_cvt_pk_bf16_f32 %0, %1, %2" : "=v"(r) : "v"(lo), "v"(hi)); return r; }
template <class Epi, class Sched, bool STAMP = false>
__device__ __forceinline__ void gemm_phase(PG8_LAS unsigned char* lds, const Gemm g, const Sched& S, const Epi& E, unsigned long long* stamps) {
    int tid_o = threadIdx.x; asm volatile("" : "+v"(tid_o));
    const int tid = tid_o, wid = __builtin_amdgcn_readfirstlane(tid >> 6), lane = tid & 63, wr = wid >> 2, wc = wid & 3, fr = lane & 15, fq = lane >> 4;
    const int K = g.K, nt = K / BK;
    int ts_lo = 0, ts_hi = 0, nts = 0; const unsigned long long rt_entry = STAMP ? (unsigned long long)wall_clock64() : 0ull;
#define PG8_STAMP() do { if (STAMP && wid == 0 && nts < 64) { const unsigned long long _c = (unsigned long long)clock64(); \
        ts_lo = (lane == nts) ? (int)(unsigned)_c : ts_lo; ts_hi = (lane == nts) ? (int)(unsigned)(_c >> 32) : ts_hi; ++nts; } } while (0)
    PG8_STAMP();
    unsigned voffA[2], voffB[2];
#pragma unroll
    for (int i = 0; i < 2; ++i) { int R, C; stage_rc(tid * 16 + i * 8192, R, C); const int Rb = Epi::PERM ? ((R & ~31) + perm32(R & 31)) : R;
        voffA[i] = (unsigned)(R * K + C) * 2u; voffB[i] = (unsigned)(Rb * K + C) * 2u; }
    const size_t kstep = (size_t)(BK * 2);
    const size_t hstep = (size_t)HALF * K * 2;
    const size_t tstep = 2 * hstep;
    const unsigned ldsw = (unsigned)wid * 1024u;
    const int aoff = lds_byte(wr * 64 + fr, fq * 8), boff = lds_byte(wc * 32 + fr, fq * 8);
#define PG8_SA(b, h) (((b) * 2 + (h)) * HTB)
#define PG8_SB(b, h) ((4 + (b) * 2 + (h)) * HTB)
#define PG8_STAGE(bufoff, gbase, voff) do { _Pragma("unroll") for (int _i = 0; _i < 2; ++_i) \
        __builtin_amdgcn_global_load_lds((const unsigned*)((const char*)(gbase) + (voff)[_i]), (PG8_LAS unsigned*)(lds + (bufoff) + ldsw + _i * 8192), 16, 0, 0); } while (0)
#define PG8_LDA(dst, b, h) do { _Pragma("unroll") for (int m = 0; m < 4; ++m) _Pragma("unroll") for (int k = 0; k < 2; ++k) dst[m][k] = *(const PG8_LAS bf16x8*)(lds + PG8_SA(b, h) + aoff + m * 2048 + k * 1024); } while (0)
#define PG8_LDB(dst, b, h) do { _Pragma("unroll") for (int n = 0; n < 2; ++n) _Pragma("unroll") for (int k = 0; k < 2; ++k) dst[n][k] = *(const PG8_LAS bf16x8*)(lds + PG8_SB(b, h) + boff + n * 2048 + k * 1024); } while (0)
#define PG8_MMA(ai, bj, At, Bt) do { __builtin_amdgcn_s_setprio(1); _Pragma("unroll") for (int m = 0; m < 4; ++m) _Pragma("unroll") for (int n = 0; n < 2; ++n) _Pragma("unroll") for (int k = 0; k < 2; ++k) \
        acc[ai][bj][m][n] = __builtin_amdgcn_mfma_f32_16x16x32_bf16(Bt[n][k], At[m][k], acc[ai][bj][m][n], 0, 0, 0); __builtin_amdgcn_s_setprio(0); } while (0)
#define PG8_WAIT_V(n) asm volatile("s_waitcnt vmcnt(" #n ")" ::: "memory")
#define PG8_WAIT_L(n) asm volatile("s_waitcnt lgkmcnt(" #n ")" ::: "memory")
#define PG8_BAR __builtin_amdgcn_s_barrier()
#define PG8_SCHED __builtin_amdgcn_sched_barrier(0)
    Unit cur, nxt; int ui = 0;
    if (!S.next(0, cur)) return;
    f32x4 acc[2][2][4][2];
#pragma unroll
    for (int a = 0; a < 2; ++a)
#pragma unroll
        for (int b = 0; b < 2; ++b)
#pragma unroll
            for (int m = 0; m < 4; ++m)
#pragma unroll
                for (int n = 0; n < 2; ++n) acc[a][b][m][n] = (f32x4){0.f, 0.f, 0.f, 0.f};
    bf16x8 At[4][2], B0[2][2], B1[2][2];
    const char* cA = (const char*)g.A + (size_t)cur.pm * tstep; const char* cB = (const char*)g.Bt + (size_t)cur.pn * tstep;
    S.a_ready(cur);
    PG8_STAGE(PG8_SB(0, 0), cB, voffB); PG8_STAGE(PG8_SA(0, 0), cA, voffA); PG8_STAGE(PG8_SB(0, 1), cB + hstep, voffB); PG8_STAGE(PG8_SA(0, 1), cA + hstep, voffA);
    if (wr == 1) PG8_BAR;
    PG8_WAIT_V(4); PG8_BAR;
    PG8_STAGE(PG8_SB(1, 0), cB + kstep, voffB); PG8_STAGE(PG8_SA(1, 0), cA + kstep, voffA); PG8_STAGE(PG8_SB(1, 1), cB + hstep + kstep, voffB);
    PG8_WAIT_V(6); PG8_BAR;
    PG8_STAMP();
    for (;;) {
        const bool has_next = S.next(ui + 1, nxt);
        const char* nA = has_next ? (const char*)g.A + (size_t)nxt.pm * tstep : cA; const char* nB = has_next ? (const char*)g.Bt + (size_t)nxt.pn * tstep : cB;
        for (int t = 0; t < nt; t += 2) {
            const bool last = (t == nt - 2);
            const char* a1 = cA + (size_t)(t + 1) * kstep;
            const char* a2 = last ? nA : cA + (size_t)(t + 2) * kstep; const char* b2 = last ? nB : cB + (size_t)(t + 2) * kstep;
            const char* a3 = a2 + kstep; const char* b3 = b2 + kstep;
            if (last && has_next) S.a_ready(nxt);
            PG8_LDB(B0, 0, 0); PG8_SCHED; PG8_LDA(At, 0, 0); PG8_STAGE(PG8_SA(1, 1), a1 + hstep, voffA);
            PG8_WAIT_L(8); PG8_BAR; PG8_WAIT_L(0); PG8_MMA(0, 0, At, B0); PG8_BAR; PG8_SCHED;
            PG8_LDB(B1, 0, 1); PG8_STAGE(PG8_SB(0, 0), b2, voffB);
            PG8_BAR; PG8_WAIT_L(0); PG8_MMA(0, 1, At, B1); PG8_BAR;
            PG8_LDA(At, 0, 1); PG8_STAGE(PG8_SA(0, 0), a2, voffA);
            PG8_BAR; PG8_WAIT_L(0); PG8_MMA(1, 0, At, B0); PG8_BAR; PG8_SCHED;
            PG8_STAGE(PG8_SB(0, 1), b2 + hstep, voffB);
            PG8_WAIT_V(6); PG8_BAR; PG8_MMA(1, 1, At, B1); PG8_BAR;
            PG8_LDB(B0, 1, 0); PG8_SCHED; PG8_LDA(At, 1, 0); PG8_STAGE(PG8_SA(0, 1), a2 + hstep, voffA);
            PG8_WAIT_L(8); PG8_BAR; PG8_WAIT_L(0); PG8_MMA(0, 0, At, B0); PG8_BAR; PG8_SCHED;
            PG8_LDB(B1, 1, 1); PG8_STAGE(PG8_SB(1, 0), b3, voffB);
            PG8_BAR; PG8_WAIT_L(0); PG8_MMA(0, 1, At, B1); PG8_BAR;
            PG8_LDA(At, 1, 1); PG8_STAGE(PG8_SA(1, 0), a3, voffA);
            PG8_BAR; PG8_WAIT_L(0); PG8_MMA(1, 0, At, B0); PG8_BAR; PG8_SCHED;
            PG8_STAGE(PG8_SB(1, 1), b3 + hstep, voffB);
            PG8_WAIT_V(6); PG8_BAR; PG8_MMA(1, 1, At, B1); PG8_BAR;
        }
        PG8_STAMP();
        if constexpr (!Epi::AFTER_DRAIN) { E(acc, cur, wr, wc, fr, fq); S.done(cur); }
        PG8_STAMP();
        if (!has_next) break;
#pragma unroll
        for (int a = 0; a < 2; ++a)
#pragma unroll
            for (int b = 0; b < 2; ++b)
#pragma unroll
                for (int m = 0; m < 4; ++m)
#pragma unroll
                    for (int n = 0; n < 2; ++n) acc[a][b][m][n] = (f32x4){0.f, 0.f, 0.f, 0.f};
        cur = nxt; cA = nA; cB = nB; ++ui;
    }
    PG8_WAIT_V(0);
    if (wr == 0) PG8_BAR;
    PG8_BAR;
    if constexpr (Epi::AFTER_DRAIN) { E.fused(acc, cur, wr, wc, fr, fq, lds, wid, lane); S.done(cur); }
    PG8_STAMP();
    if (STAMP && wid == 0) { stamps[lane] = lane < nts ? (((unsigned long long)(unsigned)ts_hi << 32) | (unsigned)ts_lo) : 0ull;
        if (lane == 62) stamps[62] = rt_entry; if (lane == 63) stamps[63] = (unsigned long long)wall_clock64(); }
#undef PG8_STAMP
#undef PG8_SA
#undef PG8_SB
#undef PG8_STAGE
#undef PG8_LDA
#undef PG8_LDB
#undef PG8_MMA
#undef PG8_WAIT_V
#undef PG8_WAIT_L
#undef PG8_BAR
#undef PG8_SCHED
}
}

using pg8::bf16_t; using pg8::bf16x8; using pg8::f32x4; using pg8::u32x4; using pg8::Unit; using pg8::cvt_pk_bf16;
typedef unsigned u32x2 __attribute__((ext_vector_type(2)));
#define LAS __attribute__((address_space(3)))

constexpr int D = 1024, DFF = 2816, NGU = 5632, INDIM = 1280;
constexpr int LA = 4112, LB = 2064, NBA = 8, NBB = 32;
constexpr int TA = NBA * LA;
constexpr int T = TA + NBB * LB;
constexpr int TPAD = 99072;
constexpr int LPA = 4224, LPB = 2176;
constexpr int MPA = 4352, MPB = 2304;
constexpr int LDS_BYTES = 147456;

constexpr size_t al256(size_t x) { return (x + 255) & ~(size_t)255; }
constexpr size_t OFF_WGU = 0;
constexpr size_t OFF_WD = al256(OFF_WGU + (size_t)4 * NGU * D * 2);
constexpr size_t OFF_WIN = al256(OFF_WD + (size_t)4 * D * DFF * 2);
constexpr size_t OFF_WO = al256(OFF_WIN + (size_t)INDIM * D * 2);
constexpr size_t OFF_W2T = al256(OFF_WO + (size_t)D * D * 2);
constexpr size_t OFF_D1 = al256(OFF_W2T + (size_t)D * 2048 * 2);
constexpr size_t OFF_D2 = al256(OFF_D1 + (size_t)MPA * LPA * 2);
constexpr size_t OFF_HMETA = al256(OFF_D2 + (size_t)MPB * LPB * 2);
constexpr size_t OFF_RSS = al256(OFF_HMETA + (size_t)640 * D * 4);
constexpr size_t OFF_HB = al256(OFF_RSS + (size_t)TPAD * 16 * 4);
constexpr size_t OFF_BIG = al256(OFF_HB + (size_t)TPAD * D * 2);
constexpr size_t OFF_ACT = OFF_BIG;
constexpr size_t OFF_Z = OFF_BIG;
constexpr size_t OFF_AP = al256(OFF_Z + (size_t)TPAD * INDIM * 2);
constexpr size_t OFF_HNT = OFF_BIG;
constexpr size_t HNT_B = (size_t)NBA * D * LPA;
constexpr size_t OFF_X = al256(OFF_HNT + ((size_t)NBA * D * LPA + (size_t)NBB * D * LPB) * 2);
constexpr size_t WS_NEED = al256(OFF_X + (size_t)TPAD * 2048 * 2);
static_assert(OFF_AP + (size_t)TPAD * D * 2 <= WS_NEED && OFF_ACT + (size_t)TPAD * DFF * 2 <= WS_NEED, "big region");

struct Params { const float* in[19]; float* out; unsigned char* ws; };

__device__ __forceinline__ void row_decode(int r, int& gb, int& l, int& L, int& rb) {
    if (r < TA) { gb = r / LA; l = r - gb * LA; L = LA; rb = gb * LA; }
    else { const int q = r - TA, b = q / LB; l = q - b * LB; gb = NBA + b; L = LB; rb = TA + b * LB; }
}
__device__ __forceinline__ float* hptr2(float* out, unsigned char* ws, int r) {
    int gb, l, L, rb; row_decode(r, gb, l, L, rb);
    if (l < 16) return (float*)(ws + OFF_HMETA) + (size_t)(gb * 16 + l) * D;
    return out + (size_t)(r - 16 * (gb + 1)) * D;
}
__device__ __forceinline__ float* hptr(const Params& p, int r) {
    int gb, l, L, rb; row_decode(r, gb, l, L, rb);
    if (l < 16) return (float*)(p.ws + OFF_HMETA) + (size_t)(gb * 16 + l) * D;
    return p.out + (size_t)(r - 16 * (gb + 1)) * D;
}
__device__ __forceinline__ int otid() { int t = threadIdx.x; asm volatile("" : "+v"(t)); return t; }
__device__ __forceinline__ bf16_t f2bf(float f) { unsigned u = __float_as_uint(f); u += 0x7FFFu + ((u >> 16) & 1u); return (bf16_t)(u >> 16); }
__device__ __forceinline__ float bflo(unsigned w) { return __uint_as_float(w << 16); }
__device__ __forceinline__ float bfhi(unsigned w) { return __uint_as_float(w & 0xFFFF0000u); }
__device__ __forceinline__ float wave_sum(float v) {
#pragma unroll
    for (int o = 1; o < 64; o <<= 1) v += __shfl_xor(v, o);
    return v;
}
__device__ __forceinline__ float rstd_row(const float* rss, int r) {
    const f32x4* q = (const f32x4*)(rss + (size_t)r * 16);
    const f32x4 a = q[0], b = q[1], c = q[2], d = q[3];
    const float s = (((a.x + a.y) + (a.z + a.w)) + ((b.x + b.y) + (b.z + b.w))) + (((c.x + c.y) + (c.z + c.w)) + ((d.x + d.y) + (d.z + d.w)));
    return rsqrtf(s * (1.0f / 1024.0f) + 1e-6f);
}

struct EpiGateUp {
    static constexpr bool PERM = true, AFTER_DRAIN = false;
    bf16_t* act; const float* rss;
    __device__ __forceinline__ void operator()(const f32x4 (&acc)[2][2][4][2], const Unit& u, int wr, int wc, int fr, int fq) const {
        const int col = u.pn * 128 + wc * 32 + fq * 8;
#pragma unroll
        for (int ai = 0; ai < 2; ++ai)
#pragma unroll
            for (int m = 0; m < 4; ++m) {
                const int r = u.pm * 256 + ai * 128 + wr * 64 + m * 16 + fr;
                if (r < T) {
                    const float rs = rstd_row(rss, r);
                    unsigned w[4];
#pragma unroll
                    for (int n = 0; n < 2; ++n)
#pragma unroll
                        for (int e = 0; e < 4; e += 2) {
                            const float g0 = acc[ai][0][m][n][e] * rs, g1 = acc[ai][0][m][n][e + 1] * rs;
                            const float u0 = acc[ai][1][m][n][e] * rs, u1 = acc[ai][1][m][n][e + 1] * rs;
                            const float o0 = g0 * __builtin_amdgcn_rcpf(1.0f + __expf(-g0)) * u0;
                            const float o1 = g1 * __builtin_amdgcn_rcpf(1.0f + __expf(-g1)) * u1;
                            w[n * 2 + (e >> 1)] = cvt_pk_bf16(o0, o1);
                        }
                    u32x4 o; o.x = w[0]; o.y = w[1]; o.z = w[2]; o.w = w[3];
                    *(u32x4*)(act + (size_t)r * DFF + col) = o;
                }
            }
    }
};
struct EpiScale {
    static constexpr bool PERM = true, AFTER_DRAIN = false;
    bf16_t* O; int ldc; const float* rss;
    __device__ __forceinline__ void operator()(const f32x4 (&acc)[2][2][4][2], const Unit& u, int wr, int wc, int fr, int fq) const {
        const int col = u.pn * 256 + wc * 32 + fq * 8;
#pragma unroll
        for (int ai = 0; ai < 2; ++ai)
#pragma unroll
            for (int m = 0; m < 4; ++m) {
                const int r = u.pm * 256 + ai * 128 + wr * 64 + m * 16 + fr;
                if (r < T) {
                    const float rs = rstd_row(rss, r);
#pragma unroll
                    for (int bj = 0; bj < 2; ++bj) {
                        const f32x4 v0 = acc[ai][bj][m][0] * rs, v1 = acc[ai][bj][m][1] * rs;
                        u32x4 o; o.x = cvt_pk_bf16(v0[0], v0[1]); o.y = cvt_pk_bf16(v0[2], v0[3]); o.z = cvt_pk_bf16(v1[0], v1[1]); o.w = cvt_pk_bf16(v1[2], v1[3]);
                        *(u32x4*)(O + (size_t)r * ldc + col + bj * 128) = o;
                    }
                }
            }
    }
};
struct EpiResid {
    static constexpr bool PERM = true, AFTER_DRAIN = false;
    float* out; unsigned char* ws; float scale;
    __device__ __forceinline__ void operator()(const f32x4 (&acc)[2][2][4][2], const Unit& u, int wr, int wc, int fr, int fq) const {
        const int col = u.pn * 256 + wc * 32 + fq * 8;
        bf16_t* hb = (bf16_t*)(ws + OFF_HB); float* rss = (float*)(ws + OFF_RSS);
#pragma unroll
        for (int ai = 0; ai < 2; ++ai)
#pragma unroll
            for (int m = 0; m < 4; ++m) {
                const int r = u.pm * 256 + ai * 128 + wr * 64 + m * 16 + fr;
                float ss = 0.f;
                if (r < T) {
                    float* hp = hptr2(out, ws, r) + col;
#pragma unroll
                    for (int bj = 0; bj < 2; ++bj) {
                        f32x4 h0 = *(const f32x4*)(hp + bj * 128), h1 = *(const f32x4*)(hp + bj * 128 + 4);
                        h0 += acc[ai][bj][m][0] * scale; h1 += acc[ai][bj][m][1] * scale;
                        *(f32x4*)(hp + bj * 128) = h0; *(f32x4*)(hp + bj * 128 + 4) = h1;
                        ss += (h0[0] * h0[0] + h0[1] * h0[1]) + (h0[2] * h0[2] + h0[3] * h0[3]) + (h1[0] * h1[0] + h1[1] * h1[1]) + (h1[2] * h1[2] + h1[3] * h1[3]);
                        u32x4 o; o.x = cvt_pk_bf16(h0[0], h0[1]); o.y = cvt_pk_bf16(h0[2], h0[3]); o.z = cvt_pk_bf16(h1[0], h1[1]); o.w = cvt_pk_bf16(h1[2], h1[3]);
                        *(u32x4*)(hb + (size_t)r * D + col + bj * 128) = o;
                    }
                }
                ss += __shfl_xor(ss, 16); ss += __shfl_xor(ss, 32);
                if (r < T && fq == 0) rss[(size_t)r * 16 + u.pn * 4 + wc] = ss;
            }
    }
};
struct EpiDft {
    static constexpr bool PERM = true, AFTER_DRAIN = false;
    bf16_t* X; int L, rowbase;
    __device__ __forceinline__ void operator()(const f32x4 (&acc)[2][2][4][2], const Unit& u, int wr, int wc, int fr, int fq) const {
        const int b = u.pn >> 2, c0 = (u.pn & 3) * 256 + wc * 32 + fq * 8, H = L >> 1;
#pragma unroll
        for (int ai = 0; ai < 2; ++ai)
#pragma unroll
            for (int m = 0; m < 4; ++m) {
                const int kk = u.pm * 256 + ai * 128 + wr * 64 + m * 16 + fr;
                if (kk < L) {
                    const bool isc = kk <= H; const int k = isc ? kk : kk - H; const float sg = isc ? 1.f : -1.f;
                    bf16_t* x0 = X + (size_t)(rowbase + b * L + k) * 2048 + (isc ? 0 : 1024) + c0;
                    bf16_t* x1 = X + (size_t)(rowbase + b * L + (L - k)) * 2048 + (isc ? 0 : 1024) + c0;
                    const bool mir = (k >= 1) && (k < H);
#pragma unroll
                    for (int bj = 0; bj < 2; ++bj) {
                        const f32x4 v0 = acc[ai][bj][m][0] * sg, v1 = acc[ai][bj][m][1] * sg;
                        u32x4 o; o.x = cvt_pk_bf16(v0[0], v0[1]); o.y = cvt_pk_bf16(v0[2], v0[3]); o.z = cvt_pk_bf16(v1[0], v1[1]); o.w = cvt_pk_bf16(v1[2], v1[3]);
                        *(u32x4*)(x0 + bj * 128) = o;
                        if (mir) { u32x4 q; if (isc) q = o; else { q.x = o.x ^ 0x80008000u; q.y = o.y ^ 0x80008000u; q.z = o.z ^ 0x80008000u; q.w = o.w ^ 0x80008000u; } *(u32x4*)(x1 + bj * 128) = q; }
                        if (isc && !mir) { u32x4 zz; zz.x = 0; zz.y = 0; zz.z = 0; zz.w = 0; *(u32x4*)(x0 + 1024 + bj * 128) = zz; }
                    }
                }
            }
    }
};

template <class Epi>
__device__ __forceinline__ void run_gemm(LAS unsigned char* lds, const bf16_t* A, const bf16_t* Bt, int M, int N, int K, const Epi& E, int c) {
    pg8::Gemm g; g.A = A; g.Bt = Bt; g.M = M; g.N = N; g.K = K;
    pg8::StaticOrder S; S.init(M, N, (int)gridDim.x, c);
    pg8::gemm_phase<Epi, pg8::StaticOrder, false>(lds, g, S, E, nullptr);
}

__device__ __forceinline__ void transpose_item(const float* W, int N, const float* gain, bf16_t* WT, int ldd, int k0, int n0, int drow0, LAS float* scr, int lane) {
#pragma unroll 8
    for (int i = 0; i < 32; ++i) { const int kk = 2 * i + (lane >> 5); float v = W[(size_t)(k0 + kk) * N + n0 + (lane & 31)]; if (gain) v *= gain[k0 + kk]; scr[kk * 33 + (lane & 31)] = v; }
    __builtin_amdgcn_s_waitcnt(0xc07f); asm volatile("s_waitcnt lgkmcnt(0)" ::: "memory");
    const int c = lane & 7;
#pragma unroll
    for (int j = 0; j < 4; ++j) { const int n = (lane >> 3) + 8 * j; const LAS float* s = scr + (8 * c) * 33 + n;
        u32x4 o; o.x = cvt_pk_bf16(s[0 * 33], s[1 * 33]); o.y = cvt_pk_bf16(s[2 * 33], s[3 * 33]); o.z = cvt_pk_bf16(s[4 * 33], s[5 * 33]); o.w = cvt_pk_bf16(s[6 * 33], s[7 * 33]);
        *(u32x4*)(WT + (size_t)(drow0 + n) * ldd + k0 + 8 * c) = o; }
    asm volatile("s_waitcnt lgkmcnt(0)" ::: "memory");
}
__device__ __forceinline__ void dft_item(bf16_t* Dm, int L, int LP, int witem, int lane) {
    const int cpr = LP / 8; const int tix = witem * 64 + lane; const int kk = tix / cpr, c8 = tix - kk * cpr;
    const int H = L >> 1; const bool isc = kk <= H; const int k = isc ? kk : kk - H;
    const float sc = rsqrtf((float)L), invL = 2.0f / (float)L;
    unsigned w[4];
#pragma unroll
    for (int e = 0; e < 8; e += 2) {
        float v[2];
#pragma unroll
        for (int q = 0; q < 2; ++q) { const int n = c8 * 8 + e + q; float x = 0.f;
            if (kk < L && n < L) { const int mm = (k * n) % L; const float a = (float)mm * invL; x = (isc ? cospif(a) : sinpif(a)) * sc; }
            v[q] = x; }
        w[e >> 1] = cvt_pk_bf16(v[0], v[1]);
    }
    u32x4 o; o.x = w[0]; o.y = w[1]; o.z = w[2]; o.w = w[3];
    *(u32x4*)(Dm + (size_t)kk * LP + c8 * 8) = o;
}
__device__ __forceinline__ void prep_phase(const Params& p, LAS unsigned char* lds) {
    const int tid = otid(), lane = tid & 63, wave = tid >> 6;
    const int gw = blockIdx.x * 8 + wave, NGW = gridDim.x * 8;
    LAS float* scr = (LAS float*)(lds + wave * 8704);
    LAS float* tab = (LAS float*)(lds + 8 * 8704);
    if (tid < 256) { tab[tid] = cospif((float)tid * (1.0f / 128.0f)); tab[256 + tid] = sinpif((float)tid * (1.0f / 128.0f)); }
    __syncthreads();
    bf16_t* Wgu = (bf16_t*)(p.ws + OFF_WGU); bf16_t* Wd = (bf16_t*)(p.ws + OFF_WD); bf16_t* Win = (bf16_t*)(p.ws + OFF_WIN);
    bf16_t* Wo = (bf16_t*)(p.ws + OFF_WO); bf16_t* W2t = (bf16_t*)(p.ws + OFF_W2T);
    constexpr int I_G = 16 * 88, I_D = 44 * 32;
    constexpr int N_TR_FFN = 4 * (2 * I_G + I_D);
    constexpr int I_IN = 16 * 40, I_WO = 8 * 32;
    constexpr int R0 = N_TR_FFN, R1 = R0 + I_IN, R2 = R1 + I_WO;
    constexpr int N_W3 = 1024 * 8, N_W2 = 1024 * 32;
    constexpr int R3 = R2 + N_W3, R4 = R3 + N_W2;
    constexpr int N_D1 = MPA * (LPA / 8) / 64, N_D2 = MPB * (LPB / 8) / 64;
    constexpr int R5 = R4 + N_D1, R6 = R5 + N_D2, R7 = R6 + T;
    for (int it = gw; it < R7; it += NGW) {
        if (it < R0) {
            const int f = it / (2 * I_G + I_D); int r = it - f * (2 * I_G + I_D); const int layer = f >> 1, which = f & 1;
            if (r < 2 * I_G) { const int up = r >= I_G; if (up) r -= I_G;
                const float* src = p.in[which ? (up ? 16 : 15) : (up ? 5 : 4)] + (size_t)layer * D * DFF;
                const float* gain = p.in[which ? 14 : 3] + layer * D;
                const int kb = r / 88, nb = r - kb * 88, n0 = nb * 32;
                const int drow0 = (n0 >> 7) * 256 + (up ? 128 : 0) + (n0 & 127);
                transpose_item(src, DFF, gain, Wgu + (size_t)f * NGU * D, D, kb * 64, n0, drow0, scr, lane);
            } else { r -= 2 * I_G;
                const float* src = p.in[which ? 17 : 6] + (size_t)layer * DFF * D;
                const int kb = r / 32, nb = r - kb * 32;
                transpose_item(src, D, nullptr, Wd + (size_t)f * D * DFF, DFF, kb * 64, nb * 32, nb * 32, scr, lane);
            }
        } else if (it < R1) { const int r = it - R0, kb = r / 40, nb = r - kb * 40;
            transpose_item(p.in[8], INDIM, p.in[7], Win, D, kb * 64, nb * 32, nb * 32, scr, lane);
        } else if (it < R2) { const int r = it - R1, kb = r / 32, nb = r - kb * 32;
            transpose_item(p.in[12], D, nullptr, Wo, D, kb * 64, nb * 32, nb * 32, scr, lane);
        } else if (it < R3) {
            const int r = it - R2, j = r & 1023, kb = r >> 10, kk = kb * 64 + lane, g = kk >> 7, c = kk & 127;
            const float* pw = p.in[10] + (size_t)(g * 128 + c) * 128; const float* ps = p.in[11] + g * 128; const float* wo = p.in[12] + (size_t)(512 + g * 128) * D + j;
            float a = 0.f;
            for (int d = 0; d < 128; ++d) a += pw[d] * (ps[d] * wo[(size_t)d * D]);
            Wo[(size_t)j * D + 512 + kk] = f2bf(a);
        } else if (it < R4) {
            const int r = it - R3, j = r & 1023, kb = r >> 10, kk = kb * 64 + lane, part = kk >> 10, k2 = kk & 1023, g = k2 >> 8, c = k2 & 255;
            const float* wf = p.in[13] + (size_t)(g * 256) * D + j; const LAS float* tb = tab + part * 256;
            float a = 0.f;
            for (int d = 0; d < 256; ++d) a += tb[(c * d) & 255] * wf[(size_t)d * D];
            W2t[(size_t)j * 2048 + kk] = f2bf(a * 0.0625f);
        } else if (it < R5) { dft_item((bf16_t*)(p.ws + OFF_D1), LA, LPA, it - R4, lane);
        } else if (it < R6) { dft_item((bf16_t*)(p.ws + OFF_D2), LB, LPB, it - R5, lane);
        } else {
            const int r = it - R6; int gb, l, L, rb; row_decode(r, gb, l, L, rb);
            const float* src = (l < 16) ? p.in[2] + (size_t)l * D : (gb < NBA ? p.in[0] + ((size_t)gb * 4096 + (l - 16)) * D : p.in[1] + ((size_t)(gb - NBA) * 2048 + (l - 16)) * D);
            float* hp = hptr(p, r); bf16_t* hb = (bf16_t*)(p.ws + OFF_HB) + (size_t)r * D; float* rss = (float*)(p.ws + OFF_RSS) + (size_t)r * 16;
            f32x4 v[4]; float ss = 0.f;
#pragma unroll
            for (int i = 0; i < 4; ++i) { v[i] = *(const f32x4*)(src + (lane + 64 * i) * 4); ss += (v[i][0] * v[i][0] + v[i][1] * v[i][1]) + (v[i][2] * v[i][2] + v[i][3] * v[i][3]); }
            ss = wave_sum(ss);
#pragma unroll
            for (int i = 0; i < 4; ++i) { *(f32x4*)(hp + (lane + 64 * i) * 4) = v[i]; u32x2 o; o.x = cvt_pk_bf16(v[i][0], v[i][1]); o.y = cvt_pk_bf16(v[i][2], v[i][3]); *(u32x2*)(hb + (lane + 64 * i) * 4) = o; }
            if (lane < 16) rss[lane] = lane == 0 ? ss : 0.f;
        }
    }
}

__device__ __forceinline__ void attn_phase(const Params& p, LAS unsigned char* lds) {
    const bf16_t* z = (const bf16_t*)(p.ws + OFF_Z); bf16_t* ap = (bf16_t*)(p.ws + OFF_AP); const float* sink = p.in[9];
    const int tid = otid(), lane = tid & 63, wave = tid >> 6, fr = lane & 15, fq = lane >> 4;
    LAS unsigned char* Ks = lds;
    LAS unsigned char* Vt = lds + 55296;
    constexpr int NU = (NBA * 33 + NBB * 17) * 2;
    for (int unit = blockIdx.x; unit < NU; unit += gridDim.x) {
        const int kvh = unit & 1; int tt = unit >> 1; int sb, ti, L, rb;
        if (tt < NBA * 33) { sb = tt / 33; ti = tt - sb * 33; L = LA; rb = sb * LA; } else { tt -= NBA * 33; sb = tt / 17; ti = tt - sb * 17; L = LB; rb = TA + sb * LB; }
        const int l0 = ti * 128;
        __syncthreads();
        for (int idx = tid; idx < 384 * 8; idx += 512) { const int j = idx >> 3, ch = idx & 7, s = l0 - 128 + j; u32x4 v; v.x = 0; v.y = 0; v.z = 0; v.w = 0;
            if (s >= 0 && s < L) v = *(const u32x4*)(z + (size_t)(rb + s) * INDIM + 512 + kvh * 64 + ch * 8);
            *(LAS u32x4*)(Ks + j * 144 + ch * 16) = v; }
        for (int idx = tid; idx < 400 * 8; idx += 512) { const int ch = idx / 400, j = idx - ch * 400, s = l0 - 128 + j; u32x4 v; v.x = 0; v.y = 0; v.z = 0; v.w = 0;
            if (j < 384 && s >= 0 && s < L) v = *(const u32x4*)(z + (size_t)(rb + s) * INDIM + 640 + kvh * 64 + ch * 8);
            LAS bf16_t* dst = (LAS bf16_t*)Vt + (ch * 8) * 408 + j;
            dst[0 * 408] = (bf16_t)(v.x & 0xFFFFu); dst[1 * 408] = (bf16_t)(v.x >> 16); dst[2 * 408] = (bf16_t)(v.y & 0xFFFFu); dst[3 * 408] = (bf16_t)(v.y >> 16);
            dst[4 * 408] = (bf16_t)(v.z & 0xFFFFu); dst[5 * 408] = (bf16_t)(v.z >> 16); dst[6 * 408] = (bf16_t)(v.w & 0xFFFFu); dst[7 * 408] = (bf16_t)(v.w >> 16); }
        __syncthreads();
        const int lq0 = l0 + 16 * wave + fr;
        if (l0 + 16 * wave < L) {
#pragma unroll 1
            for (int g = 0; g < 4; ++g) {
                int lq = lq0; asm volatile("" : "+v"(lq)); const bool qok = lq < L;
                const int h = kvh * 4 + g; const float slope = exp2f(-(float)(h + 1)); const float sk = sink[h];
                bf16x8 qf[2];
#pragma unroll
                for (int kk = 0; kk < 2; ++kk) { u32x4 q; q.x = 0; q.y = 0; q.z = 0; q.w = 0; if (qok) q = *(const u32x4*)(z + (size_t)(rb + lq) * INDIM + h * 64 + kk * 32 + fq * 8); qf[kk] = __builtin_bit_cast(bf16x8, q); }
                f32x4 sc[17];
#pragma unroll
                for (int t = 0; t < 17; ++t) { f32x4 a = {0.f, 0.f, 0.f, 0.f};
#pragma unroll
                    for (int kk = 0; kk < 2; ++kk) { const bf16x8 kf = *(const LAS bf16x8*)(Ks + (16 * wave + 16 * t + fr) * 144 + (kk * 32 + fq * 8) * 2); a = __builtin_amdgcn_mfma_f32_16x16x32_bf16(kf, qf[kk], a, 0, 0, 0); }
                    sc[t] = a; __builtin_amdgcn_sched_barrier(0); }
                float mx = -1e30f;
#pragma unroll
                for (int t = 0; t < 17; ++t)
#pragma unroll
                    for (int e = 0; e < 4; ++e) { const int s = l0 - 128 + 16 * wave + 16 * t + 4 * fq + e; const int dist = abs(lq - s); const bool valid = (s >= 0) && (s < L) && (dist <= 128);
                        const float v = valid ? sc[t][e] * 0.125f - slope * (float)dist : -1e30f; sc[t][e] = v; mx = fmaxf(mx, v); }
                mx = fmaxf(mx, __shfl_xor(mx, 16)); mx = fmaxf(mx, __shfl_xor(mx, 32)); mx = fmaxf(mx, sk);
                float sum = 0.f;
#pragma unroll
                for (int t = 0; t < 17; ++t)
#pragma unroll
                    for (int e = 0; e < 4; ++e) { const float pv = __expf(sc[t][e] - mx); sc[t][e] = pv; sum += pv; }
                sum += __shfl_xor(sum, 16); sum += __shfl_xor(sum, 32); sum += __expf(sk - mx);
                const float inv = 1.0f / sum;
                f32x4 o[4];
#pragma unroll
                for (int dt = 0; dt < 4; ++dt) o[dt] = (f32x4){0.f, 0.f, 0.f, 0.f};
#pragma unroll
                for (int u = 0; u < 9; ++u) {
                    u32x4 pw; pw.x = cvt_pk_bf16(sc[2 * u][0], sc[2 * u][1]); pw.y = cvt_pk_bf16(sc[2 * u][2], sc[2 * u][3]);
                    if (2 * u + 1 < 17) { pw.z = cvt_pk_bf16(sc[(2 * u + 1) % 17][0], sc[(2 * u + 1) % 17][1]); pw.w = cvt_pk_bf16(sc[(2 * u + 1) % 17][2], sc[(2 * u + 1) % 17][3]); } else { pw.z = 0; pw.w = 0; }
                    const bf16x8 pf = __builtin_bit_cast(bf16x8, pw);
#pragma unroll
                    for (int dt = 0; dt < 4; ++dt) { const LAS unsigned char* vp = Vt + (16 * dt + fr) * 816 + (16 * wave + 32 * u + 4 * fq) * 2;
                        const u32x2 lo = *(const LAS u32x2*)vp, hi = *(const LAS u32x2*)(vp + 32); u32x4 vv; vv.x = lo.x; vv.y = lo.y; vv.z = hi.x; vv.w = hi.y;
                        o[dt] = __builtin_amdgcn_mfma_f32_16x16x32_bf16(__builtin_bit_cast(bf16x8, vv), pf, o[dt], 0, 0, 0); }
                    __builtin_amdgcn_sched_barrier(0);
                }
                if (qok) {
#pragma unroll
                    for (int dt = 0; dt < 4; ++dt) { u32x2 w; w.x = cvt_pk_bf16(o[dt][0] * inv, o[dt][1] * inv); w.y = cvt_pk_bf16(o[dt][2] * inv, o[dt][3] * inv);
                        *(u32x2*)(ap + (size_t)(rb + lq) * D + h * 64 + 16 * dt + 4 * fq) = w; }
                }
            }
        }
    }
    const long NIT = (long)T * 64;
    for (long it = (long)blockIdx.x * 512 + tid; it < NIT; it += (long)gridDim.x * 512) {
        const int r = (int)(it >> 6), ch = (int)(it & 63), hw = 1 << (ch >> 4); int gb, l, L, rb; row_decode(r, gb, l, L, rb);
        const int lo = max(l - hw, 0), hi = min(l + hw, L);
        float s0 = 0.f, s1 = 0.f, s2 = 0.f, s3 = 0.f, s4 = 0.f, s5 = 0.f, s6 = 0.f, s7 = 0.f;
        for (int s = lo; s < hi; ++s) { const u32x4 v = *(const u32x4*)(z + (size_t)(rb + s) * INDIM + 768 + ch * 8);
            s0 += bflo(v.x); s1 += bfhi(v.x); s2 += bflo(v.y); s3 += bfhi(v.y); s4 += bflo(v.z); s5 += bfhi(v.z); s6 += bflo(v.w); s7 += bfhi(v.w); }
        const u32x4 me = *(const u32x4*)(z + (size_t)r * INDIM + 768 + ch * 8); const float ic = 1.0f / (float)(hi - lo);
        u32x4 o; o.x = cvt_pk_bf16(s0 * ic - bflo(me.x), s1 * ic - bfhi(me.x)); o.y = cvt_pk_bf16(s2 * ic - bflo(me.y), s3 * ic - bfhi(me.y));
        o.z = cvt_pk_bf16(s4 * ic - bflo(me.z), s5 * ic - bfhi(me.z)); o.w = cvt_pk_bf16(s6 * ic - bflo(me.w), s7 * ic - bfhi(me.w));
        *(u32x4*)(ap + (size_t)r * D + 512 + ch * 8) = o;
    }
}

__device__ __forceinline__ void normT_phase(const Params& p, LAS unsigned char* lds) {
    const int tid = otid(), lane = tid & 63, wave = tid >> 6;
    const float* gain = p.in[7] + D; bf16_t* HNT = (bf16_t*)(p.ws + OFF_HNT);
    LAS bf16_t* Tt = (LAS bf16_t*)lds;
    constexpr int NUA = NBA * (LPA / 64), NU = NUA + NBB * (LPB / 64);
    for (int unit = blockIdx.x; unit < NU; unit += gridDim.x) {
        int sb, ti, L, LP, rb; bf16_t* dst;
        if (unit < NUA) { sb = unit / (LPA / 64); ti = unit - sb * (LPA / 64); L = LA; LP = LPA; rb = sb * LA; dst = HNT + (size_t)sb * D * LPA; }
        else { const int uu = unit - NUA; sb = uu / (LPB / 64); ti = uu - sb * (LPB / 64); L = LB; LP = LPB; rb = TA + sb * LB; dst = HNT + HNT_B + (size_t)sb * D * LPB; }
        const int l0 = ti * 64;
        __syncthreads();
        for (int rr = 0; rr < 8; ++rr) { const int ll = wave * 8 + rr, l = l0 + ll;
            if (l < L) { const float* hp = hptr(p, rb + l); float v[16]; float ss = 0.f;
#pragma unroll
                for (int i = 0; i < 16; ++i) { v[i] = hp[lane + 64 * i]; ss += v[i] * v[i]; }
                ss = wave_sum(ss); const float rs = rsqrtf(ss * (1.0f / 1024.0f) + 1e-6f);
#pragma unroll
                for (int i = 0; i < 16; ++i) Tt[(lane + 64 * i) * 66 + ll] = f2bf(v[i] * rs * gain[lane + 64 * i]);
            } else {
#pragma unroll
                for (int i = 0; i < 16; ++i) Tt[(lane + 64 * i) * 66 + ll] = 0;
            }
        }
        __syncthreads();
        for (int idx = tid; idx < 1024 * 32; idx += 512) { const int c = idx >> 5, pr = idx & 31;
            const unsigned v = *(const LAS unsigned*)(Tt + c * 66 + 2 * pr); *(unsigned*)(dst + (size_t)c * LP + l0 + 2 * pr) = v; }
    }
}

__device__ __forceinline__ void final_phase(const Params& p) {
    const int tid = otid(); const int lane = tid & 63, gw = blockIdx.x * 8 + (tid >> 6), NGW = gridDim.x * 8; const float* gf = p.in[18];
    f32x4 gv[4];
#pragma unroll
    for (int i = 0; i < 4; ++i) gv[i] = *(const f32x4*)(gf + (lane + 64 * i) * 4);
    for (int row = gw; row < 98304; row += NGW) { float* hp = p.out + (size_t)row * D; f32x4 v[4]; float ss = 0.f;
#pragma unroll
        for (int i = 0; i < 4; ++i) { v[i] = *(const f32x4*)(hp + (lane + 64 * i) * 4); ss += (v[i][0] * v[i][0] + v[i][1] * v[i][1]) + (v[i][2] * v[i][2] + v[i][3] * v[i][3]); }
        ss = wave_sum(ss); const float rs = rsqrtf(ss * (1.0f / 1024.0f) + 1e-6f);
#pragma unroll
        for (int i = 0; i < 4; ++i) *(f32x4*)(hp + (lane + 64 * i) * 4) = v[i] * rs * gv[i];
    }
}

enum { K_PREP = 0, K_GGU, K_DOWN, K_GZ, K_ATTN, K_APO, K_NORMT, K_DFT, K_FO, K_FINAL };
__global__ void __launch_bounds__(512, 2) mega_fwd(Params p) {
    extern __shared__ __attribute__((aligned(16))) unsigned char shm[];
    LAS unsigned char* lds = (LAS unsigned char*)shm;
    cg::grid_group grid = cg::this_grid();
#pragma unroll 1
    for (int ph = 0; ph < 16; ++ph) {
        int kind, f = 0;
        switch (ph) {
            case 0: kind = K_PREP; break;
            case 1: kind = K_GGU; f = 0; break;
            case 2: kind = K_DOWN; f = 0; break;
            case 3: kind = K_GZ; break;
            case 4: kind = K_ATTN; break;
            case 5: kind = K_APO; break;
            case 6: kind = K_GGU; f = 1; break;
            case 7: kind = K_DOWN; f = 1; break;
            case 8: kind = K_GGU; f = 2; break;
            case 9: kind = K_DOWN; f = 2; break;
            case 10: kind = K_NORMT; break;
            case 11: kind = K_DFT; break;
            case 12: kind = K_FO; break;
            case 13: kind = K_GGU; f = 3; break;
            case 14: kind = K_DOWN; f = 3; break;
            default: kind = K_FINAL; break;
        }
        const int c = (int)blockIdx.x;
        if (kind == K_PREP) {
#ifndef NO_PREP
            prep_phase(p, lds);
#endif
        } else if (kind == K_GGU) {
#ifndef NO_GGU
            EpiGateUp E; E.act = (bf16_t*)(p.ws + OFF_ACT); E.rss = (const float*)(p.ws + OFF_RSS);
            run_gemm(lds, (const bf16_t*)(p.ws + OFF_HB), (const bf16_t*)(p.ws + OFF_WGU) + (size_t)f * NGU * D, TPAD, NGU, D, E, c);
#endif
        } else if (kind == K_DOWN || kind == K_APO || kind == K_FO) {
#ifndef NO_GRES
            const bf16_t* A; const bf16_t* Bt; int K; float scale;
            if (kind == K_DOWN) { A = (const bf16_t*)(p.ws + OFF_ACT); Bt = (const bf16_t*)(p.ws + OFF_WD) + (size_t)f * D * DFF; K = DFF; scale = 0.5f; }
            else if (kind == K_APO) { A = (const bf16_t*)(p.ws + OFF_AP); Bt = (const bf16_t*)(p.ws + OFF_WO); K = D; scale = 1.0f; }
            else { A = (const bf16_t*)(p.ws + OFF_X); Bt = (const bf16_t*)(p.ws + OFF_W2T); K = 2048; scale = 1.0f; }
            EpiResid E; E.out = p.out; E.ws = p.ws; E.scale = scale;
            run_gemm(lds, A, Bt, TPAD, D, K, E, c);
#endif
        } else if (kind == K_GZ) {
#ifndef NO_GZ
            EpiScale E; E.O = (bf16_t*)(p.ws + OFF_Z); E.ldc = INDIM; E.rss = (const float*)(p.ws + OFF_RSS);
            run_gemm(lds, (const bf16_t*)(p.ws + OFF_HB), (const bf16_t*)(p.ws + OFF_WIN), TPAD, INDIM, D, E, c);
#endif
        } else if (kind == K_ATTN) {
#ifndef NO_ATTN
            attn_phase(p, lds);
#endif
        } else if (kind == K_NORMT) {
#ifndef NO_NORMT
            normT_phase(p, lds);
#endif
        } else if (kind == K_DFT) {
#ifndef NO_GDFT
#pragma unroll 1
            for (int grp = 0; grp < 2; ++grp) {
                EpiDft E; E.X = (bf16_t*)(p.ws + OFF_X); E.L = grp ? LB : LA; E.rowbase = grp ? TA : 0;
                run_gemm(lds, (const bf16_t*)(p.ws + (grp ? OFF_D2 : OFF_D1)), (const bf16_t*)(p.ws + OFF_HNT) + (grp ? HNT_B : 0), grp ? MPB : MPA, (grp ? NBB : NBA) * D, grp ? LPB : LPA, E,
                         grp ? (int)gridDim.x - 1 - c : c);
            }
#endif
        } else {
#ifndef NO_FINAL
            final_phase(p);
#endif
        }
        if (ph != 15) grid.sync();
    }
}

extern "C" void kernel_launch(void* const* d_in, const int* in_sizes, int n_in, void* d_out, int out_size, void* d_ws, size_t ws_size, hipStream_t stream) {
    static int grid = 0;
    if (grid == 0) {
        if (n_in != 19 || ws_size < WS_NEED) { fprintf(stderr, "kernel_launch: need 19 inputs and %zu bytes of workspace (got %d, %zu)\n", (size_t)WS_NEED, n_in, ws_size); grid = -1; return; }
        int dev = 0, cus = 0, per_cu = 0;
        hipGetDevice(&dev); hipDeviceGetAttribute(&cus, hipDeviceAttributeMultiprocessorCount, dev);
        if (hipFuncSetAttribute((const void*)mega_fwd, hipFuncAttributeMaxDynamicSharedMemorySize, LDS_BYTES) != hipSuccess) { fprintf(stderr, "kernel_launch: hipFuncSetAttribute failed\n"); grid = -1; return; }
        if (hipOccupancyMaxActiveBlocksPerMultiprocessor(&per_cu, (const void*)mega_fwd, 512, LDS_BYTES) != hipSuccess || per_cu < 1) { fprintf(stderr, "kernel_launch: occupancy query gave %d\n", per_cu); per_cu = 1; (void)hipGetLastError(); }
        grid = cus * 1;
    }
    if (grid < 0) return;
    Params p{};
    for (int i = 0; i < 19; ++i) p.in[i] = (const float*)d_in[i];
    p.out = (float*)d_out; p.ws = (unsigned char*)d_ws;
    void* args[] = {&p};
    hipError_t e = hipLaunchCooperativeKernel((const void*)mega_fwd, dim3(grid), dim3(512), args, LDS_BYTES, stream);
    if (e != hipSuccess) fprintf(stderr, "cooperative launch failed: %s (grid %d)\n", hipGetErrorString(e), grid);
}
```

```cpp
#include <hip/hip_runtime.h>
#include <hip/hip_cooperative_groups.h>
#include <cstdio>
namespace cg = cooperative_groups;
#define LAS __attribute__((address_space(3)))
namespace pg8 {
#define PG8_LAS __attribute__((address_space(3)))
typedef unsigned short bf16_t;
typedef short bf16x8 __attribute__((ext_vector_type(8)));
typedef float f32x4 __attribute__((ext_vector_type(4)));
typedef unsigned u32x4 __attribute__((ext_vector_type(4)));
constexpr int BM = 256, BK = 64, HALF = 128, HTB = HALF * BK * 2  , STAGE_BYTES = 8 * HTB, NXCD = 8, WGM = 8;

__host__ __device__ __forceinline__ int lds_byte(int r, int c) { const int st = (r >> 4) * 2 + (c >> 5), rr = r & 15, cc = c & 31, ob = rr * 64 + cc * 2; return st * 1024 + (ob ^ (((ob >> 9) & 1) << 5)); }
__host__ __device__ __forceinline__ void stage_rc(int b, int& R, int& C) { const int st = b / 1024, sb = b % 1024, swz = sb ^ (((sb >> 9) & 1) << 5); R = (st >> 1) * 16 + swz / 64; C = (st & 1) * 32 + (swz % 64) / 2; }
__host__ __device__ __forceinline__ int perm32(int rho) { const int n = rho >> 4, i = rho & 15; return 8 * (i >> 2) + 4 * n + (i & 3); }

struct Unit { int pm, pn; };
struct Gemm { const bf16_t* A; const bf16_t* Bt; int M, N, K, ld; };

struct StaticOrder {
    int nM, nN, nwg, G, c;
    __host__ __device__ void init(int M, int N, int G_, int c_) { nM = M / BM; nN = N / BM; nwg = nM * nN; G = G_; c = c_; }
    __host__ __device__ bool next(int i, Unit& u) const {
        const int L = i * G + c; if (L >= nwg) return false;
        int wgid = (int)L; { const int q = nwg / NXCD, r = nwg % NXCD, xcd = wgid % NXCD, off = wgid / NXCD; wgid = (xcd < r ? xcd * (q + 1) : r * (q + 1) + (xcd - r) * q) + off; }
        const int nig = WGM * nN, gid = wgid / nig, fm = gid * WGM, gsz = (nM - fm) < WGM ? (nM - fm) : WGM;
        u.pm = fm + ((wgid % nig) % gsz); u.pn = (wgid % nig) / gsz; return true;
    }
    __device__ __forceinline__ void a_ready(const Unit&) const {}
    __device__ __forceinline__ void done(const Unit&) const {}
};
__device__ __forceinline__ unsigned cvt_pk_bf16(float lo, float hi) { unsigned r; asm volatile("v_cvt_pk_bf16_f32 %0, %1, %2" : "=v"(r) : "v"(lo), "v"(hi)); return r; }
template <class Epi, class Sched, bool STAMP = false>
__device__ __forceinline__ void gemm_phase(PG8_LAS unsigned char* lds, const Gemm g, const Sched& S, const Epi& E, unsigned long long* stamps) {
    int tid_o = threadIdx.x; asm volatile("" : "+v"(tid_o));
    const int tid = tid_o, wid = __builtin_amdgcn_readfirstlane(tid >> 6), lane = tid & 63, wr = wid >> 2, wc = wid & 3, fr = lane & 15, fq = lane >> 4;
    const int K = g.ld, nt = g.K / BK;
    int ts_lo = 0, ts_hi = 0, nts = 0; const unsigned long long rt_entry = STAMP ? (unsigned long long)wall_clock64() : 0ull;
#define PG8_STAMP() do { if (STAMP && wid == 0 && nts < 64) { const unsigned long long _c = (unsigned long long)clock64(); \
        ts_lo = (lane == nts) ? (int)(unsigned)_c : ts_lo; ts_hi = (lane == nts) ? (int)(unsigned)(_c >> 32) : ts_hi; ++nts; } } while (0)
    PG8_STAMP();
    unsigned voffA[2], voffB[2];
#pragma unroll
    for (int i = 0; i < 2; ++i) { int R, C; stage_rc(tid * 16 + i * 8192, R, C); const int Rb = Epi::PERM ? ((R & ~31) + perm32(R & 31)) : R;
        voffA[i] = (unsigned)(R * K + C) * 2u; voffB[i] = (unsigned)(Rb * K + C) * 2u; }
    const size_t kstep = (size_t)(BK * 2);
    const size_t hstep = (size_t)HALF * K * 2;
    const size_t tstep = 2 * hstep;
    const unsigned ldsw = (unsigned)wid * 1024u;
    const int aoff = lds_byte(wr * 64 + fr, fq * 8), boff = lds_byte(wc * 32 + fr, fq * 8);
#define PG8_SA(b, h) (((b) * 2 + (h)) * HTB)
#define PG8_SB(b, h) ((4 + (b) * 2 + (h)) * HTB)
#define PG8_STAGE(bufoff, gbase, voff) do { _Pragma("unroll") for (int _i = 0; _i < 2; ++_i) \
        __builtin_amdgcn_global_load_lds((const unsigned*)((const char*)(gbase) + (voff)[_i]), (PG8_LAS unsigned*)(lds + (bufoff) + ldsw + _i * 8192), 16, 0, 0); } while (0)
#define PG8_LDA(dst, b, h) do { _Pragma("unroll") for (int m = 0; m < 4; ++m) _Pragma("unroll") for (int k = 0; k < 2; ++k) dst[m][k] = *(const PG8_LAS bf16x8*)(lds + PG8_SA(b, h) + aoff + m * 2048 + k * 1024); } while (0)
#define PG8_LDB(dst, b, h) do { _Pragma("unroll") for (int n = 0; n < 2; ++n) _Pragma("unroll") for (int k = 0; k < 2; ++k) dst[n][k] = *(const PG8_LAS bf16x8*)(lds + PG8_SB(b, h) + boff + n * 2048 + k * 1024); } while (0)
#define PG8_MMA(ai, bj, At, Bt) do { __builtin_amdgcn_s_setprio(1); _Pragma("unroll") for (int m = 0; m < 4; ++m) _Pragma("unroll") for (int n = 0; n < 2; ++n) _Pragma("unroll") for (int k = 0; k < 2; ++k) \
        acc[ai][bj][m][n] = __builtin_amdgcn_mfma_f32_16x16x32_bf16(Bt[n][k], At[m][k], acc[ai][bj][m][n], 0, 0, 0); __builtin_amdgcn_s_setprio(0); } while (0)
#define PG8_WAIT_V(n) asm volatile("s_waitcnt vmcnt(" #n ")" ::: "memory")
#define PG8_WAIT_L(n) asm volatile("s_waitcnt lgkmcnt(" #n ")" ::: "memory")
#define PG8_BAR __builtin_amdgcn_s_barrier()
#define PG8_SCHED __builtin_amdgcn_sched_barrier(0)
    Unit cur, nxt; int ui = 0;
    if (!S.next(0, cur)) return;
    f32x4 acc[2][2][4][2];
#pragma unroll
    for (int a = 0; a < 2; ++a)
#pragma unroll
        for (int b = 0; b < 2; ++b)
#pragma unroll
            for (int m = 0; m < 4; ++m)
#pragma unroll
                for (int n = 0; n < 2; ++n) acc[a][b][m][n] = (f32x4){0.f, 0.f, 0.f, 0.f};
    bf16x8 At[4][2], B0[2][2], B1[2][2];
    const char* cA = (const char*)g.A + (size_t)cur.pm * tstep; const char* cB = (const char*)g.Bt + (size_t)cur.pn * tstep;
    S.a_ready(cur);
    PG8_STAGE(PG8_SB(0, 0), cB, voffB); PG8_STAGE(PG8_SA(0, 0), cA, voffA); PG8_STAGE(PG8_SB(0, 1), cB + hstep, voffB); PG8_STAGE(PG8_SA(0, 1), cA + hstep, voffA);
    if (wr == 1) PG8_BAR;
    PG8_WAIT_V(4); PG8_BAR;
    PG8_STAGE(PG8_SB(1, 0), cB + kstep, voffB); PG8_STAGE(PG8_SA(1, 0), cA + kstep, voffA); PG8_STAGE(PG8_SB(1, 1), cB + hstep + kstep, voffB);
    PG8_WAIT_V(6); PG8_BAR;
    PG8_STAMP();
    for (;;) {
        const bool has_next = S.next(ui + 1, nxt);
        const char* nA = has_next ? (const char*)g.A + (size_t)nxt.pm * tstep : cA; const char* nB = has_next ? (const char*)g.Bt + (size_t)nxt.pn * tstep : cB;
        for (int t = 0; t < nt; t += 2) {
            const bool last = (t == nt - 2);
            const char* a1 = cA + (size_t)(t + 1) * kstep;
            const char* a2 = last ? nA : cA + (size_t)(t + 2) * kstep; const char* b2 = last ? nB : cB + (size_t)(t + 2) * kstep;
            const char* a3 = a2 + kstep; const char* b3 = b2 + kstep;
            if (last && has_next) S.a_ready(nxt);
            PG8_LDB(B0, 0, 0); PG8_SCHED; PG8_LDA(At, 0, 0); PG8_STAGE(PG8_SA(1, 1), a1 + hstep, voffA);
            PG8_WAIT_L(8); PG8_BAR; PG8_WAIT_L(0); PG8_MMA(0, 0, At, B0); PG8_BAR; PG8_SCHED;
            PG8_LDB(B1, 0, 1); PG8_STAGE(PG8_SB(0, 0), b2, voffB);
            PG8_BAR; PG8_WAIT_L(0); PG8_MMA(0, 1, At, B1); PG8_BAR;
            PG8_LDA(At, 0, 1); PG8_STAGE(PG8_SA(0, 0), a2, voffA);
            PG8_BAR; PG8_WAIT_L(0); PG8_MMA(1, 0, At, B0); PG8_BAR; PG8_SCHED;
            PG8_STAGE(PG8_SB(0, 1), b2 + hstep, voffB);
            PG8_WAIT_V(6); PG8_BAR; PG8_MMA(1, 1, At, B1); PG8_BAR;
            PG8_LDB(B0, 1, 0); PG8_SCHED; PG8_LDA(At, 1, 0); PG8_STAGE(PG8_SA(0, 1), a2 + hstep, voffA);
            PG8_WAIT_L(8); PG8_BAR; PG8_WAIT_L(0); PG8_MMA(0, 0, At, B0); PG8_BAR; PG8_SCHED;
            PG8_LDB(B1, 1, 1); PG8_STAGE(PG8_SB(1, 0), b3, voffB);
            PG8_BAR; PG8_WAIT_L(0); PG8_MMA(0, 1, At, B1); PG8_BAR;
            PG8_LDA(At, 1, 1); PG8_STAGE(PG8_SA(1, 0), a3, voffA);
            PG8_BAR; PG8_WAIT_L(0); PG8_MMA(1, 0, At, B0); PG8_BAR; PG8_SCHED;
            PG8_STAGE(PG8_SB(1, 1), b3 + hstep, voffB);
            PG8_WAIT_V(6); PG8_BAR; PG8_MMA(1, 1, At, B1); PG8_BAR;
        }
        PG8_STAMP();
        if constexpr (!Epi::AFTER_DRAIN) { E(acc, cur, wr, wc, fr, fq); S.done(cur); }
        PG8_STAMP();
        if (!has_next) break;
#pragma unroll
        for (int a = 0; a < 2; ++a)
#pragma unroll
            for (int b = 0; b < 2; ++b)
#pragma unroll
                for (int m = 0; m < 4; ++m)
#pragma unroll
                    for (int n = 0; n < 2; ++n) acc[a][b][m][n] = (f32x4){0.f, 0.f, 0.f, 0.f};
        cur = nxt; cA = nA; cB = nB; ++ui;
    }
    PG8_WAIT_V(0);
    if (wr == 0) PG8_BAR;
    PG8_BAR;
    if constexpr (Epi::AFTER_DRAIN) { E.fused(acc, cur, wr, wc, fr, fq, lds, wid, lane); S.done(cur); }
    PG8_STAMP();
    if (STAMP && wid == 0) { stamps[lane] = lane < nts ? (((unsigned long long)(unsigned)ts_hi << 32) | (unsigned)ts_lo) : 0ull;
        if (lane == 62) stamps[62] = rt_entry; if (lane == 63) stamps[63] = (unsigned long long)wall_clock64(); }
#undef PG8_STAMP
#undef PG8_SA
#undef PG8_SB
#undef PG8_STAGE
#undef PG8_LDA
#undef PG8_LDB
#undef PG8_MMA
#undef PG8_WAIT_V
#undef PG8_WAIT_L
#undef PG8_BAR
#undef PG8_SCHED
}
}
#define XB_TMO      128
#define XB_XCNT(j)  (256  + 64 * (j))
#define XB_XSUB(j)  (1280 + 64 * (j))
#define XB_XGEN(j)  (2304 + 64 * (j))
#define XB_TOP      3328
#define XB_TOPGEN   3392
#define XCD_BAR_WORDS 3456
#define XB_SPIN_CAP (1u << 18)

__device__ __forceinline__ unsigned xb_ld(unsigned* p)              { return __hip_atomic_load(p, __ATOMIC_RELAXED, __HIP_MEMORY_SCOPE_AGENT); }
__device__ __forceinline__ unsigned xb_add(unsigned* p, unsigned v) { return __hip_atomic_fetch_add(p, v, __ATOMIC_RELAXED, __HIP_MEMORY_SCOPE_AGENT); }
__device__ __forceinline__ unsigned xb_xcc_id() { return (unsigned)__builtin_amdgcn_s_getreg((3 << 11) | 20) & 0xFu; }
#define XB_SPIN(cond, bar) do { unsigned _sp = 0; while (cond) { __builtin_amdgcn_s_sleep(1); \
    if ((++_sp & 255u) == 0u) { if (xb_ld(&(bar)[XB_TMO])) break; if (_sp > XB_SPIN_CAP) { atomicAdd(&(bar)[XB_TMO], 1u); break; } } } } while (0)

struct XcdBarrier {
    unsigned* bar; unsigned x;
    volatile LAS unsigned* st;
};

__device__ __forceinline__ XcdBarrier xcd_barrier_post(unsigned* bar, volatile LAS unsigned* st) {
    XcdBarrier b; b.bar = bar; b.x = xb_xcc_id(); b.st = st;
    if (threadIdx.x == 0) (void)xb_add(&bar[XB_XCNT(b.x)], 1u);
    return b;
}
__device__ __forceinline__ void xcd_barrier_complete(unsigned* bar, unsigned x, unsigned& nloc, unsigned& nx) {
    const unsigned G = gridDim.x * gridDim.y * gridDim.z;
    unsigned sum, cnt, mine, sp = 0u;
    for (;;) {
        sum = 0u; cnt = 0u; mine = 0u;
#pragma unroll
        for (unsigned j = 0; j < 16; ++j) { const unsigned c = xb_ld(&bar[XB_XCNT(j)]); sum += c; cnt += (c > 0u) ? 1u : 0u; mine = (j == x) ? c : mine; }
        if (sum == G) break;
        __builtin_amdgcn_s_sleep(1);
        if ((++sp & 255u) == 0u) { if (xb_ld(&bar[XB_TMO])) break; if (sp > XB_SPIN_CAP) { atomicAdd(&bar[XB_TMO], 1u); break; } }
    }
    nloc = mine > 0u ? mine : 1u; nx = cnt > 0u ? cnt : 1u;
}

__device__ __forceinline__ void xcd_barrier(const XcdBarrier& b) {
    asm volatile("s_waitcnt vmcnt(0)" ::: "memory");
    __syncthreads();
    if (threadIdx.x == 0) {
        unsigned* bar = b.bar;
        __builtin_amdgcn_s_waitcnt(0);
        unsigned nloc = b.st[0], nx = b.st[1];
        if (nloc == 0u) { xcd_barrier_complete(bar, b.x, nloc, nx); b.st[0] = nloc; b.st[1] = nx; }
        const unsigned old = xb_add(&bar[XB_XSUB(b.x)], 1u);
        const unsigned gen = old / nloc;
        if (old + 1u == (gen + 1u) * nloc) {
            __builtin_amdgcn_fence(__ATOMIC_RELEASE, "agent");
            asm volatile("s_waitcnt vmcnt(0)" ::: "memory");
            const unsigned og = xb_add(&bar[XB_TOP], 1u);
            const unsigned tg = og / nx;
            if (og + 1u == (tg + 1u) * nx) xb_add(&bar[XB_TOPGEN], 1u);
            else XB_SPIN(xb_ld(&bar[XB_TOPGEN]) == tg, bar);
            __builtin_amdgcn_fence(__ATOMIC_ACQUIRE, "agent");
            xb_add(&bar[XB_XGEN(b.x)], 1u);
            asm volatile("s_waitcnt vmcnt(0)" ::: "memory");
        } else {
            XB_SPIN(xb_ld(&bar[XB_XGEN(b.x)]) == gen, bar);
            __builtin_amdgcn_fence(__ATOMIC_ACQUIRE, "agent");
            asm volatile("s_waitcnt vmcnt(0)" ::: "memory");
        }
    }
    __syncthreads();
}

using pg8::bf16_t; using pg8::bf16x8; using pg8::f32x4; using pg8::u32x4; using pg8::Unit; using pg8::cvt_pk_bf16;
typedef unsigned u32x2 __attribute__((ext_vector_type(2)));
typedef float f32x2 __attribute__((ext_vector_type(2)));

#define GAS __attribute__((address_space(1)))
template <class T> __device__ __forceinline__ T gload(const T* p) { return *(const GAS T*)p; }
template <class T> __device__ __forceinline__ void gstore(T* p, const T& v) { *(GAS T*)p = v; }
constexpr int D = 1024, DFF = 2816, NGU = 5632, INDIM = 1280;
constexpr int LA = 4112, LB = 2064, NBA = 8, NBB = 32;
constexpr int TA = NBA * LA;
constexpr int T = TA + NBB * LB;
constexpr int TPAD = 99072;
constexpr int LPA = 4224, LPB = 2176;
constexpr int MPA = 4352, MPB = 2304;
constexpr int LDS_BYTES = 147456;

constexpr size_t al256(size_t x) { return (x + 255) & ~(size_t)255; }
constexpr size_t OFF_WGU = 0;
constexpr size_t OFF_WD = al256(OFF_WGU + (size_t)4 * NGU * D * 2);
constexpr size_t OFF_WIN = al256(OFF_WD + (size_t)4 * D * DFF * 2);
constexpr size_t OFF_WO = al256(OFF_WIN + (size_t)INDIM * D * 2);
constexpr size_t OFF_W2T = al256(OFF_WO + (size_t)D * D * 2);
constexpr size_t OFF_D1 = al256(OFF_W2T + (size_t)D * 2048 * 2);
constexpr size_t OFF_D2 = al256(OFF_D1 + (size_t)MPA * LPA * 2);
constexpr size_t OFF_HMETA = al256(OFF_D2 + (size_t)MPB * LPB * 2);
constexpr size_t OFF_RSS = al256(OFF_HMETA + (size_t)640 * D * 4);
constexpr size_t OFF_HB = al256(OFF_RSS + (size_t)TPAD * 16 * 4);
constexpr size_t OFF_BIG = al256(OFF_HB + (size_t)TPAD * D * 2);
constexpr size_t OFF_ACT = OFF_BIG;
constexpr size_t OFF_Z = OFF_BIG;
constexpr size_t OFF_AP = al256(OFF_Z + (size_t)TPAD * INDIM * 2);
constexpr size_t OFF_HNT = OFF_BIG;
constexpr size_t HNT_B = (size_t)NBA * D * LPA;
constexpr size_t OFF_X = al256(OFF_HNT + ((size_t)NBA * D * LPA + (size_t)NBB * D * LPB) * 2);
constexpr size_t OFF_SMALL = al256(OFF_X + (size_t)TPAD * 2048 * 2);
constexpr size_t OFF_BAR = al256(OFF_SMALL + 3072 * 4);
constexpr size_t OFF_PART = al256(OFF_BAR + (size_t)XCD_BAR_WORDS * 4);
constexpr size_t WS_NEED = al256(OFF_PART + (size_t)12 * 16 * 256 * 256 * 4);
static_assert(OFF_AP + (size_t)TPAD * D * 2 <= WS_NEED && OFF_ACT + (size_t)TPAD * DFF * 2 <= WS_NEED, "big region");

struct Params { const float* in[19]; float* out; unsigned char* ws; };

__device__ __forceinline__ void row_decode(int r, int& gb, int& l, int& L, int& rb) {
    if (r < TA) { gb = r / LA; l = r - gb * LA; L = LA; rb = gb * LA; }
    else { const int q = r - TA, b = q / LB; l = q - b * LB; gb = NBA + b; L = LB; rb = TA + b * LB; }
}
__device__ __forceinline__ float* hptr2(float* out, unsigned char* ws, int r) {
    int gb, l, L, rb; row_decode(r, gb, l, L, rb);
    if (l < 16) return (float*)(ws + OFF_HMETA) + (size_t)(gb * 16 + l) * D;
    return out + (size_t)(r - 16 * (gb + 1)) * D;
}
__device__ __forceinline__ float* hptr(const Params& p, int r) {
    int gb, l, L, rb; row_decode(r, gb, l, L, rb);
    if (l < 16) return (float*)(p.ws + OFF_HMETA) + (size_t)(gb * 16 + l) * D;
    return p.out + (size_t)(r - 16 * (gb + 1)) * D;
}
__device__ __forceinline__ int otid() { int t = threadIdx.x; asm volatile("" : "+v"(t)); return t; }
__device__ __forceinline__ bf16_t f2bf(float f) { unsigned u = __float_as_uint(f); u += 0x7FFFu + ((u >> 16) & 1u); return (bf16_t)(u >> 16); }
__device__ __forceinline__ float bflo(unsigned w) { return __uint_as_float(w << 16); }
__device__ __forceinline__ float bfhi(unsigned w) { return __uint_as_float(w & 0xFFFF0000u); }
__device__ __forceinline__ float wave_sum(float v) {
#pragma unroll
    for (int o = 1; o < 64; o <<= 1) v += __shfl_xor(v, o);
    return v;
}
__device__ __forceinline__ float rstd_of(float ss) { return __builtin_amdgcn_rsqf(ss * (1.0f / 1024.0f) + 1e-6f); }

struct EpiGateUp {
    static constexpr bool PERM = true, AFTER_DRAIN = false;
    bf16_t* act; const float* rss;
    __device__ __forceinline__ void operator()(const f32x4 (&acc)[2][2][4][2], const Unit& u, int wr, int wc, int fr, int fq) const {
        const int col = u.pn * 128 + wc * 32 + fq * 8;
        float rsc[2][4];
#pragma unroll
        for (int ai = 0; ai < 2; ++ai)
#pragma unroll
            for (int m = 0; m < 4; ++m) { const int r = u.pm * 256 + ai * 128 + wr * 64 + m * 16 + fr; const f32x4 q4 = gload((const f32x4*)(rss + (size_t)min(r, T - 1) * 4)); rsc[ai][m] = (q4[0] + q4[1]) + (q4[2] + q4[3]); }
#pragma unroll
        for (int ai = 0; ai < 2; ++ai)
#pragma unroll
            for (int m = 0; m < 4; ++m) rsc[ai][m] = rstd_of(rsc[ai][m]);
#pragma unroll
        for (int ai = 0; ai < 2; ++ai)
#pragma unroll
            for (int m = 0; m < 4; ++m) {
                const int r = u.pm * 256 + ai * 128 + wr * 64 + m * 16 + fr;
                const float rs = rsc[ai][m]; const f32x2 rs2 = {rs * rs, rs * rs}, nrl = {rs * -1.4426950408889634f, rs * -1.4426950408889634f}, one = {1.0f, 1.0f};
                unsigned w[4];
#pragma unroll
                for (int n = 0; n < 2; ++n)
#pragma unroll
                    for (int e = 0; e < 4; e += 2) {
                        const f32x2 g = {acc[ai][0][m][n][e], acc[ai][0][m][n][e + 1]}, uu = {acc[ai][1][m][n][e], acc[ai][1][m][n][e + 1]};
                        const f32x2 t = g * nrl; f32x2 ex; ex.x = __builtin_amdgcn_exp2f(t.x); ex.y = __builtin_amdgcn_exp2f(t.y);
                        const f32x2 dn = ex + one; f32x2 rc; rc.x = __builtin_amdgcn_rcpf(dn.x); rc.y = __builtin_amdgcn_rcpf(dn.y);
                        const f32x2 o2 = ((g * uu) * rs2) * rc;
                        w[n * 2 + (e >> 1)] = cvt_pk_bf16(o2.x, o2.y);
                    }
                u32x4 o; o.x = w[0]; o.y = w[1]; o.z = w[2]; o.w = w[3];
                if (r < T) gstore((u32x4*)(act + (size_t)r * DFF + col), o);
            }
    }
};
struct EpiScale {
    static constexpr bool PERM = true, AFTER_DRAIN = false;
    bf16_t* O; int ldc; const float* rss;
    __device__ __forceinline__ void operator()(const f32x4 (&acc)[2][2][4][2], const Unit& u, int wr, int wc, int fr, int fq) const {
        const int col = u.pn * 256 + wc * 32 + fq * 8;
        float rsv[2][4];
#pragma unroll
        for (int ai = 0; ai < 2; ++ai)
#pragma unroll
            for (int m = 0; m < 4; ++m) { const int r = u.pm * 256 + ai * 128 + wr * 64 + m * 16 + fr; { const f32x4 q4 = gload((const f32x4*)(rss + (size_t)min(r, T - 1) * 4)); rsv[ai][m] = (q4[0] + q4[1]) + (q4[2] + q4[3]); } }
#pragma unroll
        for (int ai = 0; ai < 2; ++ai)
#pragma unroll
            for (int m = 0; m < 4; ++m) {
                const int r = u.pm * 256 + ai * 128 + wr * 64 + m * 16 + fr;
                const float rs = rstd_of(rsv[ai][m]);
                if (r < T) {
#pragma unroll
                    for (int bj = 0; bj < 2; ++bj) {
                        const f32x4 v0 = acc[ai][bj][m][0] * rs, v1 = acc[ai][bj][m][1] * rs;
                        u32x4 o; o.x = cvt_pk_bf16(v0[0], v0[1]); o.y = cvt_pk_bf16(v0[2], v0[3]); o.z = cvt_pk_bf16(v1[0], v1[1]); o.w = cvt_pk_bf16(v1[2], v1[3]);
                        gstore((u32x4*)(O + (size_t)r * ldc + col + bj * 128), o);
                    }
                }
            }
    }
};
struct EpiNone {
    static constexpr bool PERM = true, AFTER_DRAIN = false;
    __device__ __forceinline__ void operator()(const f32x4 (&acc)[2][2][4][2], const Unit& u, int wr, int wc, int fr, int fq) const {
#pragma unroll
        for (int ai = 0; ai < 2; ++ai)
#pragma unroll
            for (int bj = 0; bj < 2; ++bj)
#pragma unroll
                for (int m = 0; m < 4; ++m)
#pragma unroll
                    for (int n = 0; n < 2; ++n) asm volatile("" :: "v"(acc[ai][bj][m][n]));
    }
};
template <bool LAST> struct EpiResid {
    static constexpr bool PERM = true, AFTER_DRAIN = false;
    float* out; unsigned char* ws; int half; float* rss4; LAS float* part;
    __device__ __forceinline__ void operator()(const f32x4 (&acc)[2][2][4][2], const Unit& u, int wr, int wc, int fr, int fq) const {
        const int col = u.pn * 256 + wc * 32 + fq * 8;
        bf16_t* hb = (bf16_t*)(ws + OFF_HB);
        u32x4 hv[2][4][2];
#pragma unroll
        for (int ai = 0; ai < 2; ++ai)
#pragma unroll
            for (int m = 0; m < 4; ++m) { const int r = u.pm * 256 + ai * 128 + wr * 64 + m * 16 + fr; const bf16_t* hp = hb + (size_t)min(r, T - 1) * D + col;
#pragma unroll
                for (int bj = 0; bj < 2; ++bj) hv[ai][m][bj] = gload((const u32x4*)(hp + bj * 128)); }
#pragma unroll
        for (int ai = 0; ai < 2; ++ai)
#pragma unroll
            for (int m = 0; m < 4; ++m) {
                const int r = u.pm * 256 + ai * 128 + wr * 64 + m * 16 + fr;
                f32x2 ss2 = {0.f, 0.f}; const float scale = half ? 0.5f : 1.0f; const f32x2 sc2 = {scale, scale};
#pragma unroll
                for (int bj = 0; bj < 2; ++bj) {
                    const u32x4 w = hv[ai][m][bj]; const f32x4 a0 = acc[ai][bj][m][0], a1 = acc[ai][bj][m][1];
                    f32x2 p0 = {bflo(w.x), bfhi(w.x)}, p1 = {bflo(w.y), bfhi(w.y)}, p2 = {bflo(w.z), bfhi(w.z)}, p3 = {bflo(w.w), bfhi(w.w)};
                    p0 += (f32x2){a0[0], a0[1]} * sc2; p1 += (f32x2){a0[2], a0[3]} * sc2; p2 += (f32x2){a1[0], a1[1]} * sc2; p3 += (f32x2){a1[2], a1[3]} * sc2;
                    ss2 += p0 * p0; ss2 += p1 * p1; ss2 += p2 * p2; ss2 += p3 * p3;
                    if (r < T) {
                        u32x4 o; o.x = cvt_pk_bf16(p0.x, p0.y); o.y = cvt_pk_bf16(p1.x, p1.y); o.z = cvt_pk_bf16(p2.x, p2.y); o.w = cvt_pk_bf16(p3.x, p3.y);
                        gstore((u32x4*)(hb + (size_t)r * D + col + bj * 128), o);
                    }
                }
                float ss = ss2.x + ss2.y;
                ss += __shfl_xor(ss, 16); ss += __shfl_xor(ss, 32);
                if (fq == 0) part[(ai * 128 + wr * 64 + m * 16 + fr) * 4 + wc] = ss;
            }
        asm volatile("s_waitcnt lgkmcnt(0)" ::: "memory"); __builtin_amdgcn_s_barrier(); asm volatile("" ::: "memory");
        const int lane = fq * 16 + fr;
        if (lane < 32) { const int rl = (lane >> 4) * 128 + wr * 64 + wc * 16 + (lane & 15), r = u.pm * 256 + rl;
            const f32x4 v = *(const LAS f32x4*)(part + rl * 4);
            if (r < T) gstore(rss4 + (size_t)r * 4 + u.pn, (v[0] + v[1]) + (v[2] + v[3])); }
    }
};
struct EpiDft {
    static constexpr bool PERM = true, AFTER_DRAIN = false;
    bf16_t* X; int L, rowbase;
    __device__ __forceinline__ void operator()(const f32x4 (&acc)[2][2][4][2], const Unit& u, int wr, int wc, int fr, int fq) const {
        const int b = u.pn >> 2, c0 = (u.pn & 3) * 256 + wc * 32 + fq * 8, H = L >> 1;
#pragma unroll
        for (int ai = 0; ai < 2; ++ai)
#pragma unroll
            for (int m = 0; m < 4; ++m) {
                const int kk = u.pm * 256 + ai * 128 + wr * 64 + m * 16 + fr;
                if (kk < L) {
                    const bool isc = kk <= H; const int k = isc ? kk : kk - H; const float sg = isc ? 1.f : -1.f;
                    bf16_t* x0 = X + (size_t)(rowbase + b * L + k) * 2048 + (isc ? 0 : 1024) + c0;
                    bf16_t* x1 = X + (size_t)(rowbase + b * L + (L - k)) * 2048 + (isc ? 0 : 1024) + c0;
                    const bool mir = (k >= 1) && (k < H);
#pragma unroll
                    for (int bj = 0; bj < 2; ++bj) {
                        const f32x4 v0 = acc[ai][bj][m][0] * sg, v1 = acc[ai][bj][m][1] * sg;
                        u32x4 o; o.x = cvt_pk_bf16(v0[0], v0[1]); o.y = cvt_pk_bf16(v0[2], v0[3]); o.z = cvt_pk_bf16(v1[0], v1[1]); o.w = cvt_pk_bf16(v1[2], v1[3]);
                        gstore((u32x4*)(x0 + bj * 128), o);
                        if (mir) { u32x4 q; if (isc) q = o; else { q.x = o.x ^ 0x80008000u; q.y = o.y ^ 0x80008000u; q.z = o.z ^ 0x80008000u; q.w = o.w ^ 0x80008000u; } gstore((u32x4*)(x1 + bj * 128), q); }
                        if (isc && !mir) { u32x4 zz; zz.x = 0; zz.y = 0; zz.z = 0; zz.w = 0; gstore((u32x4*)(x0 + 1024 + bj * 128), zz); }
                    }
                }
            }
    }
};

struct DftOrder : pg8::StaticOrder {
    int cc, GG, mode;
    __device__ void init2(int M, int N, int G_, int c_, int mode_) { init(M, N, 1, 0); cc = c_; GG = G_; mode = mode_; }
    __device__ bool next(int i, Unit& u) const { int L;
        if (mode == 0) { L = i * GG + cc; if (L >= nwg) return false; }
        else if (cc < 32) { if (i >= 3) return false; L = 1056 + cc * 3 + i; }
        else { const int d = cc - 32; if (i < 4) L = i * 224 + d; else if (i == 4 && d < 160) L = 896 + d; else return false; }
        return pg8::StaticOrder::next(L, u); }
};
constexpr int TAIL_L0 = 6 * 256, TAIL_UNITS = (TPAD / 256) * 4 - TAIL_L0;
struct CapOrder : pg8::StaticOrder {
    int cc, GG, cap;
    __device__ void init2(int M, int N, int G_, int c_, int cap_) { init(M, N, 1, 0); cc = c_; GG = G_; cap = cap_; }
    __device__ bool next(int i, Unit& u) const { const int L = i * GG + cc; if (L >= cap) return false; return pg8::StaticOrder::next(L, u); }
};
struct TailOrder : pg8::StaticOrder {
    int tu;
    __device__ void init2(int M, int N, int tu_) { init(M, N, 1, 0); tu = tu_; }
    __device__ bool next(int i, Unit& u) const { if (i != 0) return false; return pg8::StaticOrder::next(TAIL_L0 + tu, u); }
};
struct EpiPartial {
    static constexpr bool PERM = true, AFTER_DRAIN = false;
    float* P;
    __device__ __forceinline__ void operator()(const f32x4 (&acc)[2][2][4][2], const Unit& u, int wr, int wc, int fr, int fq) const {
#pragma unroll
        for (int ai = 0; ai < 2; ++ai)
#pragma unroll
            for (int m = 0; m < 4; ++m) { float* rowp = P + (size_t)(ai * 128 + wr * 64 + m * 16 + fr) * 256 + wc * 32 + fq * 8;
#pragma unroll
                for (int bj = 0; bj < 2; ++bj) { gstore((f32x4*)(rowp + bj * 128), acc[ai][bj][m][0]); gstore((f32x4*)(rowp + bj * 128 + 4), acc[ai][bj][m][1]); } }
    }
};
__device__ __forceinline__ void tail_fixup(unsigned char* ws, int nsl, int half) {
    const float scale = half ? 0.5f : 1.0f;
    const int tid = otid(), lane = tid & 63, gw = blockIdx.x * 8 + (tid >> 6), NGW = gridDim.x * 8;
    bf16_t* hb = (bf16_t*)(ws + OFF_HB); float* rss4 = (float*)(ws + OFF_RSS); const float* P0 = (const float*)(ws + OFF_PART);
    pg8::StaticOrder so; so.init(TPAD, D, 1, 0);
    for (int it = gw; it < TAIL_UNITS * 256; it += NGW) {
        const int tu = it >> 8, rl = it & 255; Unit u; so.next(TAIL_L0 + tu, u);
        const int r = u.pm * 256 + rl, col = u.pn * 256 + lane * 4;
        f32x4 a = {0.f, 0.f, 0.f, 0.f};
        f32x4 pv[11];
#pragma unroll
        for (int sl = 0; sl < 11; ++sl) pv[sl] = *(const f32x4*)(P0 + ((size_t)(tu * 16 + min(sl, nsl - 1)) * 256 + rl) * 256 + lane * 4);
#pragma unroll
        for (int sl = 0; sl < 11; ++sl) { const float m = sl < nsl ? 1.0f : 0.0f; a += pv[sl] * m; }
        float ss = 0.f;
        if (r < T) { const u32x2 w = *(const u32x2*)(hb + (size_t)r * D + col);
            f32x4 h; h[0] = bflo(w.x); h[1] = bfhi(w.x); h[2] = bflo(w.y); h[3] = bfhi(w.y); h += a * scale;
            ss = (h[0] * h[0] + h[1] * h[1]) + (h[2] * h[2] + h[3] * h[3]);
            u32x2 o; o.x = cvt_pk_bf16(h[0], h[1]); o.y = cvt_pk_bf16(h[2], h[3]); *(u32x2*)(hb + (size_t)r * D + col) = o; }
        ss = wave_sum(ss);
        if (lane == 0 && r < T) rss4[(size_t)r * 4 + u.pn] = ss;
    }
}
struct LocalOrder : pg8::StaticOrder { __device__ bool next(int i, Unit& u) const { const bool ok = pg8::StaticOrder::next(i, u); u.pm &= 7; return ok; } };
template <class Epi>
__device__ __forceinline__ void run_gemm(LAS unsigned char* lds, const bf16_t* A, const bf16_t* Bt, int M, int N, int K, const Epi& E, int c) {
    pg8::Gemm g; g.A = A; g.Bt = Bt; g.M = M; g.N = N; g.K = K; g.ld = K;
    pg8::StaticOrder S; S.init(M, N, (int)gridDim.x, c);
    pg8::gemm_phase<Epi, pg8::StaticOrder, false>(lds, g, S, E, nullptr);
}

__device__ __forceinline__ void transpose_item(const float* W, int N, const float* gain, bf16_t* WT, int ldd, int k0, int n0, int drow0, LAS float* scr, int lane, float osc = 1.0f) {
#pragma unroll
    for (int i = 0; i < 32; ++i) { const int kk = 2 * i + (lane >> 5); f32x2 v = *(const f32x2*)(W + (size_t)(k0 + kk) * N + n0 + 2 * (lane & 31)); if (gain) v *= gain[k0 + kk] * osc; *(LAS f32x2*)(scr + kk * 66 + 2 * (lane & 31)) = v; }
    asm volatile("s_waitcnt lgkmcnt(0)" ::: "memory");
    const int c = lane & 7;
#pragma unroll
    for (int jj = 0; jj < 8; ++jj) { const int n = (lane >> 3) + 8 * jj; const LAS float* sp = scr + (8 * c) * 66 + n;
        u32x4 o; o.x = cvt_pk_bf16(sp[0 * 66], sp[1 * 66]); o.y = cvt_pk_bf16(sp[2 * 66], sp[3 * 66]); o.z = cvt_pk_bf16(sp[4 * 66], sp[5 * 66]); o.w = cvt_pk_bf16(sp[6 * 66], sp[7 * 66]);
        *(u32x4*)(WT + (size_t)(drow0 + n) * ldd + k0 + 8 * c) = o; }
    asm volatile("s_waitcnt lgkmcnt(0)" ::: "memory");
}
__device__ __forceinline__ void dft_item(bf16_t* Dm, int L, int LP, int witem, int lane) {
    const int cpr = LP >> 3, H = L >> 1; const int tix = witem * 64 + lane; const int kk = tix / cpr, c8 = tix - kk * cpr;
    const bool isc = kk <= H; const int k = isc ? kk : kk - H;
    const float sc = rsqrtf((float)L), invL = 1.0f / (float)L;
    int mm = (k * (c8 * 8)) % L;
    unsigned w[4];
#pragma unroll
    for (int e = 0; e < 8; e += 2) {
        float v[2];
#pragma unroll
        for (int q = 0; q < 2; ++q) { const int n = c8 * 8 + e + q; const float a = (float)mm * invL;
            const float x = (isc ? __builtin_amdgcn_cosf(a) : __builtin_amdgcn_sinf(a)) * sc;
            v[q] = (kk < L && n < L) ? x : 0.f;
            mm += k; mm = mm >= L ? mm - L : mm; }
        w[e >> 1] = cvt_pk_bf16(v[0], v[1]);
    }
    u32x4 o; o.x = w[0]; o.y = w[1]; o.z = w[2]; o.w = w[3];
    *(u32x4*)(Dm + (size_t)kk * LP + c8 * 8) = o;
}
__device__ __forceinline__ void prep_phase(const Params& p, LAS unsigned char* lds) {
    const int tid = otid(), lane = tid & 63, wave = __builtin_amdgcn_readfirstlane(tid >> 6);
    const int gw = blockIdx.x * 8 + wave, NGW = gridDim.x * 8;
    LAS float* scr = (LAS float*)(lds + wave * 16896);
    LAS float* tab = (LAS float*)(lds + 8 * 16896);
    if (tid < 256) { tab[tid] = cospif((float)tid * (1.0f / 128.0f)); tab[256 + tid] = sinpif((float)tid * (1.0f / 128.0f)); }
    __syncthreads();
    if (blockIdx.x == 0) { float* sm = (float*)(p.ws + OFF_SMALL); if (tid < 8) sm[tid] = p.in[9][tid]; for (int i = tid; i < 1024; i += 512) { sm[1024 + i] = p.in[7][D + i]; sm[2048 + i] = p.in[18][i]; } }
    bf16_t* Wgu = (bf16_t*)(p.ws + OFF_WGU); bf16_t* Wd = (bf16_t*)(p.ws + OFF_WD); bf16_t* Win = (bf16_t*)(p.ws + OFF_WIN);
    bf16_t* Wo = (bf16_t*)(p.ws + OFF_WO); bf16_t* W2t = (bf16_t*)(p.ws + OFF_W2T);
    constexpr int I_G = 16 * 44, I_D = 44 * 16;
    constexpr int N_TR_FFN = 4 * (2 * I_G + I_D);
    constexpr int I_IN = 16 * 20, I_WO = 8 * 16;
    constexpr int R0 = N_TR_FFN, R1 = R0 + I_IN, R2 = R1 + I_WO;
    constexpr int N_W3 = 256 * 8, N_W2 = 128 * 32;
    constexpr int R3 = R2 + N_W3, R4 = R3 + N_W2;
    constexpr int N_D1 = MPA * (LPA / 8) / 64, N_D2 = MPB * (LPB / 8) / 64;
    constexpr int R5 = R4 + N_D1, R6 = R5 + N_D2, R7 = R6 + T / 2;
    for (int it = gw; it < R7; it += NGW) {
        if (it < R0) {
            const int f = it / (2 * I_G + I_D); int r = it - f * (2 * I_G + I_D); const int layer = f >> 1, which = f & 1;
            if (r < 2 * I_G) { const int up = r >= I_G; if (up) r -= I_G;
                const float* src = p.in[which ? (up ? 16 : 15) : (up ? 5 : 4)] + (size_t)layer * D * DFF;
                const float* gain = p.in[which ? 14 : 3] + layer * D;
                const int kb = r / 44, nb = r - kb * 44, n0 = nb * 64;
                const int drow0 = (n0 >> 7) * 256 + (up ? 128 : 0) + (n0 & 127);
                transpose_item(src, DFF, gain, Wgu + (size_t)f * NGU * D, D, kb * 64, n0, drow0, scr, lane);
            } else { r -= 2 * I_G;
                const float* src = p.in[which ? 17 : 6] + (size_t)layer * DFF * D;
                const int kb = r / 16, nb = r - kb * 16;
                transpose_item(src, D, nullptr, Wd + (size_t)f * D * DFF, DFF, kb * 64, nb * 64, nb * 64, scr, lane);
            }
        } else if (it < R1) { const int r = it - R0, kb = r / 20, nb = r - kb * 20;
            transpose_item(p.in[8], INDIM, p.in[7], Win, D, kb * 64, nb * 64, nb * 64, scr, lane, nb < 8 ? 0.125f : 1.0f);
        } else if (it < R2) { const int r = it - R1, kb = r / 16, nb = r - kb * 16;
            transpose_item(p.in[12], D, nullptr, Wo, D, kb * 64, nb * 64, nb * 64, scr, lane);
        } else if (it < R3) {
            const int r = it - R2, j = (r & 255) * 4, kb = r >> 8, kk = kb * 64 + lane, g = kk >> 7, c = kk & 127;
            const float* pw = p.in[10] + (size_t)(g * 128 + c) * 128; const float* ps = p.in[11] + g * 128; const float* wo = p.in[12] + (size_t)(512 + g * 128) * D + j;
            f32x4 a = {0.f, 0.f, 0.f, 0.f};
#pragma unroll 16
            for (int d = 0; d < 128; ++d) { const f32x4 w = *(const f32x4*)(wo + (size_t)d * D); a += w * (pw[d] * ps[d]); }
#pragma unroll
            for (int q = 0; q < 4; ++q) Wo[(size_t)(j + q) * D + 512 + kk] = f2bf(a[q]);
        } else if (it < R4) {
            const int r = it - R3, j = (r & 127) * 8, kb = r >> 7, kk = kb * 64 + lane, part = kk >> 10, k2 = kk & 1023, g = k2 >> 8, c = k2 & 255;
            const float* wf = p.in[13] + (size_t)(g * 256) * D + j; const LAS float* tb = tab + part * 256;
            f32x4 a0 = {0.f, 0.f, 0.f, 0.f}, a1 = {0.f, 0.f, 0.f, 0.f};
#pragma unroll 8
            for (int d = 0; d < 256; ++d) { const f32x4 w0 = *(const f32x4*)(wf + (size_t)d * D), w1 = *(const f32x4*)(wf + (size_t)d * D + 4); const float t = tb[(c * d) & 255]; a0 += w0 * t; a1 += w1 * t; }
#pragma unroll
            for (int q = 0; q < 4; ++q) { W2t[(size_t)(j + q) * 2048 + kk] = f2bf(a0[q] * 0.0625f); W2t[(size_t)(j + 4 + q) * 2048 + kk] = f2bf(a1[q] * 0.0625f); }
        } else if (it < R5) { dft_item((bf16_t*)(p.ws + OFF_D1), LA, LPA, it - R4, lane);
        } else if (it < R6) { dft_item((bf16_t*)(p.ws + OFF_D2), LB, LPB, it - R5, lane);
        } else {
            const int r0 = (it - R6) * 2; const float* src[2]; f32x4 v[2][4];
#pragma unroll
            for (int q = 0; q < 2; ++q) { int gb, l, L, rb; row_decode(r0 + q, gb, l, L, rb);
                src[q] = (l < 16) ? p.in[2] + (size_t)l * D : (gb < NBA ? p.in[0] + ((size_t)gb * 4096 + (l - 16)) * D : p.in[1] + ((size_t)(gb - NBA) * 2048 + (l - 16)) * D); }
#pragma unroll
            for (int q = 0; q < 2; ++q)
#pragma unroll
                for (int i = 0; i < 4; ++i) v[q][i] = *(const f32x4*)(src[q] + (lane + 64 * i) * 4);
            float* rss0 = (float*)(p.ws + OFF_RSS);
#pragma unroll
            for (int q = 0; q < 2; ++q) { bf16_t* hb = (bf16_t*)(p.ws + OFF_HB) + (size_t)(r0 + q) * D; float ss = 0.f;
#pragma unroll
                for (int i = 0; i < 4; ++i) { ss += (v[q][i][0] * v[q][i][0] + v[q][i][1] * v[q][i][1]) + (v[q][i][2] * v[q][i][2] + v[q][i][3] * v[q][i][3]);
                    u32x2 o; o.x = cvt_pk_bf16(v[q][i][0], v[q][i][1]); o.y = cvt_pk_bf16(v[q][i][2], v[q][i][3]); *(u32x2*)(hb + (lane + 64 * i) * 4) = o; }
                ss = wave_sum(ss);
                if (lane == 0) { f32x4 q4 = {ss, 0.f, 0.f, 0.f}; *(f32x4*)(rss0 + (size_t)(r0 + q) * 4) = q4; } }
        }
    }
}

template <int HW> __device__ __forceinline__ void pool_item(const bf16_t* z, bf16_t* ap, int r, int ch) {
    int gb, l, L, rb; row_decode(r, gb, l, L, rb);
    const bf16_t* base = z + (size_t)r * INDIM + 768 + ch * 8;
    u32x4 v[2 * HW + 1];
#pragma unroll
    for (int o = 0; o <= 2 * HW; ++o) { const int s = l - HW + o; u32x4 t; t.x = 0; t.y = 0; t.z = 0; t.w = 0; if (s >= 0 && s < L) t = *(const u32x4*)(base + (long)(o - HW) * INDIM); v[o] = t; }
    float s0 = 0.f, s1 = 0.f, s2 = 0.f, s3 = 0.f, s4 = 0.f, s5 = 0.f, s6 = 0.f, s7 = 0.f;
#pragma unroll
    for (int o = 1; o < 2 * HW; ++o) { s0 += bflo(v[o].x); s1 += bfhi(v[o].x); s2 += bflo(v[o].y); s3 += bfhi(v[o].y); s4 += bflo(v[o].z); s5 += bfhi(v[o].z); s6 += bflo(v[o].w); s7 += bfhi(v[o].w); }
#pragma unroll
    for (int q = 0; q < 2; ++q) {
        const u32x4 ex = v[q ? 2 * HW : 0], me = v[HW + q]; const int lq = l + q;
        const float ic = 1.0f / (float)(min(lq + HW, L) - max(lq - HW, 0));
        u32x4 o; o.x = cvt_pk_bf16((s0 + bflo(ex.x)) * ic - bflo(me.x), (s1 + bfhi(ex.x)) * ic - bfhi(me.x)); o.y = cvt_pk_bf16((s2 + bflo(ex.y)) * ic - bflo(me.y), (s3 + bfhi(ex.y)) * ic - bfhi(me.y));
        o.z = cvt_pk_bf16((s4 + bflo(ex.z)) * ic - bflo(me.z), (s5 + bfhi(ex.z)) * ic - bfhi(me.z)); o.w = cvt_pk_bf16((s6 + bflo(ex.w)) * ic - bflo(me.w), (s7 + bfhi(ex.w)) * ic - bfhi(me.w));
        *(u32x4*)(ap + (size_t)(r + q) * D + 512 + ch * 8) = o;
    }
}
struct PW { unsigned char* ws; float* out; };
__device__ __forceinline__ void attn_phase(const PW& p, LAS unsigned char* lds) {
    const bf16_t* z = (const bf16_t*)(p.ws + OFF_Z); bf16_t* ap = (bf16_t*)(p.ws + OFF_AP); const float* sink = (const float*)(p.ws + OFF_SMALL);
    const int tid = otid(), lane = tid & 63, wave = __builtin_amdgcn_readfirstlane(tid >> 6), fr = lane & 15, fq = lane >> 4;
    LAS unsigned char* Ks = lds;
    LAS unsigned char* Vt = lds + 55296;
    constexpr int NU = (NBA * 33 + NBB * 17) * 2;
    for (int unit = blockIdx.x; unit < NU; unit += gridDim.x) {
        const int kvh = unit & 1; int tt = unit >> 1; int sb, ti, L, rb;
        if (tt < NBA * 33) { sb = tt / 33; ti = tt - sb * 33; L = LA; rb = sb * LA; } else { tt -= NBA * 33; sb = tt / 17; ti = tt - sb * 17; L = LB; rb = TA + sb * LB; }
        const int l0 = ti * 128;
        __syncthreads();
        {
            typedef __attribute__((address_space(1))) const u32x4 gu32x4;
            u32x4 kreg[6], vreg[7];
#pragma unroll
            for (int i = 0; i < 6; ++i) { const int idx = tid + 512 * i, j = idx >> 3, ch = idx & 7, s = l0 - 128 + j; const bool ok = (s >= 0) && (s < L);
                kreg[i] = *(gu32x4*)(z + (size_t)(rb + (ok ? s : 0)) * INDIM + 512 + kvh * 64 + ch * 8); }
#pragma unroll
            for (int i = 0; i < 7; ++i) { const int idx = tid + 512 * i, ch = min(idx / 400, 7), j = idx - (idx / 400) * 400, s = l0 - 128 + j; const bool ok = (idx < 3200) && (j < 384) && (s >= 0) && (s < L);
                vreg[i] = *(gu32x4*)(z + (size_t)(rb + (ok ? s : 0)) * INDIM + 640 + kvh * 64 + ch * 8); }
            __builtin_amdgcn_sched_barrier(0);
#pragma unroll
            for (int i = 0; i < 6; ++i) { const int idx = tid + 512 * i, j = idx >> 3, s = l0 - 128 + j; const bool ok = (s >= 0) && (s < L);
                kreg[i].x = ok ? kreg[i].x : 0u; kreg[i].y = ok ? kreg[i].y : 0u; kreg[i].z = ok ? kreg[i].z : 0u; kreg[i].w = ok ? kreg[i].w : 0u; }
#pragma unroll
            for (int i = 0; i < 7; ++i) { const int idx = tid + 512 * i, j = idx - (idx / 400) * 400, s = l0 - 128 + j; const bool ok = (idx < 3200) && (j < 384) && (s >= 0) && (s < L);
                vreg[i].x = ok ? vreg[i].x : 0u; vreg[i].y = ok ? vreg[i].y : 0u; vreg[i].z = ok ? vreg[i].z : 0u; vreg[i].w = ok ? vreg[i].w : 0u; }
#pragma unroll
            for (int i = 0; i < 6; ++i) { const int idx = tid + 512 * i, j = idx >> 3, ch = idx & 7; *(LAS u32x4*)(Ks + j * 144 + ch * 16) = kreg[i]; }
#pragma unroll
            for (int i = 0; i < 7; ++i) { const int idx = tid + 512 * i; if (idx < 3200) { const int ch = idx / 400, j = idx - ch * 400; const u32x4 v = vreg[i];
                LAS bf16_t* dst = (LAS bf16_t*)Vt + (ch * 8) * 408 + j;
                dst[0 * 408] = (bf16_t)(v.x & 0xFFFFu); dst[1 * 408] = (bf16_t)(v.x >> 16); dst[2 * 408] = (bf16_t)(v.y & 0xFFFFu); dst[3 * 408] = (bf16_t)(v.y >> 16);
                dst[4 * 408] = (bf16_t)(v.z & 0xFFFFu); dst[5 * 408] = (bf16_t)(v.z >> 16); dst[6 * 408] = (bf16_t)(v.w & 0xFFFFu); dst[7 * 408] = (bf16_t)(v.w >> 16); } }
        }
        __syncthreads();
        const int lq0 = l0 + 16 * wave + fr;
        if (l0 + 16 * wave < L) {
#pragma unroll 1
            for (int g = 0; g < 4; ++g) {
                int lq = lq0; asm volatile("" : "+v"(lq)); const bool qok = lq < L;
                const int h = kvh * 4 + g; const float slope = exp2f(-(float)(h + 1)); const float sk = sink[h];
                bf16x8 qf[2];
#pragma unroll
                for (int kk = 0; kk < 2; ++kk) { u32x4 q; q.x = 0; q.y = 0; q.z = 0; q.w = 0; if (qok) q = *(const u32x4*)(z + (size_t)(rb + lq) * INDIM + h * 64 + kk * 32 + fq * 8); qf[kk] = __builtin_bit_cast(bf16x8, q); }
                f32x4 sc[17];
#pragma unroll
                for (int t = 0; t < 17; ++t) { f32x4 a = {0.f, 0.f, 0.f, 0.f};
#pragma unroll
                    for (int kk = 0; kk < 2; ++kk) { const bf16x8 kf = *(const LAS bf16x8*)(Ks + (16 * wave + 16 * t + fr) * 144 + (kk * 32 + fq * 8) * 2); a = __builtin_amdgcn_mfma_f32_16x16x32_bf16(kf, qf[kk], a, 0, 0, 0); }
                    sc[t] = a; __builtin_amdgcn_sched_barrier(0); }
                float mx = -1e30f;
                int db = 128 + fr - 4 * fq, lob = 128 - l0 - 16 * wave - 4 * fq; asm volatile("" : "+v"(db), "+v"(lob));
#pragma unroll
                for (int t = 0; t < 17; ++t)
#pragma unroll
                    for (int e = 0; e < 4; ++e) { const int off = 16 * t + e; const int dist = abs(db - off);
                        bool valid = (unsigned)(off - lob) < (unsigned)L;
                        if (t == 0 || t == 16) valid = valid && (dist <= 128);
                        const float v = valid ? fmaf(-slope, (float)dist, sc[t][e]) : -1e30f; sc[t][e] = v; mx = fmaxf(mx, v); }
                mx = fmaxf(mx, __shfl_xor(mx, 16)); mx = fmaxf(mx, __shfl_xor(mx, 32)); mx = fmaxf(mx, sk);
                float sum = 0.f;
#pragma unroll
                for (int t = 0; t < 17; ++t)
#pragma unroll
                    for (int e = 0; e < 4; ++e) { const float pv = __expf(sc[t][e] - mx); sc[t][e] = pv; sum += pv; }
                sum += __shfl_xor(sum, 16); sum += __shfl_xor(sum, 32); sum += __expf(sk - mx);
                const float inv = 1.0f / sum;
                f32x4 o[4];
#pragma unroll
                for (int dt = 0; dt < 4; ++dt) o[dt] = (f32x4){0.f, 0.f, 0.f, 0.f};
#pragma unroll
                for (int u = 0; u < 9; ++u) {
                    u32x4 pw; pw.x = cvt_pk_bf16(sc[2 * u][0], sc[2 * u][1]); pw.y = cvt_pk_bf16(sc[2 * u][2], sc[2 * u][3]);
                    if (2 * u + 1 < 17) { pw.z = cvt_pk_bf16(sc[(2 * u + 1) % 17][0], sc[(2 * u + 1) % 17][1]); pw.w = cvt_pk_bf16(sc[(2 * u + 1) % 17][2], sc[(2 * u + 1) % 17][3]); } else { pw.z = 0; pw.w = 0; }
                    const bf16x8 pf = __builtin_bit_cast(bf16x8, pw);
#pragma unroll
                    for (int dt = 0; dt < 4; ++dt) { const LAS unsigned char* vp = Vt + (16 * dt + fr) * 816 + (16 * wave + 32 * u + 4 * fq) * 2;
                        const u32x2 lo = *(const LAS u32x2*)vp, hi = *(const LAS u32x2*)(vp + 32); u32x4 vv; vv.x = lo.x; vv.y = lo.y; vv.z = hi.x; vv.w = hi.y;
                        o[dt] = __builtin_amdgcn_mfma_f32_16x16x32_bf16(__builtin_bit_cast(bf16x8, vv), pf, o[dt], 0, 0, 0); }
                    __builtin_amdgcn_sched_barrier(0);
                }
                if (qok) {
#pragma unroll
                    for (int dt = 0; dt < 4; ++dt) { u32x2 w; w.x = cvt_pk_bf16(o[dt][0] * inv, o[dt][1] * inv); w.y = cvt_pk_bf16(o[dt][2] * inv, o[dt][3] * inv);
                        *(u32x2*)(ap + (size_t)(rb + lq) * D + h * 64 + 16 * dt + 4 * fq) = w; }
                }
            }
        }
    }
    constexpr int PER_G = (T / 2) * 16;
    for (int it = blockIdx.x * 512 + tid; it < 4 * PER_G; it += gridDim.x * 512) {
        const int g = it / PER_G, rem = it - g * PER_G, r = (rem >> 4) * 2, ch = g * 16 + (rem & 15);
        if (g == 0) pool_item<1>(z, ap, r, ch); else if (g == 1) pool_item<2>(z, ap, r, ch); else if (g == 2) pool_item<4>(z, ap, r, ch); else pool_item<8>(z, ap, r, ch);
    }
}

__device__ __forceinline__ void normT_phase(const PW& p, LAS unsigned char* lds) {
    const int tid = otid(), lane = tid & 63, wave = __builtin_amdgcn_readfirstlane(tid >> 6);
    const float* gain = (const float*)(p.ws + OFF_SMALL) + 1024; bf16_t* HNT = (bf16_t*)(p.ws + OFF_HNT);
    LAS bf16_t* Tt = (LAS bf16_t*)lds;
    constexpr int NUA = NBA * (LPA / 64), NU = NUA + NBB * (LPB / 64);
    for (int unit = blockIdx.x; unit < NU; unit += gridDim.x) {
        int sb, ti, L, LP, rb; bf16_t* dst;
        if (unit < NUA) { sb = unit / (LPA / 64); ti = unit - sb * (LPA / 64); L = LA; LP = LPA; rb = sb * LA; dst = HNT + (size_t)sb * D * LPA; }
        else { const int uu = unit - NUA; sb = uu / (LPB / 64); ti = uu - sb * (LPB / 64); L = LB; LP = LPB; rb = TA + sb * LB; dst = HNT + HNT_B + (size_t)sb * D * LPB; }
        const int l0 = ti * 64;
        __syncthreads();
        {
            unsigned raw[8][8]; float rs[8];
#pragma unroll
            for (int rr = 0; rr < 8; ++rr) { const int l = l0 + wave * 8 + rr; const bool ok = l < L;
                const unsigned* hp = (const unsigned*)((const bf16_t*)(p.ws + OFF_HB) + (size_t)(rb + min(l, L - 1)) * D);
#pragma unroll
                for (int i = 0; i < 8; ++i) { unsigned t = hp[lane + 64 * i]; raw[rr][i] = ok ? t : 0u; } }
#pragma unroll
            for (int rr = 0; rr < 8; ++rr) { float ss = 0.f;
#pragma unroll
                for (int i = 0; i < 8; ++i) { const float a = bflo(raw[rr][i]), b = bfhi(raw[rr][i]); ss += a * a + b * b; }
                ss = wave_sum(ss); rs[rr] = __builtin_amdgcn_rsqf(ss * (1.0f / 1024.0f) + 1e-6f); }
            LAS unsigned* TtW = (LAS unsigned*)lds;
#pragma unroll
            for (int i = 0; i < 8; ++i) { const float g0 = gain[2 * lane + 128 * i], g1 = gain[2 * lane + 128 * i + 1]; const int c0 = 2 * lane + 128 * i;
#pragma unroll
                for (int q = 0; q < 4; ++q) {
                    TtW[c0 * 33 + wave * 4 + q] = cvt_pk_bf16(bflo(raw[2 * q][i]) * rs[2 * q] * g0, bflo(raw[2 * q + 1][i]) * rs[2 * q + 1] * g0);
                    TtW[(c0 + 1) * 33 + wave * 4 + q] = cvt_pk_bf16(bfhi(raw[2 * q][i]) * rs[2 * q] * g1, bfhi(raw[2 * q + 1][i]) * rs[2 * q + 1] * g1); } }
        }
        __syncthreads();
#pragma unroll 8
        for (int i = 0; i < 64; ++i) { const int idx = tid + 512 * i; const int c = idx >> 5, pr = idx & 31;
            const unsigned v = *(const LAS unsigned*)(Tt + c * 66 + 2 * pr); *(unsigned*)(dst + (size_t)c * LP + l0 + 2 * pr) = v; }
    }
}

__device__ __forceinline__ void final_phase(const PW& p) {
    const int tid = otid(); const int lane = tid & 63, gw = blockIdx.x * 8 + (tid >> 6), NGW = gridDim.x * 8; const float* gf = (const float*)(p.ws + OFF_SMALL) + 2048;
    const bf16_t* hb = (const bf16_t*)(p.ws + OFF_HB); const float* rss = (const float*)(p.ws + OFF_RSS);
    f32x4 gv[4];
#pragma unroll
    for (int i = 0; i < 4; ++i) gv[i] = *(const f32x4*)(gf + lane * 8 + 512 * (i >> 1) + 4 * (i & 1));
    for (int row = gw; row < 98304; row += NGW) {
        int r; if (row < NBA * 4096) { const int gb = row >> 12; r = row + 16 * (gb + 1); } else { const int o2 = row - NBA * 4096, b = o2 >> 11; r = TA + b * LB + 16 + (o2 - (b << 11)); }
        const f32x4 q4 = *(const f32x4*)(rss + (size_t)r * 4); const float rs = rstd_of((q4[0] + q4[1]) + (q4[2] + q4[3]));
        const bf16_t* hp = hb + (size_t)r * D; float* op = p.out + (size_t)row * D;
        const u32x4 w0 = *(const u32x4*)(hp + lane * 8), w1 = *(const u32x4*)(hp + 512 + lane * 8);
        f32x4 a, b2, c2, d2;
        a[0] = bflo(w0.x); a[1] = bfhi(w0.x); a[2] = bflo(w0.y); a[3] = bfhi(w0.y); b2[0] = bflo(w0.z); b2[1] = bfhi(w0.z); b2[2] = bflo(w0.w); b2[3] = bfhi(w0.w);
        c2[0] = bflo(w1.x); c2[1] = bfhi(w1.x); c2[2] = bflo(w1.y); c2[3] = bfhi(w1.y); d2[0] = bflo(w1.z); d2[1] = bfhi(w1.z); d2[2] = bflo(w1.w); d2[3] = bfhi(w1.w);
        *(f32x4*)(op + lane * 8) = a * rs * gv[0]; *(f32x4*)(op + lane * 8 + 4) = b2 * rs * gv[1];
        *(f32x4*)(op + 512 + lane * 8) = c2 * rs * gv[2]; *(f32x4*)(op + 512 + lane * 8 + 4) = d2 * rs * gv[3];
    }
}

enum { K_PREP = 0, K_GGU, K_DOWN, K_GZ, K_ATTN, K_APO, K_NORMT, K_DFT, K_FO, K_FINAL };
#ifndef REP_PREP
#define REP_PREP 1
#endif
__global__ void __launch_bounds__(512, 2) mega_fwd(Params p0) {
    extern __shared__ __attribute__((aligned(16))) unsigned char shm[];
    LAS unsigned char* lds = (LAS unsigned char*)shm;
    cg::grid_group grid = cg::this_grid();
    volatile LAS unsigned* xst = (volatile LAS unsigned*)(lds + (LDS_BYTES - 16));
    if (threadIdx.x == 0) { xst[0] = 0u; xst[1] = 0u; }
    __syncthreads();
    XcdBarrier xb = xcd_barrier_post((unsigned*)(p0.ws + OFF_BAR), xst);
    const int nrep = REP_PREP + (p0.out == nullptr ? 1 : 0);
#pragma unroll 1
    for (int rep = 0; rep < nrep; ++rep) { prep_phase(p0, lds); grid.sync(); }
#ifdef PROBE_SLEEP_TICKS
    { const unsigned long long t0 = __builtin_amdgcn_s_memrealtime(); while (__builtin_amdgcn_s_memrealtime() - t0 < (unsigned long long)PROBE_SLEEP_TICKS) __builtin_amdgcn_s_sleep(32); }
#endif
    PW p; p.ws = p0.ws; p.out = p0.out;
    { unsigned long long w = (unsigned long long)p.ws, o = (unsigned long long)p.out; asm volatile("" : "+s"(w), "+s"(o)); p.ws = (unsigned char*)w; p.out = (float*)o; }
#pragma unroll 1
    for (int ph = 1; ph < 16; ++ph) {
        int kind, f = 0, rbuf = 0;
        switch (ph) {
            case 0: kind = K_PREP; break;
            case 1: kind = K_GGU; f = 0; rbuf = 0; break;
            case 2: kind = K_DOWN; f = 0; rbuf = 1; break;
            case 3: kind = K_GZ; rbuf = 1; break;
            case 4: kind = K_ATTN; break;
            case 5: kind = K_APO; rbuf = 0; break;
            case 6: kind = K_GGU; f = 1; rbuf = 0; break;
            case 7: kind = K_DOWN; f = 1; rbuf = 1; break;
            case 8: kind = K_GGU; f = 2; rbuf = 1; break;
            case 9: kind = K_DOWN; f = 2; rbuf = 0; break;
            case 10: kind = K_NORMT; break;
            case 11: kind = K_DFT; break;
            case 12: kind = K_FO; rbuf = 1; break;
            case 13: kind = K_GGU; f = 3; rbuf = 1; break;
            case 14: kind = K_DOWN; f = 3; rbuf = 0; break;
            default: kind = K_FINAL; break;
        }
        const int c = (int)blockIdx.x;
        if (kind == K_PREP) {
        } else if (kind == K_GGU) {
#ifndef NO_GGU
            EpiGateUp E; E.act = (bf16_t*)(p.ws + OFF_ACT); E.rss = (const float*)(p.ws + OFF_RSS);
#ifndef REP_GGU
#define REP_GGU 1
#endif
#pragma unroll 1
            for (int rep = 0; rep < REP_GGU; ++rep) {
            run_gemm(lds, (const bf16_t*)(p.ws + OFF_HB), (const bf16_t*)(p.ws + OFF_WGU) + (size_t)f * NGU * D, TPAD, NGU, D, E, c);
            if (rep + 1 < REP_GGU) grid.sync(); }
#ifdef PROBE_KLOOP
            xcd_barrier(xb); { EpiNone EN; pg8::Gemm g; g.A = (const bf16_t*)(p.ws + OFF_HB); g.Bt = (const bf16_t*)(p.ws + OFF_WGU) + (size_t)f * NGU * D; g.M = TPAD; g.N = NGU; g.K = D; g.ld = D;
#if PROBE_KLOOP == 2
              LocalOrder S;
#else
              pg8::StaticOrder S;
#endif
              S.init(TPAD, NGU, (int)gridDim.x, c); pg8::gemm_phase<EpiNone, decltype(S), false>(lds, g, S, EN, nullptr); }
#endif
#endif
        } else if (kind == K_DOWN || kind == K_APO || kind == K_FO) {
#ifndef NO_GRES
            const bf16_t* A; const bf16_t* Bt; int K; float scale;
            if (kind == K_DOWN) { A = (const bf16_t*)(p.ws + OFF_ACT); Bt = (const bf16_t*)(p.ws + OFF_WD) + (size_t)f * D * DFF; K = DFF; scale = 0.5f; }
            else if (kind == K_APO) { A = (const bf16_t*)(p.ws + OFF_AP); Bt = (const bf16_t*)(p.ws + OFF_WO); K = D; scale = 1.0f; }
            else { A = (const bf16_t*)(p.ws + OFF_X); Bt = (const bf16_t*)(p.ws + OFF_W2T); K = 2048; scale = 1.0f; }
            { EpiResid<false> E; E.out = p.out; E.ws = p.ws; E.half = (kind == K_DOWN); E.rss4 = (float*)(p.ws + OFF_RSS); E.part = (LAS float*)(lds + 131072);
              pg8::Gemm g; g.A = A; g.Bt = Bt; g.M = TPAD; g.N = D; g.K = K; g.ld = K;
              const bool split = (int)gridDim.x == 256 && K >= 2048;
              CapOrder S; S.init2(TPAD, D, (int)gridDim.x, c, split ? TAIL_L0 : (TPAD / 256) * 4);
              pg8::gemm_phase<EpiResid<false>, CapOrder, false>(lds, g, S, E, nullptr);
              if (split) {
                  const int nsl = K / 256;
                  if (c < TAIL_UNITS * nsl) { const int tu = c / nsl, sl = c - tu * nsl;
                      EpiPartial EP; EP.P = (float*)(p.ws + OFF_PART) + (size_t)(tu * 16 + sl) * 65536;
                      pg8::Gemm g2; g2.A = A + sl * 256; g2.Bt = Bt + sl * 256; g2.M = TPAD; g2.N = D; g2.K = K / nsl; g2.ld = K;
                      TailOrder S2; S2.init2(TPAD, D, tu);
                      pg8::gemm_phase<EpiPartial, TailOrder, false>(lds, g2, S2, EP, nullptr); }
                  xcd_barrier(xb);
                  tail_fixup(p.ws, nsl, kind == K_DOWN);
              } }
#endif
        } else if (kind == K_GZ) {
#ifndef NO_GZ
            EpiScale E; E.O = (bf16_t*)(p.ws + OFF_Z); E.ldc = INDIM; E.rss = (const float*)(p.ws + OFF_RSS);
            run_gemm(lds, (const bf16_t*)(p.ws + OFF_HB), (const bf16_t*)(p.ws + OFF_WIN), TPAD, INDIM, D, E, c);
#endif
        } else if (kind == K_ATTN) {
#ifndef REP_ATTN
#define REP_ATTN 1
#endif
            for (int rep = 0; rep < REP_ATTN; ++rep) { attn_phase(p, lds); if (rep + 1 < REP_ATTN) grid.sync(); }
        } else if (kind == K_NORMT) {
#ifndef REP_NORMT
#define REP_NORMT 1
#endif
            for (int rep = 0; rep < REP_NORMT; ++rep) { normT_phase(p, lds); if (rep + 1 < REP_NORMT) grid.sync(); }
        } else if (kind == K_DFT) {
#ifndef NO_GDFT
#ifndef REP_DFT
#define REP_DFT 1
#endif
#pragma unroll 1
            for (int grp = 0; grp < 2; ++grp) {
                EpiDft E; E.X = (bf16_t*)(p.ws + OFF_X); E.L = grp ? LB : LA; E.rowbase = grp ? TA : 0;
                pg8::Gemm g; g.A = (const bf16_t*)(p.ws + (grp ? OFF_D2 : OFF_D1)); g.Bt = (const bf16_t*)(p.ws + OFF_HNT) + (grp ? HNT_B : 0); g.M = grp ? MPB : MPA; g.N = (grp ? NBB : NBA) * D; g.K = grp ? LPB : LPA; g.ld = g.K;
                const bool bal = grp && (int)gridDim.x == 256;
                DftOrder S; S.init2(g.M, g.N, (int)gridDim.x, (grp && !bal) ? (int)gridDim.x - 1 - c : c, bal ? 1 : 0);
                pg8::gemm_phase<EpiDft, DftOrder, false>(lds, g, S, E, nullptr);
            }
#endif
        } else {
#ifndef NO_FINAL
            final_phase(p);
#endif
        }
#ifdef USE_CG_SYNC
        if (ph != 15) grid.sync();
#else
        if (ph != 15) xcd_barrier(xb);
#endif
    }
}

extern "C" void kernel_launch(void* const* d_in, const int* in_sizes, int n_in, void* d_out, int out_size, void* d_ws, size_t ws_size, hipStream_t stream) {
    static int grid = 0;
    if (grid == 0) {
        if (n_in != 19 || ws_size < WS_NEED) { fprintf(stderr, "kernel_launch: need 19 inputs and %zu bytes of workspace (got %d, %zu)\n", (size_t)WS_NEED, n_in, ws_size); grid = -1; return; }
        int dev = 0, cus = 0, per_cu = 0;
        hipGetDevice(&dev); hipDeviceGetAttribute(&cus, hipDeviceAttributeMultiprocessorCount, dev);
        if (hipFuncSetAttribute((const void*)mega_fwd, hipFuncAttributeMaxDynamicSharedMemorySize, LDS_BYTES) != hipSuccess) { fprintf(stderr, "kernel_launch: hipFuncSetAttribute failed\n"); grid = -1; return; }
        if (hipOccupancyMaxActiveBlocksPerMultiprocessor(&per_cu, (const void*)mega_fwd, 512, LDS_BYTES) != hipSuccess || per_cu < 1) { fprintf(stderr, "kernel_launch: occupancy query gave %d\n", per_cu); per_cu = 1; (void)hipGetLastError(); }
        grid = cus * 1;
    }
    if (grid < 0) return;
    Params p{};
    for (int i = 0; i < 19; ++i) p.in[i] = (const float*)d_in[i];
    p.out = (float*)d_out; p.ws = (unsigned char*)d_ws;
    if (hipMemsetAsync((unsigned char*)d_ws + OFF_BAR, 0, (size_t)XCD_BAR_WORDS * 4, stream) != hipSuccess) { fprintf(stderr, "kernel_launch: memset of barrier words failed\n"); return; }
    void* args[] = {&p};
    hipError_t e = hipLaunchCooperativeKernel((const void*)mega_fwd, dim3(grid), dim3(512), args, LDS_BYTES, stream);
    if (e != hipSuccess) fprintf(stderr, "cooperative launch failed: %s (grid %d)\n", hipGetErrorString(e), grid);
}
```

```cpp
#include <hip/hip_runtime.h>
#include <hip/hip_cooperative_groups.h>
#include <cstdio>
namespace cg = cooperative_groups;
#define LAS __attribute__((address_space(3)))
namespace pg8 {
#define PG8_LAS __attribute__((address_space(3)))
typedef unsigned short bf16_t;
typedef short bf16x8 __attribute__((ext_vector_type(8)));
typedef float f32x4 __attribute__((ext_vector_type(4)));
typedef unsigned u32x4 __attribute__((ext_vector_type(4)));
constexpr int BM = 256, BK = 64, HALF = 128, HTB = HALF * BK * 2  , STAGE_BYTES = 8 * HTB, NXCD = 8, WGM = 8;

__host__ __device__ __forceinline__ int lds_byte(int r, int c) { const int st = (r >> 4) * 2 + (c >> 5), rr = r & 15, cc = c & 31, ob = rr * 64 + cc * 2; return st * 1024 + (ob ^ (((ob >> 9) & 1) << 5)); }
__host__ __device__ __forceinline__ void stage_rc(int b, int& R, int& C) { const int st = b / 1024, sb = b % 1024, swz = sb ^ (((sb >> 9) & 1) << 5); R = (st >> 1) * 16 + swz / 64; C = (st & 1) * 32 + (swz % 64) / 2; }
__host__ __device__ __forceinline__ int perm32(int rho) { const int n = rho >> 4, i = rho & 15; return 8 * (i >> 2) + 4 * n + (i & 3); }

struct Unit { int pm, pn; };
struct Gemm { const bf16_t* A; const bf16_t* Bt; int M, N, K, ld; };

struct StaticOrder {
    int nM, nN, nwg, G, c;
    __host__ __device__ void init(int M, int N, int G_, int c_) { nM = M / BM; nN = N / BM; nwg = nM * nN; G = G_; c = c_; }
    __host__ __device__ bool next(int i, Unit& u) const {
        const int L = i * G + c; if (L >= nwg) return false;
        int wgid = (int)L; { const int q = nwg / NXCD, r = nwg % NXCD, xcd = wgid % NXCD, off = wgid / NXCD; wgid = (xcd < r ? xcd * (q + 1) : r * (q + 1) + (xcd - r) * q) + off; }
        const int nig = WGM * nN, gid = wgid / nig, fm = gid * WGM, gsz = (nM - fm) < WGM ? (nM - fm) : WGM;
        u.pm = fm + ((wgid % nig) % gsz); u.pn = (wgid % nig) / gsz; return true;
    }
    __device__ __forceinline__ void a_ready(const Unit&) const {}
    __device__ __forceinline__ void done(const Unit&) const {}
};
__device__ __forceinline__ unsigned cvt_pk_bf16(float lo, float hi) { unsigned r; asm volatile("v_cvt_pk_bf16_f32 %0, %1, %2" : "=v"(r) : "v"(lo), "v"(hi)); return r; }
template <class Epi, class Sched, bool STAMP = false>
__device__ __forceinline__ void gemm_phase(PG8_LAS unsigned char* lds, const Gemm g, const Sched& S, const Epi& E, unsigned long long* stamps) {
    int tid_o = threadIdx.x; asm volatile("" : "+v"(tid_o));
    const int tid = tid_o, wid = __builtin_amdgcn_readfirstlane(tid >> 6), lane = tid & 63, wr = wid >> 2, wc = wid & 3, fr = lane & 15, fq = lane >> 4;
    const int K = g.ld, nt = g.K / BK;
    int ts_lo = 0, ts_hi = 0, nts = 0; const unsigned long long rt_entry = STAMP ? (unsigned long long)wall_clock64() : 0ull;
#define PG8_STAMP() do { if (STAMP && wid == 0 && nts < 64) { const unsigned long long _c = (unsigned long long)clock64(); \
        ts_lo = (lane == nts) ? (int)(unsigned)_c : ts_lo; ts_hi = (lane == nts) ? (int)(unsigned)(_c >> 32) : ts_hi; ++nts; } } while (0)
    PG8_STAMP();
    unsigned voffA[2], voffB[2];
#pragma unroll
    for (int i = 0; i < 2; ++i) { int R, C; stage_rc(tid * 16 + i * 8192, R, C); const int Rb = Epi::PERM ? ((R & ~31) + perm32(R & 31)) : R;
        voffA[i] = (unsigned)(R * K + C) * 2u; voffB[i] = (unsigned)(Rb * K + C) * 2u; }
    const size_t kstep = (size_t)(BK * 2);
    const size_t hstep = (size_t)HALF * K * 2;
    const size_t tstep = 2 * hstep;
    const unsigned ldsw = (unsigned)wid * 1024u;
    const int aoff = lds_byte(wr * 64 + fr, fq * 8), boff = lds_byte(wc * 32 + fr, fq * 8);
#define PG8_SA(b, h) (((b) * 2 + (h)) * HTB)
#define PG8_SB(b, h) ((4 + (b) * 2 + (h)) * HTB)
#define PG8_STAGE(bufoff, gbase, voff) do { _Pragma("unroll") for (int _i = 0; _i < 2; ++_i) \
        __builtin_amdgcn_global_load_lds((const unsigned*)((const char*)(gbase) + (voff)[_i]), (PG8_LAS unsigned*)(lds + (bufoff) + ldsw + _i * 8192), 16, 0, 0); } while (0)
#define PG8_LDA(dst, b, h) do { _Pragma("unroll") for (int m = 0; m < 4; ++m) _Pragma("unroll") for (int k = 0; k < 2; ++k) dst[m][k] = *(const PG8_LAS bf16x8*)(lds + PG8_SA(b, h) + aoff + m * 2048 + k * 1024); } while (0)
#define PG8_LDB(dst, b, h) do { _Pragma("unroll") for (int n = 0; n < 2; ++n) _Pragma("unroll") for (int k = 0; k < 2; ++k) dst[n][k] = *(const PG8_LAS bf16x8*)(lds + PG8_SB(b, h) + boff + n * 2048 + k * 1024); } while (0)
#define PG8_MMA(ai, bj, At, Bt) do { __builtin_amdgcn_s_setprio(1); _Pragma("unroll") for (int m = 0; m < 4; ++m) _Pragma("unroll") for (int n = 0; n < 2; ++n) _Pragma("unroll") for (int k = 0; k < 2; ++k) \
        acc[ai][bj][m][n] = __builtin_amdgcn_mfma_f32_16x16x32_bf16(Bt[n][k], At[m][k], acc[ai][bj][m][n], 0, 0, 0); __builtin_amdgcn_s_setprio(0); } while (0)
#define PG8_WAIT_V(n) asm volatile("s_waitcnt vmcnt(" #n ")" ::: "memory")
#define PG8_WAIT_L(n) asm volatile("s_waitcnt lgkmcnt(" #n ")" ::: "memory")
#define PG8_BAR __builtin_amdgcn_s_barrier()
#define PG8_SCHED __builtin_amdgcn_sched_barrier(0)
    Unit cur, nxt; int ui = 0;
    if (!S.next(0, cur)) return;
    f32x4 acc[2][2][4][2];
#pragma unroll
    for (int a = 0; a < 2; ++a)
#pragma unroll
        for (int b = 0; b < 2; ++b)
#pragma unroll
            for (int m = 0; m < 4; ++m)
#pragma unroll
                for (int n = 0; n < 2; ++n) acc[a][b][m][n] = (f32x4){0.f, 0.f, 0.f, 0.f};
    bf16x8 At[4][2], B0[2][2], B1[2][2];
    const char* cA = (const char*)g.A + (size_t)cur.pm * tstep; const char* cB = (const char*)g.Bt + (size_t)cur.pn * tstep;
    S.a_ready(cur);
    PG8_STAGE(PG8_SB(0, 0), cB, voffB); PG8_STAGE(PG8_SA(0, 0), cA, voffA); PG8_STAGE(PG8_SB(0, 1), cB + hstep, voffB); PG8_STAGE(PG8_SA(0, 1), cA + hstep, voffA);
    if (wr == 1) PG8_BAR;
    PG8_WAIT_V(4); PG8_BAR;
    PG8_STAGE(PG8_SB(1, 0), cB + kstep, voffB); PG8_STAGE(PG8_SA(1, 0), cA + kstep, voffA); PG8_STAGE(PG8_SB(1, 1), cB + hstep + kstep, voffB);
    PG8_WAIT_V(6); PG8_BAR;
    PG8_STAMP();
    for (;;) {
        const bool has_next = S.next(ui + 1, nxt);
        const char* nA = has_next ? (const char*)g.A + (size_t)nxt.pm * tstep : cA; const char* nB = has_next ? (const char*)g.Bt + (size_t)nxt.pn * tstep : cB;
        for (int t = 0; t < nt; t += 2) {
            const bool last = (t == nt - 2);
            const char* a1 = cA + (size_t)(t + 1) * kstep;
            const char* a2 = last ? nA : cA + (size_t)(t + 2) * kstep; const char* b2 = last ? nB : cB + (size_t)(t + 2) * kstep;
            const char* a3 = a2 + kstep; const char* b3 = b2 + kstep;
            if (last && has_next) S.a_ready(nxt);
            PG8_LDB(B0, 0, 0); PG8_SCHED; PG8_LDA(At, 0, 0); PG8_STAGE(PG8_SA(1, 1), a1 + hstep, voffA);
            PG8_WAIT_L(8); PG8_BAR; PG8_WAIT_L(0); PG8_MMA(0, 0, At, B0); PG8_BAR; PG8_SCHED;
            PG8_LDB(B1, 0, 1); PG8_STAGE(PG8_SB(0, 0), b2, voffB);
            PG8_BAR; PG8_WAIT_L(0); PG8_MMA(0, 1, At, B1); PG8_BAR;
            PG8_LDA(At, 0, 1); PG8_STAGE(PG8_SA(0, 0), a2, voffA);
            PG8_BAR; PG8_WAIT_L(0); PG8_MMA(1, 0, At, B0); PG8_BAR; PG8_SCHED;
            PG8_STAGE(PG8_SB(0, 1), b2 + hstep, voffB);
            PG8_WAIT_V(6); PG8_BAR; PG8_MMA(1, 1, At, B1); PG8_BAR;
            PG8_LDB(B0, 1, 0); PG8_SCHED; PG8_LDA(At, 1, 0); PG8_STAGE(PG8_SA(0, 1), a2 + hstep, voffA);
            PG8_WAIT_L(8); PG8_BAR; PG8_WAIT_L(0); PG8_MMA(0, 0, At, B0); PG8_BAR; PG8_SCHED;
            PG8_LDB(B1, 1, 1); PG8_STAGE(PG8_SB(1, 0), b3, voffB);
            PG8_BAR; PG8_WAIT_L(0); PG8_MMA(0, 1, At, B1); PG8_BAR;
            PG8_LDA(At, 1, 1); PG8_STAGE(PG8_SA(1, 0), a3, voffA);
            PG8_BAR; PG8_WAIT_L(0); PG8_MMA(1, 0, At, B0); PG8_BAR; PG8_SCHED;
            PG8_STAGE(PG8_SB(1, 1), b3 + hstep, voffB);
            PG8_WAIT_V(6); PG8_BAR; PG8_MMA(1, 1, At, B1); PG8_BAR;
        }
        PG8_STAMP();
        if constexpr (!Epi::AFTER_DRAIN) { E(acc, cur, wr, wc, fr, fq); S.done(cur); }
        PG8_STAMP();
        if (!has_next) break;
#pragma unroll
        for (int a = 0; a < 2; ++a)
#pragma unroll
            for (int b = 0; b < 2; ++b)
#pragma unroll
                for (int m = 0; m < 4; ++m)
#pragma unroll
                    for (int n = 0; n < 2; ++n) acc[a][b][m][n] = (f32x4){0.f, 0.f, 0.f, 0.f};
        cur = nxt; cA = nA; cB = nB; ++ui;
    }
    PG8_WAIT_V(0);
    if (wr == 0) PG8_BAR;
    PG8_BAR;
    if constexpr (Epi::AFTER_DRAIN) { E.fused(acc, cur, wr, wc, fr, fq, lds, wid, lane); S.done(cur); }
    PG8_STAMP();
    if (STAMP && wid == 0) { stamps[lane] = lane < nts ? (((unsigned long long)(unsigned)ts_hi << 32) | (unsigned)ts_lo) : 0ull;
        if (lane == 62) stamps[62] = rt_entry; if (lane == 63) stamps[63] = (unsigned long long)wall_clock64(); }
#undef PG8_STAMP
#undef PG8_SA
#undef PG8_SB
#undef PG8_STAGE
#undef PG8_LDA
#undef PG8_LDB
#undef PG8_MMA
#undef PG8_WAIT_V
#undef PG8_WAIT_L
#undef PG8_BAR
#undef PG8_SCHED
}
}
#define XB_TMO      128
#define XB_XCNT(j)  (256  + 64 * (j))
#define XB_XSUB(j)  (1280 + 64 * (j))
#define XB_XGEN(j)  (2304 + 64 * (j))
#define XB_TOP      3328
#define XB_TOPGEN   3392
#define XCD_BAR_WORDS 3456
#define XB_SPIN_CAP (1u << 18)

__device__ __forceinline__ unsigned xb_ld(unsigned* p)              { return __hip_atomic_load(p, __ATOMIC_RELAXED, __HIP_MEMORY_SCOPE_AGENT); }
__device__ __forceinline__ unsigned xb_add(unsigned* p, unsigned v) { return __hip_atomic_fetch_add(p, v, __ATOMIC_RELAXED, __HIP_MEMORY_SCOPE_AGENT); }
__device__ __forceinline__ unsigned xb_xcc_id() { return (unsigned)__builtin_amdgcn_s_getreg((3 << 11) | 20) & 0xFu; }
#define XB_SPIN(cond, bar) do { unsigned _sp = 0; while (cond) { __builtin_amdgcn_s_sleep(1); \
    if ((++_sp & 255u) == 0u) { if (xb_ld(&(bar)[XB_TMO])) break; if (_sp > XB_SPIN_CAP) { atomicAdd(&(bar)[XB_TMO], 1u); break; } } } } while (0)

struct XcdBarrier {
    unsigned* bar; unsigned x;
    volatile LAS unsigned* st;
};

__device__ __forceinline__ XcdBarrier xcd_barrier_post(unsigned* bar, volatile LAS unsigned* st) {
    XcdBarrier b; b.bar = bar; b.x = xb_xcc_id(); b.st = st;
    if (threadIdx.x == 0) (void)xb_add(&bar[XB_XCNT(b.x)], 1u);
    return b;
}
__device__ __forceinline__ void xcd_barrier_complete(unsigned* bar, unsigned x, unsigned& nloc, unsigned& nx) {
    const unsigned G = gridDim.x * gridDim.y * gridDim.z;
    unsigned sum, cnt, mine, sp = 0u;
    for (;;) {
        sum = 0u; cnt = 0u; mine = 0u;
#pragma unroll
        for (unsigned j = 0; j < 16; ++j) { const unsigned c = xb_ld(&bar[XB_XCNT(j)]); sum += c; cnt += (c > 0u) ? 1u : 0u; mine = (j == x) ? c : mine; }
        if (sum == G) break;
        __builtin_amdgcn_s_sleep(1);
        if ((++sp & 255u) == 0u) { if (xb_ld(&bar[XB_TMO])) break; if (sp > XB_SPIN_CAP) { atomicAdd(&bar[XB_TMO], 1u); break; } }
    }
    nloc = mine > 0u ? mine : 1u; nx = cnt > 0u ? cnt : 1u;
}

__device__ __forceinline__ void xcd_barrier(const XcdBarrier& b) {
    asm volatile("s_waitcnt vmcnt(0)" ::: "memory");
    __syncthreads();
    if (threadIdx.x == 0) {
        unsigned* bar = b.bar;
        __builtin_amdgcn_s_waitcnt(0);
        unsigned nloc = b.st[0], nx = b.st[1];
        if (nloc == 0u) { xcd_barrier_complete(bar, b.x, nloc, nx); b.st[0] = nloc; b.st[1] = nx; }
        const unsigned old = xb_add(&bar[XB_XSUB(b.x)], 1u);
        const unsigned gen = old / nloc;
        if (old + 1u == (gen + 1u) * nloc) {
            __builtin_amdgcn_fence(__ATOMIC_RELEASE, "agent");
            asm volatile("s_waitcnt vmcnt(0)" ::: "memory");
            const unsigned og = xb_add(&bar[XB_TOP], 1u);
            const unsigned tg = og / nx;
            if (og + 1u == (tg + 1u) * nx) xb_add(&bar[XB_TOPGEN], 1u);
            else XB_SPIN(xb_ld(&bar[XB_TOPGEN]) == tg, bar);
            __builtin_amdgcn_fence(__ATOMIC_ACQUIRE, "agent");
            xb_add(&bar[XB_XGEN(b.x)], 1u);
            asm volatile("s_waitcnt vmcnt(0)" ::: "memory");
        } else {
            XB_SPIN(xb_ld(&bar[XB_XGEN(b.x)]) == gen, bar);
            __builtin_amdgcn_fence(__ATOMIC_ACQUIRE, "agent");
            asm volatile("s_waitcnt vmcnt(0)" ::: "memory");
        }
    }
    __syncthreads();
}

using pg8::bf16_t; using pg8::bf16x8; using pg8::f32x4; using pg8::u32x4; using pg8::Unit; using pg8::cvt_pk_bf16;
typedef unsigned u32x2 __attribute__((ext_vector_type(2)));
typedef float f32x2 __attribute__((ext_vector_type(2)));

#define GAS __attribute__((address_space(1)))
template <class T> __device__ __forceinline__ T gload(const T* p) { return *(const GAS T*)p; }
template <class T> __device__ __forceinline__ void gstore(T* p, const T& v) { *(GAS T*)p = v; }
constexpr int D = 1024, DFF = 2816, NGU = 5632, INDIM = 1280;
constexpr int LA = 4112, LB = 2064, NBA = 8, NBB = 32;
constexpr int TA = NBA * LA;
constexpr int T = TA + NBB * LB;
constexpr int TPAD = 99072;
constexpr int LPA = 4224, LPB = 2176;
constexpr int MPA = 4352, MPB = 2304;
constexpr int LDS_BYTES = 147456;

constexpr size_t al256(size_t x) { return (x + 255) & ~(size_t)255; }
constexpr size_t OFF_WGU = 0;
constexpr size_t OFF_WD = al256(OFF_WGU + (size_t)4 * NGU * D * 2);
constexpr size_t OFF_WIN = al256(OFF_WD + (size_t)4 * D * DFF * 2);
constexpr size_t OFF_WO = al256(OFF_WIN + (size_t)INDIM * D * 2);
constexpr size_t OFF_W2T = al256(OFF_WO + (size_t)D * D * 2);
constexpr size_t OFF_D1 = al256(OFF_W2T + (size_t)D * 2048 * 2);
constexpr size_t OFF_D2 = al256(OFF_D1 + (size_t)MPA * LPA * 2);
constexpr size_t OFF_HMETA = al256(OFF_D2 + (size_t)MPB * LPB * 2);
constexpr size_t OFF_RSS = al256(OFF_HMETA + (size_t)640 * D * 4);
constexpr size_t OFF_HB = al256(OFF_RSS + (size_t)TPAD * 16 * 4);
constexpr size_t OFF_BIG = al256(OFF_HB + (size_t)TPAD * D * 2);
constexpr size_t OFF_ACT = OFF_BIG;
constexpr size_t OFF_Z = OFF_BIG;
constexpr size_t OFF_AP = al256(OFF_Z + (size_t)TPAD * INDIM * 2);
constexpr size_t OFF_HNT = OFF_BIG;
constexpr size_t HNT_B = (size_t)NBA * D * LPA;
constexpr size_t OFF_X = al256(OFF_HNT + ((size_t)NBA * D * LPA + (size_t)NBB * D * LPB) * 2);
constexpr size_t OFF_SMALL = al256(OFF_X + (size_t)TPAD * 2048 * 2);
constexpr size_t OFF_BAR = al256(OFF_SMALL + 3072 * 4);
constexpr size_t OFF_PART = al256(OFF_BAR + (size_t)XCD_BAR_WORDS * 4);
constexpr size_t WS_NEED = al256(OFF_PART + (size_t)12 * 16 * 256 * 256 * 4);
static_assert(OFF_AP + (size_t)TPAD * D * 2 <= WS_NEED && OFF_ACT + (size_t)TPAD * DFF * 2 <= WS_NEED, "big region");

struct Params { const float* in[19]; float* out; unsigned char* ws; };

__device__ __forceinline__ void row_decode(int r, int& gb, int& l, int& L, int& rb) {
    if (r < TA) { gb = r / LA; l = r - gb * LA; L = LA; rb = gb * LA; }
    else { const int q = r - TA, b = q / LB; l = q - b * LB; gb = NBA + b; L = LB; rb = TA + b * LB; }
}
__device__ __forceinline__ float* hptr2(float* out, unsigned char* ws, int r) {
    int gb, l, L, rb; row_decode(r, gb, l, L, rb);
    if (l < 16) return (float*)(ws + OFF_HMETA) + (size_t)(gb * 16 + l) * D;
    return out + (size_t)(r - 16 * (gb + 1)) * D;
}
__device__ __forceinline__ float* hptr(const Params& p, int r) {
    int gb, l, L, rb; row_decode(r, gb, l, L, rb);
    if (l < 16) return (float*)(p.ws + OFF_HMETA) + (size_t)(gb * 16 + l) * D;
    return p.out + (size_t)(r - 16 * (gb + 1)) * D;
}
__device__ __forceinline__ int otid() { int t = threadIdx.x; asm volatile("" : "+v"(t)); return t; }
__device__ __forceinline__ bf16_t f2bf(float f) { unsigned u = __float_as_uint(f); u += 0x7FFFu + ((u >> 16) & 1u); return (bf16_t)(u >> 16); }
__device__ __forceinline__ float bflo(unsigned w) { return __uint_as_float(w << 16); }
__device__ __forceinline__ float bfhi(unsigned w) { return __uint_as_float(w & 0xFFFF0000u); }
__device__ __forceinline__ float wave_sum(float v) {
#pragma unroll
    for (int o = 1; o < 64; o <<= 1) v += __shfl_xor(v, o);
    return v;
}
__device__ __forceinline__ float rstd_of(float ss) { return __builtin_amdgcn_rsqf(ss * (1.0f / 1024.0f) + 1e-6f); }

struct EpiGateUp {
    static constexpr bool PERM = true, AFTER_DRAIN = false;
    bf16_t* act; const float* rss;
    __device__ __forceinline__ void operator()(const f32x4 (&acc)[2][2][4][2], const Unit& u, int wr, int wc, int fr, int fq) const {
        const int col = u.pn * 128 + wc * 32 + fq * 8;
        float rsc[2][4];
#pragma unroll
        for (int ai = 0; ai < 2; ++ai)
#pragma unroll
            for (int m = 0; m < 4; ++m) { const int r = u.pm * 256 + ai * 128 + wr * 64 + m * 16 + fr; const f32x4 q4 = gload((const f32x4*)(rss + (size_t)min(r, T - 1) * 4)); rsc[ai][m] = (q4[0] + q4[1]) + (q4[2] + q4[3]); }
#pragma unroll
        for (int ai = 0; ai < 2; ++ai)
#pragma unroll
            for (int m = 0; m < 4; ++m) rsc[ai][m] = rstd_of(rsc[ai][m]);
#pragma unroll
        for (int ai = 0; ai < 2; ++ai)
#pragma unroll
            for (int m = 0; m < 4; ++m) {
                const int r = u.pm * 256 + ai * 128 + wr * 64 + m * 16 + fr;
                const float rs = rsc[ai][m]; const f32x2 rs2 = {rs * rs, rs * rs}, nrl = {rs * -1.4426950408889634f, rs * -1.4426950408889634f}, one = {1.0f, 1.0f};
                unsigned w[4];
#pragma unroll
                for (int n = 0; n < 2; ++n)
#pragma unroll
                    for (int e = 0; e < 4; e += 2) {
                        const f32x2 g = {acc[ai][0][m][n][e], acc[ai][0][m][n][e + 1]}, uu = {acc[ai][1][m][n][e], acc[ai][1][m][n][e + 1]};
                        const f32x2 t = g * nrl; f32x2 ex; ex.x = __builtin_amdgcn_exp2f(t.x); ex.y = __builtin_amdgcn_exp2f(t.y);
                        const f32x2 dn = ex + one; f32x2 rc; rc.x = __builtin_amdgcn_rcpf(dn.x); rc.y = __builtin_amdgcn_rcpf(dn.y);
                        const f32x2 o2 = ((g * uu) * rs2) * rc;
                        w[n * 2 + (e >> 1)] = cvt_pk_bf16(o2.x, o2.y);
                    }
                u32x4 o; o.x = w[0]; o.y = w[1]; o.z = w[2]; o.w = w[3];
                if (r < T) gstore((u32x4*)(act + (size_t)r * DFF + col), o);
            }
    }
};
struct EpiScale {
    static constexpr bool PERM = true, AFTER_DRAIN = false;
    bf16_t* O; int ldc; const float* rss;
    __device__ __forceinline__ void operator()(const f32x4 (&acc)[2][2][4][2], const Unit& u, int wr, int wc, int fr, int fq) const {
        const int col = u.pn * 256 + wc * 32 + fq * 8;
        float rsv[2][4];
#pragma unroll
        for (int ai = 0; ai < 2; ++ai)
#pragma unroll
            for (int m = 0; m < 4; ++m) { const int r = u.pm * 256 + ai * 128 + wr * 64 + m * 16 + fr; { const f32x4 q4 = gload((const f32x4*)(rss + (size_t)min(r, T - 1) * 4)); rsv[ai][m] = (q4[0] + q4[1]) + (q4[2] + q4[3]); } }
#pragma unroll
        for (int ai = 0; ai < 2; ++ai)
#pragma unroll
            for (int m = 0; m < 4; ++m) {
                const int r = u.pm * 256 + ai * 128 + wr * 64 + m * 16 + fr;
                const float rs = rstd_of(rsv[ai][m]);
                if (r < T) {
#pragma unroll
                    for (int bj = 0; bj < 2; ++bj) {
                        const f32x4 v0 = acc[ai][bj][m][0] * rs, v1 = acc[ai][bj][m][1] * rs;
                        u32x4 o; o.x = cvt_pk_bf16(v0[0], v0[1]); o.y = cvt_pk_bf16(v0[2], v0[3]); o.z = cvt_pk_bf16(v1[0], v1[1]); o.w = cvt_pk_bf16(v1[2], v1[3]);
                        gstore((u32x4*)(O + (size_t)r * ldc + col + bj * 128), o);
                    }
                }
            }
    }
};
struct EpiNone {
    static constexpr bool PERM = true, AFTER_DRAIN = false;
    __device__ __forceinline__ void operator()(const f32x4 (&acc)[2][2][4][2], const Unit& u, int wr, int wc, int fr, int fq) const {
#pragma unroll
        for (int ai = 0; ai < 2; ++ai)
#pragma unroll
            for (int bj = 0; bj < 2; ++bj)
#pragma unroll
                for (int m = 0; m < 4; ++m)
#pragma unroll
                    for (int n = 0; n < 2; ++n) asm volatile("" :: "v"(acc[ai][bj][m][n]));
    }
};
template <bool LAST> struct EpiResid {
    static constexpr bool PERM = true, AFTER_DRAIN = false;
    float* out; unsigned char* ws; int half; float* rss4; LAS float* part;
    __device__ __forceinline__ void operator()(const f32x4 (&acc)[2][2][4][2], const Unit& u, int wr, int wc, int fr, int fq) const {
        const int col = u.pn * 256 + wc * 32 + fq * 8;
        bf16_t* hb = (bf16_t*)(ws + OFF_HB);
        u32x4 hv[2][4][2];
#pragma unroll
        for (int ai = 0; ai < 2; ++ai)
#pragma unroll
            for (int m = 0; m < 4; ++m) { const int r = u.pm * 256 + ai * 128 + wr * 64 + m * 16 + fr; const bf16_t* hp = hb + (size_t)min(r, T - 1) * D + col;
#pragma unroll
                for (int bj = 0; bj < 2; ++bj) hv[ai][m][bj] = gload((const u32x4*)(hp + bj * 128)); }
#pragma unroll
        for (int ai = 0; ai < 2; ++ai)
#pragma unroll
            for (int m = 0; m < 4; ++m) {
                const int r = u.pm * 256 + ai * 128 + wr * 64 + m * 16 + fr;
                f32x2 ss2 = {0.f, 0.f}; const float scale = half ? 0.5f : 1.0f; const f32x2 sc2 = {scale, scale};
#pragma unroll
                for (int bj = 0; bj < 2; ++bj) {
                    const u32x4 w = hv[ai][m][bj]; const f32x4 a0 = acc[ai][bj][m][0], a1 = acc[ai][bj][m][1];
                    f32x2 p0 = {bflo(w.x), bfhi(w.x)}, p1 = {bflo(w.y), bfhi(w.y)}, p2 = {bflo(w.z), bfhi(w.z)}, p3 = {bflo(w.w), bfhi(w.w)};
                    p0 += (f32x2){a0[0], a0[1]} * sc2; p1 += (f32x2){a0[2], a0[3]} * sc2; p2 += (f32x2){a1[0], a1[1]} * sc2; p3 += (f32x2){a1[2], a1[3]} * sc2;
                    ss2 += p0 * p0; ss2 += p1 * p1; ss2 += p2 * p2; ss2 += p3 * p3;
                    if (r < T) {
                        u32x4 o; o.x = cvt_pk_bf16(p0.x, p0.y); o.y = cvt_pk_bf16(p1.x, p1.y); o.z = cvt_pk_bf16(p2.x, p2.y); o.w = cvt_pk_bf16(p3.x, p3.y);
                        gstore((u32x4*)(hb + (size_t)r * D + col + bj * 128), o);
                    }
                }
                float ss = ss2.x + ss2.y;
                ss += __shfl_xor(ss, 16); ss += __shfl_xor(ss, 32);
                if (fq == 0) part[(ai * 128 + wr * 64 + m * 16 + fr) * 4 + wc] = ss;
            }
        asm volatile("s_waitcnt lgkmcnt(0)" ::: "memory"); __builtin_amdgcn_s_barrier(); asm volatile("" ::: "memory");
        const int lane = fq * 16 + fr;
        if (lane < 32) { const int rl = (lane >> 4) * 128 + wr * 64 + wc * 16 + (lane & 15), r = u.pm * 256 + rl;
            const f32x4 v = *(const LAS f32x4*)(part + rl * 4);
            if (r < T) gstore(rss4 + (size_t)r * 4 + u.pn, (v[0] + v[1]) + (v[2] + v[3])); }
    }
};
struct EpiDft {
    static constexpr bool PERM = true, AFTER_DRAIN = false;
    bf16_t* X; int L, rowbase;
    __device__ __forceinline__ void operator()(const f32x4 (&acc)[2][2][4][2], const Unit& u, int wr, int wc, int fr, int fq) const {
        const int b = u.pn >> 2, c0 = (u.pn & 3) * 256 + wc * 32 + fq * 8, H = L >> 1;
#pragma unroll
        for (int ai = 0; ai < 2; ++ai)
#pragma unroll
            for (int m = 0; m < 4; ++m) {
                const int kk = u.pm * 256 + ai * 128 + wr * 64 + m * 16 + fr;
                if (kk < L) {
                    const bool isc = kk <= H; const int k = isc ? kk : kk - H; const float sg = isc ? 1.f : -1.f;
                    bf16_t* x0 = X + (size_t)(rowbase + b * L + k) * 2048 + (isc ? 0 : 1024) + c0;
                    bf16_t* x1 = X + (size_t)(rowbase + b * L + (L - k)) * 2048 + (isc ? 0 : 1024) + c0;
                    const bool mir = (k >= 1) && (k < H);
#pragma unroll
                    for (int bj = 0; bj < 2; ++bj) {
                        const f32x4 v0 = acc[ai][bj][m][0] * sg, v1 = acc[ai][bj][m][1] * sg;
                        u32x4 o; o.x = cvt_pk_bf16(v0[0], v0[1]); o.y = cvt_pk_bf16(v0[2], v0[3]); o.z = cvt_pk_bf16(v1[0], v1[1]); o.w = cvt_pk_bf16(v1[2], v1[3]);
                        gstore((u32x4*)(x0 + bj * 128), o);
                        if (mir) { u32x4 q; if (isc) q = o; else { q.x = o.x ^ 0x80008000u; q.y = o.y ^ 0x80008000u; q.z = o.z ^ 0x80008000u; q.w = o.w ^ 0x80008000u; } gstore((u32x4*)(x1 + bj * 128), q); }
                        if (isc && !mir) { u32x4 zz; zz.x = 0; zz.y = 0; zz.z = 0; zz.w = 0; gstore((u32x4*)(x0 + 1024 + bj * 128), zz); }
                    }
                }
            }
    }
};

struct DftOrder : pg8::StaticOrder {
    int cc, GG, mode;
    __device__ void init2(int M, int N, int G_, int c_, int mode_) { init(M, N, 1, 0); cc = c_; GG = G_; mode = mode_; }
    __device__ bool next(int i, Unit& u) const { int L;
        if (mode == 0) { L = i * GG + cc; if (L >= nwg) return false; }
        else if (cc < 32) { if (i >= 3) return false; L = 1056 + cc * 3 + i; }
        else { const int d = cc - 32; if (i < 4) L = i * 224 + d; else if (i == 4 && d < 160) L = 896 + d; else return false; }
        return pg8::StaticOrder::next(L, u); }
};
constexpr int TAIL_L0 = 6 * 256, TAIL_UNITS = (TPAD / 256) * 4 - TAIL_L0;
struct CapOrder : pg8::StaticOrder {
    int cc, GG, cap;
    __device__ void init2(int M, int N, int G_, int c_, int cap_) { init(M, N, 1, 0); cc = c_; GG = G_; cap = cap_; }
    __device__ bool next(int i, Unit& u) const { const int L = i * GG + cc; if (L >= cap) return false; return pg8::StaticOrder::next(L, u); }
};
struct TailOrder : pg8::StaticOrder {
    int tu;
    __device__ void init2(int M, int N, int tu_) { init(M, N, 1, 0); tu = tu_; }
    __device__ bool next(int i, Unit& u) const { if (i != 0) return false; return pg8::StaticOrder::next(TAIL_L0 + tu, u); }
};
struct EpiPartial {
    static constexpr bool PERM = true, AFTER_DRAIN = false;
    float* P;
    __device__ __forceinline__ void operator()(const f32x4 (&acc)[2][2][4][2], const Unit& u, int wr, int wc, int fr, int fq) const {
#pragma unroll
        for (int ai = 0; ai < 2; ++ai)
#pragma unroll
            for (int m = 0; m < 4; ++m) { float* rowp = P + (size_t)(ai * 128 + wr * 64 + m * 16 + fr) * 256 + wc * 32 + fq * 8;
#pragma unroll
                for (int bj = 0; bj < 2; ++bj) { gstore((f32x4*)(rowp + bj * 128), acc[ai][bj][m][0]); gstore((f32x4*)(rowp + bj * 128 + 4), acc[ai][bj][m][1]); } }
    }
};
__device__ __forceinline__ void tail_fixup(unsigned char* ws, int nsl, int half) {
    const float scale = half ? 0.5f : 1.0f;
    const int tid = otid(), lane = tid & 63, gw = blockIdx.x * 8 + (tid >> 6), NGW = gridDim.x * 8;
    bf16_t* hb = (bf16_t*)(ws + OFF_HB); float* rss4 = (float*)(ws + OFF_RSS); const float* P0 = (const float*)(ws + OFF_PART);
    pg8::StaticOrder so; so.init(TPAD, D, 1, 0);
    for (int it = gw; it < TAIL_UNITS * 256; it += NGW) {
        const int tu = it >> 8, rl = it & 255; Unit u; so.next(TAIL_L0 + tu, u);
        const int r = u.pm * 256 + rl, col = u.pn * 256 + lane * 4;
        f32x4 a = {0.f, 0.f, 0.f, 0.f};
        f32x4 pv[11];
#pragma unroll
        for (int sl = 0; sl < 11; ++sl) pv[sl] = *(const f32x4*)(P0 + ((size_t)(tu * 16 + min(sl, nsl - 1)) * 256 + rl) * 256 + lane * 4);
#pragma unroll
        for (int sl = 0; sl < 11; ++sl) { const float m = sl < nsl ? 1.0f : 0.0f; a += pv[sl] * m; }
        float ss = 0.f;
        if (r < T) { const u32x2 w = *(const u32x2*)(hb + (size_t)r * D + col);
            f32x4 h; h[0] = bflo(w.x); h[1] = bfhi(w.x); h[2] = bflo(w.y); h[3] = bfhi(w.y); h += a * scale;
            ss = (h[0] * h[0] + h[1] * h[1]) + (h[2] * h[2] + h[3] * h[3]);
            u32x2 o; o.x = cvt_pk_bf16(h[0], h[1]); o.y = cvt_pk_bf16(h[2], h[3]); *(u32x2*)(hb + (size_t)r * D + col) = o; }
        ss = wave_sum(ss);
        if (lane == 0 && r < T) rss4[(size_t)r * 4 + u.pn] = ss;
    }
}
struct LocalOrder : pg8::StaticOrder { __device__ bool next(int i, Unit& u) const { const bool ok = pg8::StaticOrder::next(i, u); u.pm &= 7; return ok; } };
template <class Epi>
__device__ __forceinline__ void run_gemm(LAS unsigned char* lds, const bf16_t* A, const bf16_t* Bt, int M, int N, int K, const Epi& E, int c) {
    pg8::Gemm g; g.A = A; g.Bt = Bt; g.M = M; g.N = N; g.K = K; g.ld = K;
    pg8::StaticOrder S; S.init(M, N, (int)gridDim.x, c);
    pg8::gemm_phase<Epi, pg8::StaticOrder, false>(lds, g, S, E, nullptr);
}

__device__ __forceinline__ void transpose_item(const float* W, int N, const float* gain, bf16_t* WT, int ldd, int k0, int n0, int drow0, LAS float* scr, int lane, float osc = 1.0f) {
#pragma unroll
    for (int i = 0; i < 32; ++i) { const int kk = 2 * i + (lane >> 5); f32x2 v = *(const f32x2*)(W + (size_t)(k0 + kk) * N + n0 + 2 * (lane & 31)); if (gain) v *= gain[k0 + kk] * osc; *(LAS f32x2*)(scr + kk * 66 + 2 * (lane & 31)) = v; }
    asm volatile("s_waitcnt lgkmcnt(0)" ::: "memory");
    const int c = lane & 7;
#pragma unroll
    for (int jj = 0; jj < 8; ++jj) { const int n = (lane >> 3) + 8 * jj; const LAS float* sp = scr + (8 * c) * 66 + n;
        u32x4 o; o.x = cvt_pk_bf16(sp[0 * 66], sp[1 * 66]); o.y = cvt_pk_bf16(sp[2 * 66], sp[3 * 66]); o.z = cvt_pk_bf16(sp[4 * 66], sp[5 * 66]); o.w = cvt_pk_bf16(sp[6 * 66], sp[7 * 66]);
        *(u32x4*)(WT + (size_t)(drow0 + n) * ldd + k0 + 8 * c) = o; }
    asm volatile("s_waitcnt lgkmcnt(0)" ::: "memory");
}
__device__ __forceinline__ void dft_item(bf16_t* Dm, int L, int LP, int witem, int lane) {
    const int cpr = LP >> 3, H = L >> 1; const int tix = witem * 64 + lane; const int kk = tix / cpr, c8 = tix - kk * cpr;
    const bool isc = kk <= H; const int k = isc ? kk : kk - H;
    const float sc = rsqrtf((float)L), invL = 1.0f / (float)L;
    int mm = (k * (c8 * 8)) % L;
    unsigned w[4];
#pragma unroll
    for (int e = 0; e < 8; e += 2) {
        float v[2];
#pragma unroll
        for (int q = 0; q < 2; ++q) { const int n = c8 * 8 + e + q; const float a = (float)mm * invL;
            const float x = (isc ? __builtin_amdgcn_cosf(a) : __builtin_amdgcn_sinf(a)) * sc;
            v[q] = (kk < L && n < L) ? x : 0.f;
            mm += k; mm = mm >= L ? mm - L : mm; }
        w[e >> 1] = cvt_pk_bf16(v[0], v[1]);
    }
    u32x4 o; o.x = w[0]; o.y = w[1]; o.z = w[2]; o.w = w[3];
    *(u32x4*)(Dm + (size_t)kk * LP + c8 * 8) = o;
}
__device__ __forceinline__ void prep_phase(const Params& p, LAS unsigned char* lds) {
    const int tid = otid(), lane = tid & 63, wave = __builtin_amdgcn_readfirstlane(tid >> 6);
    const int gw = blockIdx.x * 8 + wave, NGW = gridDim.x * 8;
    LAS float* scr = (LAS float*)(lds + wave * 16896);
    LAS float* tab = (LAS float*)(lds + 8 * 16896);
    if (tid < 256) { tab[tid] = cospif((float)tid * (1.0f / 128.0f)); tab[256 + tid] = sinpif((float)tid * (1.0f / 128.0f)); }
    __syncthreads();
    if (blockIdx.x == 0) { float* sm = (float*)(p.ws + OFF_SMALL); if (tid < 8) sm[tid] = p.in[9][tid]; for (int i = tid; i < 1024; i += 512) { sm[1024 + i] = p.in[7][D + i]; sm[2048 + i] = p.in[18][i]; } }
    bf16_t* Wgu = (bf16_t*)(p.ws + OFF_WGU); bf16_t* Wd = (bf16_t*)(p.ws + OFF_WD); bf16_t* Win = (bf16_t*)(p.ws + OFF_WIN);
    bf16_t* Wo = (bf16_t*)(p.ws + OFF_WO); bf16_t* W2t = (bf16_t*)(p.ws + OFF_W2T);
    constexpr int I_G = 16 * 44, I_D = 44 * 16;
    constexpr int N_TR_FFN = 4 * (2 * I_G + I_D);
    constexpr int I_IN = 16 * 20, I_WO = 8 * 16;
    constexpr int R0 = N_TR_FFN, R1 = R0 + I_IN, R2 = R1 + I_WO;
    constexpr int N_W3 = 256 * 8, N_W2 = 128 * 32;
    constexpr int R3 = R2 + N_W3, R4 = R3 + N_W2;
    constexpr int N_D1 = MPA * (LPA / 8) / 64, N_D2 = MPB * (LPB / 8) / 64;
    constexpr int R5 = R4 + N_D1, R6 = R5 + N_D2, R7 = R6 + T / 2;
    for (int it = gw; it < R7; it += NGW) {
        if (it < R0) {
            const int f = it / (2 * I_G + I_D); int r = it - f * (2 * I_G + I_D); const int layer = f >> 1, which = f & 1;
            if (r < 2 * I_G) { const int up = r >= I_G; if (up) r -= I_G;
                const float* src = p.in[which ? (up ? 16 : 15) : (up ? 5 : 4)] + (size_t)layer * D * DFF;
                const float* gain = p.in[which ? 14 : 3] + layer * D;
                const int kb = r / 44, nb = r - kb * 44, n0 = nb * 64;
                const int drow0 = (n0 >> 7) * 256 + (up ? 128 : 0) + (n0 & 127);
                transpose_item(src, DFF, gain, Wgu + (size_t)f * NGU * D, D, kb * 64, n0, drow0, scr, lane);
            } else { r -= 2 * I_G;
                const float* src = p.in[which ? 17 : 6] + (size_t)layer * DFF * D;
                const int kb = r / 16, nb = r - kb * 16;
                transpose_item(src, D, nullptr, Wd + (size_t)f * D * DFF, DFF, kb * 64, nb * 64, nb * 64, scr, lane);
            }
        } else if (it < R1) { const int r = it - R0, kb = r / 20, nb = r - kb * 20;
            transpose_item(p.in[8], INDIM, p.in[7], Win, D, kb * 64, nb * 64, nb * 64, scr, lane, nb < 8 ? 0.125f : 1.0f);
        } else if (it < R2) { const int r = it - R1, kb = r / 16, nb = r - kb * 16;
            transpose_item(p.in[12], D, nullptr, Wo, D, kb * 64, nb * 64, nb * 64, scr, lane);
        } else if (it < R3) {
            const int r = it - R2, j = (r & 255) * 4, kb = r >> 8, kk = kb * 64 + lane, g = kk >> 7, c = kk & 127;
            const float* pw = p.in[10] + (size_t)(g * 128 + c) * 128; const float* ps = p.in[11] + g * 128; const float* wo = p.in[12] + (size_t)(512 + g * 128) * D + j;
            f32x4 a = {0.f, 0.f, 0.f, 0.f};
#pragma unroll 16
            for (int d = 0; d < 128; ++d) { const f32x4 w = *(const f32x4*)(wo + (size_t)d * D); a += w * (pw[d] * ps[d]); }
#pragma unroll
            for (int q = 0; q < 4; ++q) Wo[(size_t)(j + q) * D + 512 + kk] = f2bf(a[q]);
        } else if (it < R4) {
            const int r = it - R3, j = (r & 127) * 8, kb = r >> 7, kk = kb * 64 + lane, part = kk >> 10, k2 = kk & 1023, g = k2 >> 8, c = k2 & 255;
            const float* wf = p.in[13] + (size_t)(g * 256) * D + j; const LAS float* tb = tab + part * 256;
            f32x4 a0 = {0.f, 0.f, 0.f, 0.f}, a1 = {0.f, 0.f, 0.f, 0.f};
#pragma unroll 8
            for (int d = 0; d < 256; ++d) { const f32x4 w0 = *(const f32x4*)(wf + (size_t)d * D), w1 = *(const f32x4*)(wf + (size_t)d * D + 4); const float t = tb[(c * d) & 255]; a0 += w0 * t; a1 += w1 * t; }
#pragma unroll
            for (int q = 0; q < 4; ++q) { W2t[(size_t)(j + q) * 2048 + kk] = f2bf(a0[q] * 0.0625f); W2t[(size_t)(j + 4 + q) * 2048 + kk] = f2bf(a1[q] * 0.0625f); }
        } else if (it < R5) { dft_item((bf16_t*)(p.ws + OFF_D1), LA, LPA, it - R4, lane);
        } else if (it < R6) { dft_item((bf16_t*)(p.ws + OFF_D2), LB, LPB, it - R5, lane);
        } else {
            const int r0 = (it - R6) * 2; const float* src[2]; f32x4 v[2][4];
#pragma unroll
            for (int q = 0; q < 2; ++q) { int gb, l, L, rb; row_decode(r0 + q, gb, l, L, rb);
                src[q] = (l < 16) ? p.in[2] + (size_t)l * D : (gb < NBA ? p.in[0] + ((size_t)gb * 4096 + (l - 16)) * D : p.in[1] + ((size_t)(gb - NBA) * 2048 + (l - 16)) * D); }
#pragma unroll
            for (int q = 0; q < 2; ++q)
#pragma unroll
                for (int i = 0; i < 4; ++i) v[q][i] = *(const f32x4*)(src[q] + (lane + 64 * i) * 4);
            float* rss0 = (float*)(p.ws + OFF_RSS);
#pragma unroll
            for (int q = 0; q < 2; ++q) { bf16_t* hb = (bf16_t*)(p.ws + OFF_HB) + (size_t)(r0 + q) * D; float ss = 0.f;
#pragma unroll
                for (int i = 0; i < 4; ++i) { ss += (v[q][i][0] * v[q][i][0] + v[q][i][1] * v[q][i][1]) + (v[q][i][2] * v[q][i][2] + v[q][i][3] * v[q][i][3]);
                    u32x2 o; o.x = cvt_pk_bf16(v[q][i][0], v[q][i][1]); o.y = cvt_pk_bf16(v[q][i][2], v[q][i][3]); *(u32x2*)(hb + (lane + 64 * i) * 4) = o; }
                ss = wave_sum(ss);
                if (lane == 0) { f32x4 q4 = {ss, 0.f, 0.f, 0.f}; *(f32x4*)(rss0 + (size_t)(r0 + q) * 4) = q4; } }
        }
    }
}

template <int HW> __device__ __forceinline__ void pool_item(const bf16_t* z, bf16_t* ap, int r, int ch) {
    int gb, l, L, rb; row_decode(r, gb, l, L, rb);
    const bf16_t* base = z + (size_t)r * INDIM + 768 + ch * 8;
    u32x4 v[2 * HW + 1];
#pragma unroll
    for (int o = 0; o <= 2 * HW; ++o) { const int s = l - HW + o; u32x4 t; t.x = 0; t.y = 0; t.z = 0; t.w = 0; if (s >= 0 && s < L) t = gload((const u32x4*)(base + (long)(o - HW) * INDIM)); v[o] = t; }
    float s0 = 0.f, s1 = 0.f, s2 = 0.f, s3 = 0.f, s4 = 0.f, s5 = 0.f, s6 = 0.f, s7 = 0.f;
#pragma unroll
    for (int o = 1; o < 2 * HW; ++o) { s0 += bflo(v[o].x); s1 += bfhi(v[o].x); s2 += bflo(v[o].y); s3 += bfhi(v[o].y); s4 += bflo(v[o].z); s5 += bfhi(v[o].z); s6 += bflo(v[o].w); s7 += bfhi(v[o].w); }
#pragma unroll
    for (int q = 0; q < 2; ++q) {
        const u32x4 ex = v[q ? 2 * HW : 0], me = v[HW + q]; const int lq = l + q;
        const float ic = 1.0f / (float)(min(lq + HW, L) - max(lq - HW, 0));
        u32x4 o; o.x = cvt_pk_bf16((s0 + bflo(ex.x)) * ic - bflo(me.x), (s1 + bfhi(ex.x)) * ic - bfhi(me.x)); o.y = cvt_pk_bf16((s2 + bflo(ex.y)) * ic - bflo(me.y), (s3 + bfhi(ex.y)) * ic - bfhi(me.y));
        o.z = cvt_pk_bf16((s4 + bflo(ex.z)) * ic - bflo(me.z), (s5 + bfhi(ex.z)) * ic - bfhi(me.z)); o.w = cvt_pk_bf16((s6 + bflo(ex.w)) * ic - bflo(me.w), (s7 + bfhi(ex.w)) * ic - bfhi(me.w));
        gstore((u32x4*)(ap + (size_t)(r + q) * D + 512 + ch * 8), o);
    }
}
struct PW { unsigned char* ws; float* out; };
__device__ __forceinline__ void attn_phase(const PW& p, LAS unsigned char* lds) {
    const bf16_t* z = (const bf16_t*)(p.ws + OFF_Z); bf16_t* ap = (bf16_t*)(p.ws + OFF_AP); const float* sink = (const float*)(p.ws + OFF_SMALL);
    const int tid = otid(), lane = tid & 63, wave = __builtin_amdgcn_readfirstlane(tid >> 6), fr = lane & 15, fq = lane >> 4;
    LAS unsigned char* Ks = lds;
    LAS unsigned char* Vt = lds + 55296;
    constexpr int NU = (NBA * 33 + NBB * 17) * 2;
    for (int unit = blockIdx.x; unit < NU; unit += gridDim.x) {
        const int kvh = unit & 1; int tt = unit >> 1; int sb, ti, L, rb;
        if (tt < NBA * 33) { sb = tt / 33; ti = tt - sb * 33; L = LA; rb = sb * LA; } else { tt -= NBA * 33; sb = tt / 17; ti = tt - sb * 17; L = LB; rb = TA + sb * LB; }
        const int l0 = ti * 128;
        __syncthreads();
        {
            typedef __attribute__((address_space(1))) const u32x4 gu32x4;
            u32x4 kreg[6], vreg[7];
#pragma unroll
            for (int i = 0; i < 6; ++i) { const int idx = tid + 512 * i, j = idx >> 3, ch = idx & 7, s = l0 - 128 + j; const bool ok = (s >= 0) && (s < L);
                kreg[i] = *(gu32x4*)(z + (size_t)(rb + (ok ? s : 0)) * INDIM + 512 + kvh * 64 + ch * 8); }
#pragma unroll
            for (int i = 0; i < 7; ++i) { const int idx = tid + 512 * i, ch = min(idx / 400, 7), j = idx - (idx / 400) * 400, s = l0 - 128 + j; const bool ok = (idx < 3200) && (j < 384) && (s >= 0) && (s < L);
                vreg[i] = *(gu32x4*)(z + (size_t)(rb + (ok ? s : 0)) * INDIM + 640 + kvh * 64 + ch * 8); }
            __builtin_amdgcn_sched_barrier(0);
#pragma unroll
            for (int i = 0; i < 6; ++i) { const int idx = tid + 512 * i, j = idx >> 3, s = l0 - 128 + j; const bool ok = (s >= 0) && (s < L);
                kreg[i].x = ok ? kreg[i].x : 0u; kreg[i].y = ok ? kreg[i].y : 0u; kreg[i].z = ok ? kreg[i].z : 0u; kreg[i].w = ok ? kreg[i].w : 0u; }
#pragma unroll
            for (int i = 0; i < 7; ++i) { const int idx = tid + 512 * i, j = idx - (idx / 400) * 400, s = l0 - 128 + j; const bool ok = (idx < 3200) && (j < 384) && (s >= 0) && (s < L);
                vreg[i].x = ok ? vreg[i].x : 0u; vreg[i].y = ok ? vreg[i].y : 0u; vreg[i].z = ok ? vreg[i].z : 0u; vreg[i].w = ok ? vreg[i].w : 0u; }
#pragma unroll
            for (int i = 0; i < 6; ++i) { const int idx = tid + 512 * i, j = idx >> 3, ch = idx & 7; *(LAS u32x4*)(Ks + j * 144 + ch * 16) = kreg[i]; }
#pragma unroll
            for (int i = 0; i < 7; ++i) { const int idx = tid + 512 * i; if (idx < 3200) { const int ch = idx / 400, j = idx - ch * 400; const u32x4 v = vreg[i];
                LAS bf16_t* dst = (LAS bf16_t*)Vt + (ch * 8) * 408 + j;
                dst[0 * 408] = (bf16_t)(v.x & 0xFFFFu); dst[1 * 408] = (bf16_t)(v.x >> 16); dst[2 * 408] = (bf16_t)(v.y & 0xFFFFu); dst[3 * 408] = (bf16_t)(v.y >> 16);
                dst[4 * 408] = (bf16_t)(v.z & 0xFFFFu); dst[5 * 408] = (bf16_t)(v.z >> 16); dst[6 * 408] = (bf16_t)(v.w & 0xFFFFu); dst[7 * 408] = (bf16_t)(v.w >> 16); } }
        }
        __syncthreads();
        const int lq0 = l0 + 16 * wave + fr;
        if (l0 + 16 * wave < L) {
#pragma unroll 1
            for (int g = 0; g < 4; ++g) {
                int lq = lq0; asm volatile("" : "+v"(lq)); const bool qok = lq < L;
                const int h = kvh * 4 + g; const float slope = exp2f(-(float)(h + 1)); const float sk = gload(sink + h);
                bf16x8 qf[2];
#pragma unroll
                for (int kk = 0; kk < 2; ++kk) { u32x4 q; q.x = 0; q.y = 0; q.z = 0; q.w = 0; if (qok) q = gload((const u32x4*)(z + (size_t)(rb + lq) * INDIM + h * 64 + kk * 32 + fq * 8)); qf[kk] = __builtin_bit_cast(bf16x8, q); }
                f32x4 sc[17];
#pragma unroll
                for (int t = 0; t < 17; ++t) { f32x4 a = {0.f, 0.f, 0.f, 0.f};
#pragma unroll
                    for (int kk = 0; kk < 2; ++kk) { const bf16x8 kf = *(const LAS bf16x8*)(Ks + (16 * wave + 16 * t + fr) * 144 + (kk * 32 + fq * 8) * 2); a = __builtin_amdgcn_mfma_f32_16x16x32_bf16(kf, qf[kk], a, 0, 0, 0); }
                    sc[t] = a; __builtin_amdgcn_sched_barrier(0); }
                float mx = -1e30f;
                int db = 128 + fr - 4 * fq, lob = 128 - l0 - 16 * wave - 4 * fq; asm volatile("" : "+v"(db), "+v"(lob));
#pragma unroll
                for (int t = 0; t < 17; ++t)
#pragma unroll
                    for (int e = 0; e < 4; ++e) { const int off = 16 * t + e; const int dist = abs(db - off);
                        bool valid = (unsigned)(off - lob) < (unsigned)L;
                        if (t == 0 || t == 16) valid = valid && (dist <= 128);
                        const float v = valid ? fmaf(-slope, (float)dist, sc[t][e]) : -1e30f; sc[t][e] = v; mx = fmaxf(mx, v); }
                mx = fmaxf(mx, __shfl_xor(mx, 16)); mx = fmaxf(mx, __shfl_xor(mx, 32)); mx = fmaxf(mx, sk);
                float sum = 0.f;
#pragma unroll
                for (int t = 0; t < 17; ++t)
#pragma unroll
                    for (int e = 0; e < 4; ++e) { const float pv = __expf(sc[t][e] - mx); sc[t][e] = pv; sum += pv; }
                sum += __shfl_xor(sum, 16); sum += __shfl_xor(sum, 32); sum += __expf(sk - mx);
                const float inv = 1.0f / sum;
                f32x4 o[4];
#pragma unroll
                for (int dt = 0; dt < 4; ++dt) o[dt] = (f32x4){0.f, 0.f, 0.f, 0.f};
#pragma unroll
                for (int u = 0; u < 9; ++u) {
                    u32x4 pw; pw.x = cvt_pk_bf16(sc[2 * u][0], sc[2 * u][1]); pw.y = cvt_pk_bf16(sc[2 * u][2], sc[2 * u][3]);
                    if (2 * u + 1 < 17) { pw.z = cvt_pk_bf16(sc[(2 * u + 1) % 17][0], sc[(2 * u + 1) % 17][1]); pw.w = cvt_pk_bf16(sc[(2 * u + 1) % 17][2], sc[(2 * u + 1) % 17][3]); } else { pw.z = 0; pw.w = 0; }
                    const bf16x8 pf = __builtin_bit_cast(bf16x8, pw);
#pragma unroll
                    for (int dt = 0; dt < 4; ++dt) { const LAS unsigned char* vp = Vt + (16 * dt + fr) * 816 + (16 * wave + 32 * u + 4 * fq) * 2;
                        const u32x2 lo = *(const LAS u32x2*)vp, hi = *(const LAS u32x2*)(vp + 32); u32x4 vv; vv.x = lo.x; vv.y = lo.y; vv.z = hi.x; vv.w = hi.y;
                        o[dt] = __builtin_amdgcn_mfma_f32_16x16x32_bf16(__builtin_bit_cast(bf16x8, vv), pf, o[dt], 0, 0, 0); }
                    __builtin_amdgcn_sched_barrier(0);
                }
                if (qok) {
#pragma unroll
                    for (int dt = 0; dt < 4; ++dt) { u32x2 w; w.x = cvt_pk_bf16(o[dt][0] * inv, o[dt][1] * inv); w.y = cvt_pk_bf16(o[dt][2] * inv, o[dt][3] * inv);
                        gstore((u32x2*)(ap + (size_t)(rb + lq) * D + h * 64 + 16 * dt + 4 * fq), w); }
                }
            }
        }
    }
    constexpr int PER_G = (T / 2) * 16;
    for (int it = blockIdx.x * 512 + tid; it < 4 * PER_G; it += gridDim.x * 512) {
        const int g = it / PER_G, rem = it - g * PER_G, r = (rem >> 4) * 2, ch = g * 16 + (rem & 15);
        if (g == 0) pool_item<1>(z, ap, r, ch); else if (g == 1) pool_item<2>(z, ap, r, ch); else if (g == 2) pool_item<4>(z, ap, r, ch); else pool_item<8>(z, ap, r, ch);
    }
}

__device__ __forceinline__ void normT_phase(const PW& p, LAS unsigned char* lds) {
    const int tid = otid(), lane = tid & 63, wave = __builtin_amdgcn_readfirstlane(tid >> 6);
    const float* gain = (const float*)(p.ws + OFF_SMALL) + 1024; bf16_t* HNT = (bf16_t*)(p.ws + OFF_HNT);
    LAS bf16_t* Tt = (LAS bf16_t*)lds;
    constexpr int NUA = NBA * (LPA / 64), NU = NUA + NBB * (LPB / 64);
    for (int unit = blockIdx.x; unit < NU; unit += gridDim.x) {
        int sb, ti, L, LP, rb; bf16_t* dst;
        if (unit < NUA) { sb = unit / (LPA / 64); ti = unit - sb * (LPA / 64); L = LA; LP = LPA; rb = sb * LA; dst = HNT + (size_t)sb * D * LPA; }
        else { const int uu = unit - NUA; sb = uu / (LPB / 64); ti = uu - sb * (LPB / 64); L = LB; LP = LPB; rb = TA + sb * LB; dst = HNT + HNT_B + (size_t)sb * D * LPB; }
        const int l0 = ti * 64;
        __syncthreads();
        {
            unsigned raw[8][8]; float rs[8];
#pragma unroll
            for (int rr = 0; rr < 8; ++rr) { const int l = l0 + wave * 8 + rr; const bool ok = l < L;
                const unsigned* hp = (const unsigned*)((const bf16_t*)(p.ws + OFF_HB) + (size_t)(rb + min(l, L - 1)) * D);
#pragma unroll
                for (int i = 0; i < 8; ++i) { unsigned t = hp[lane + 64 * i]; raw[rr][i] = ok ? t : 0u; } }
#pragma unroll
            for (int rr = 0; rr < 8; ++rr) { float ss = 0.f;
#pragma unroll
                for (int i = 0; i < 8; ++i) { const float a = bflo(raw[rr][i]), b = bfhi(raw[rr][i]); ss += a * a + b * b; }
                ss = wave_sum(ss); rs[rr] = __builtin_amdgcn_rsqf(ss * (1.0f / 1024.0f) + 1e-6f); }
            LAS unsigned* TtW = (LAS unsigned*)lds;
#pragma unroll
            for (int i = 0; i < 8; ++i) { const float g0 = gain[2 * lane + 128 * i], g1 = gain[2 * lane + 128 * i + 1]; const int c0 = 2 * lane + 128 * i;
#pragma unroll
                for (int q = 0; q < 4; ++q) {
                    TtW[c0 * 33 + wave * 4 + q] = cvt_pk_bf16(bflo(raw[2 * q][i]) * rs[2 * q] * g0, bflo(raw[2 * q + 1][i]) * rs[2 * q + 1] * g0);
                    TtW[(c0 + 1) * 33 + wave * 4 + q] = cvt_pk_bf16(bfhi(raw[2 * q][i]) * rs[2 * q] * g1, bfhi(raw[2 * q + 1][i]) * rs[2 * q + 1] * g1); } }
        }
        __syncthreads();
#pragma unroll 8
        for (int i = 0; i < 64; ++i) { const int idx = tid + 512 * i; const int c = idx >> 5, pr = idx & 31;
            const unsigned v = *(const LAS unsigned*)(Tt + c * 66 + 2 * pr); *(unsigned*)(dst + (size_t)c * LP + l0 + 2 * pr) = v; }
    }
}

__device__ __forceinline__ void final_phase(const PW& p) {
    const int tid = otid(); const int lane = tid & 63, gw = blockIdx.x * 8 + (tid >> 6), NGW = gridDim.x * 8; const float* gf = (const float*)(p.ws + OFF_SMALL) + 2048;
    const bf16_t* hb = (const bf16_t*)(p.ws + OFF_HB); const float* rss = (const float*)(p.ws + OFF_RSS);
    f32x4 gv[4];
#pragma unroll
    for (int i = 0; i < 4; ++i) gv[i] = *(const f32x4*)(gf + lane * 8 + 512 * (i >> 1) + 4 * (i & 1));
    for (int row = gw; row < 98304; row += NGW) {
        int r; if (row < NBA * 4096) { const int gb = row >> 12; r = row + 16 * (gb + 1); } else { const int o2 = row - NBA * 4096, b = o2 >> 11; r = TA + b * LB + 16 + (o2 - (b << 11)); }
        const f32x4 q4 = *(const f32x4*)(rss + (size_t)r * 4); const float rs = rstd_of((q4[0] + q4[1]) + (q4[2] + q4[3]));
        const bf16_t* hp = hb + (size_t)r * D; float* op = p.out + (size_t)row * D;
        const u32x4 w0 = *(const u32x4*)(hp + lane * 8), w1 = *(const u32x4*)(hp + 512 + lane * 8);
        f32x4 a, b2, c2, d2;
        a[0] = bflo(w0.x); a[1] = bfhi(w0.x); a[2] = bflo(w0.y); a[3] = bfhi(w0.y); b2[0] = bflo(w0.z); b2[1] = bfhi(w0.z); b2[2] = bflo(w0.w); b2[3] = bfhi(w0.w);
        c2[0] = bflo(w1.x); c2[1] = bfhi(w1.x); c2[2] = bflo(w1.y); c2[3] = bfhi(w1.y); d2[0] = bflo(w1.z); d2[1] = bfhi(w1.z); d2[2] = bflo(w1.w); d2[3] = bfhi(w1.w);
        *(f32x4*)(op + lane * 8) = a * rs * gv[0]; *(f32x4*)(op + lane * 8 + 4) = b2 * rs * gv[1];
        *(f32x4*)(op + 512 + lane * 8) = c2 * rs * gv[2]; *(f32x4*)(op + 512 + lane * 8 + 4) = d2 * rs * gv[3];
    }
}

enum { K_PREP = 0, K_GGU, K_DOWN, K_GZ, K_ATTN, K_APO, K_NORMT, K_DFT, K_FO, K_FINAL };
#ifndef REP_PREP
#define REP_PREP 1
#endif
__global__ void __launch_bounds__(512, 2) mega_fwd(Params p0) {
    extern __shared__ __attribute__((aligned(16))) unsigned char shm[];
    LAS unsigned char* lds = (LAS unsigned char*)shm;
    cg::grid_group grid = cg::this_grid();
    volatile LAS unsigned* xst = (volatile LAS unsigned*)(lds + (LDS_BYTES - 16));
    if (threadIdx.x == 0) { xst[0] = 0u; xst[1] = 0u; }
    __syncthreads();
    XcdBarrier xb = xcd_barrier_post((unsigned*)(p0.ws + OFF_BAR), xst);
    const int nrep = REP_PREP + (p0.out == nullptr ? 1 : 0);
#pragma unroll 1
    for (int rep = 0; rep < nrep; ++rep) { prep_phase(p0, lds); grid.sync(); }
#ifdef PROBE_SLEEP_TICKS
    { const unsigned long long t0 = __builtin_amdgcn_s_memrealtime(); while (__builtin_amdgcn_s_memrealtime() - t0 < (unsigned long long)PROBE_SLEEP_TICKS) __builtin_amdgcn_s_sleep(32); }
#endif
    PW p; p.ws = p0.ws; p.out = p0.out;
    { unsigned long long w = (unsigned long long)p.ws, o = (unsigned long long)p.out; asm volatile("" : "+s"(w), "+s"(o)); p.ws = (unsigned char*)w; p.out = (float*)o; }
#pragma unroll 1
    for (int ph = 1; ph < 16; ++ph) {
        int kind, f = 0, rbuf = 0;
        switch (ph) {
            case 0: kind = K_PREP; break;
            case 1: kind = K_GGU; f = 0; rbuf = 0; break;
            case 2: kind = K_DOWN; f = 0; rbuf = 1; break;
            case 3: kind = K_GZ; rbuf = 1; break;
            case 4: kind = K_ATTN; break;
            case 5: kind = K_APO; rbuf = 0; break;
            case 6: kind = K_GGU; f = 1; rbuf = 0; break;
            case 7: kind = K_DOWN; f = 1; rbuf = 1; break;
            case 8: kind = K_GGU; f = 2; rbuf = 1; break;
            case 9: kind = K_DOWN; f = 2; rbuf = 0; break;
            case 10: kind = K_NORMT; break;
            case 11: kind = K_DFT; break;
            case 12: kind = K_FO; rbuf = 1; break;
            case 13: kind = K_GGU; f = 3; rbuf = 1; break;
            case 14: kind = K_DOWN; f = 3; rbuf = 0; break;
            default: kind = K_FINAL; break;
        }
        const int c = (int)blockIdx.x;
        if (kind == K_PREP) {
        } else if (kind == K_GGU) {
#ifndef NO_GGU
            EpiGateUp E; E.act = (bf16_t*)(p.ws + OFF_ACT); E.rss = (const float*)(p.ws + OFF_RSS);
#ifndef REP_GGU
#define REP_GGU 1
#endif
#pragma unroll 1
            for (int rep = 0; rep < REP_GGU; ++rep) {
            run_gemm(lds, (const bf16_t*)(p.ws + OFF_HB), (const bf16_t*)(p.ws + OFF_WGU) + (size_t)f * NGU * D, TPAD, NGU, D, E, c);
            if (rep + 1 < REP_GGU) grid.sync(); }
#ifdef PROBE_KLOOP
            xcd_barrier(xb); { EpiNone EN; pg8::Gemm g; g.A = (const bf16_t*)(p.ws + OFF_HB); g.Bt = (const bf16_t*)(p.ws + OFF_WGU) + (size_t)f * NGU * D; g.M = TPAD; g.N = NGU; g.K = D; g.ld = D;
#if PROBE_KLOOP == 2
              LocalOrder S;
#else
              pg8::StaticOrder S;
#endif
              S.init(TPAD, NGU, (int)gridDim.x, c); pg8::gemm_phase<EpiNone, decltype(S), false>(lds, g, S, EN, nullptr); }
#endif
#endif
        } else if (kind == K_DOWN || kind == K_APO || kind == K_FO) {
#ifndef NO_GRES
            const bf16_t* A; const bf16_t* Bt; int K; float scale;
            if (kind == K_DOWN) { A = (const bf16_t*)(p.ws + OFF_ACT); Bt = (const bf16_t*)(p.ws + OFF_WD) + (size_t)f * D * DFF; K = DFF; scale = 0.5f; }
            else if (kind == K_APO) { A = (const bf16_t*)(p.ws + OFF_AP); Bt = (const bf16_t*)(p.ws + OFF_WO); K = D; scale = 1.0f; }
            else { A = (const bf16_t*)(p.ws + OFF_X); Bt = (const bf16_t*)(p.ws + OFF_W2T); K = 2048; scale = 1.0f; }
            { EpiResid<false> E; E.out = p.out; E.ws = p.ws; E.half = (kind == K_DOWN); E.rss4 = (float*)(p.ws + OFF_RSS); E.part = (LAS float*)(lds + 131072);
              pg8::Gemm g; g.A = A; g.Bt = Bt; g.M = TPAD; g.N = D; g.K = K; g.ld = K;
              const bool split = (int)gridDim.x == 256 && K >= 2048;
              CapOrder S; S.init2(TPAD, D, (int)gridDim.x, c, split ? TAIL_L0 : (TPAD / 256) * 4);
              pg8::gemm_phase<EpiResid<false>, CapOrder, false>(lds, g, S, E, nullptr);
              if (split) {
                  const int nsl = K / 256;
                  if (c < TAIL_UNITS * nsl) { const int tu = c / nsl, sl = c - tu * nsl;
                      EpiPartial EP; EP.P = (float*)(p.ws + OFF_PART) + (size_t)(tu * 16 + sl) * 65536;
                      pg8::Gemm g2; g2.A = A + sl * 256; g2.Bt = Bt + sl * 256; g2.M = TPAD; g2.N = D; g2.K = K / nsl; g2.ld = K;
                      TailOrder S2; S2.init2(TPAD, D, tu);
                      pg8::gemm_phase<EpiPartial, TailOrder, false>(lds, g2, S2, EP, nullptr); }
                  xcd_barrier(xb);
                  tail_fixup(p.ws, nsl, kind == K_DOWN);
              } }
#endif
        } else if (kind == K_GZ) {
#ifndef NO_GZ
            EpiScale E; E.O = (bf16_t*)(p.ws + OFF_Z); E.ldc = INDIM; E.rss = (const float*)(p.ws + OFF_RSS);
            run_gemm(lds, (const bf16_t*)(p.ws + OFF_HB), (const bf16_t*)(p.ws + OFF_WIN), TPAD, INDIM, D, E, c);
#endif
        } else if (kind == K_ATTN) {
#ifndef REP_ATTN
#define REP_ATTN 1
#endif
            for (int rep = 0; rep < REP_ATTN; ++rep) { attn_phase(p, lds); if (rep + 1 < REP_ATTN) grid.sync(); }
        } else if (kind == K_NORMT) {
#ifndef REP_NORMT
#define REP_NORMT 1
#endif
            for (int rep = 0; rep < REP_NORMT; ++rep) { normT_phase(p, lds); if (rep + 1 < REP_NORMT) grid.sync(); }
        } else if (kind == K_DFT) {
#ifndef NO_GDFT
#ifndef REP_DFT
#define REP_DFT 1
#endif
#pragma unroll 1
            for (int grp = 0; grp < 2; ++grp) {
                EpiDft E; E.X = (bf16_t*)(p.ws + OFF_X); E.L = grp ? LB : LA; E.rowbase = grp ? TA : 0;
                pg8::Gemm g; g.A = (const bf16_t*)(p.ws + (grp ? OFF_D2 : OFF_D1)); g.Bt = (const bf16_t*)(p.ws + OFF_HNT) + (grp ? HNT_B : 0); g.M = grp ? MPB : MPA; g.N = (grp ? NBB : NBA) * D; g.K = grp ? LPB : LPA; g.ld = g.K;
                const bool bal = grp && (int)gridDim.x == 256;
                DftOrder S; S.init2(g.M, g.N, (int)gridDim.x, (grp && !bal) ? (int)gridDim.x - 1 - c : c, bal ? 1 : 0);
                pg8::gemm_phase<EpiDft, DftOrder, false>(lds, g, S, E, nullptr);
            }
#endif
        } else {
#ifndef NO_FINAL
            final_phase(p);
#endif
        }
#ifdef USE_CG_SYNC
        if (ph != 15) grid.sync();
#else
        if (ph != 15) xcd_barrier(xb);
#endif
    }
}

extern "C" void kernel_launch(void* const* d_in, const int* in_sizes, int n_in, void* d_out, int out_size, void* d_ws, size_t ws_size, hipStream_t stream) {
    static int grid = 0;
    if (grid == 0) {
        if (n_in != 19 || ws_size < WS_NEED) { fprintf(stderr, "kernel_launch: need 19 inputs and %zu bytes of workspace (got %d, %zu)\n", (size_t)WS_NEED, n_in, ws_size); grid = -1; return; }
        int dev = 0, cus = 0, per_cu = 0;
        hipGetDevice(&dev); hipDeviceGetAttribute(&cus, hipDeviceAttributeMultiprocessorCount, dev);
        if (hipFuncSetAttribute((const void*)mega_fwd, hipFuncAttributeMaxDynamicSharedMemorySize, LDS_BYTES) != hipSuccess) { fprintf(stderr, "kernel_launch: hipFuncSetAttribute failed\n"); grid = -1; return; }
        if (hipOccupancyMaxActiveBlocksPerMultiprocessor(&per_cu, (const void*)mega_fwd, 512, LDS_BYTES) != hipSuccess || per_cu < 1) { fprintf(stderr, "kernel_launch: occupancy query gave %d\n", per_cu); per_cu = 1; (void)hipGetLastError(); }
        grid = cus * 1;
    }
    if (grid < 0) return;
    Params p{};
    for (int i = 0; i < 19; ++i) p.in[i] = (const float*)d_in[i];
    p.out = (float*)d_out; p.ws = (unsigned char*)d_ws;
    if (hipMemsetAsync((unsigned char*)d_ws + OFF_BAR, 0, (size_t)XCD_BAR_WORDS * 4, stream) != hipSuccess) { fprintf(stderr, "kernel_launch: memset of barrier words failed\n"); return; }
    void* args[] = {&p};
    hipError_t e = hipLaunchCooperativeKernel((const void*)mega_fwd, dim3(grid), dim3(512), args, LDS_BYTES, stream);
    if (e != hipSuccess) fprintf(stderr, "cooperative launch failed: %s (grid %d)\n", hipGetErrorString(e), grid);
}
```

```cpp
#include <hip/hip_runtime.h>
#include <hip/hip_cooperative_groups.h>
#include <cstdio>
namespace cg = cooperative_groups;
#define LAS __attribute__((address_space(3)))
namespace pg8 {
#define PG8_LAS __attribute__((address_space(3)))
typedef unsigned short bf16_t;
typedef short bf16x8 __attribute__((ext_vector_type(8)));
typedef float f32x4 __attribute__((ext_vector_type(4)));
typedef unsigned u32x4 __attribute__((ext_vector_type(4)));
constexpr int BM = 256, BK = 64, HALF = 128, HTB = HALF * BK * 2  , STAGE_BYTES = 8 * HTB, NXCD = 8, WGM = 8;

__host__ __device__ __forceinline__ int lds_byte(int r, int c) { const int st = (r >> 4) * 2 + (c >> 5), rr = r & 15, cc = c & 31, ob = rr * 64 + cc * 2; return st * 1024 + (ob ^ (((ob >> 9) & 1) << 5)); }
__host__ __device__ __forceinline__ void stage_rc(int b, int& R, int& C) { const int st = b / 1024, sb = b % 1024, swz = sb ^ (((sb >> 9) & 1) << 5); R = (st >> 1) * 16 + swz / 64; C = (st & 1) * 32 + (swz % 64) / 2; }
__host__ __device__ __forceinline__ int perm32(int rho) { const int n = rho >> 4, i = rho & 15; return 8 * (i >> 2) + 4 * n + (i & 3); }

struct Unit { int pm, pn; };
struct Gemm { const bf16_t* A; const bf16_t* Bt; int M, N, K, ld; };

struct StaticOrder {
    int nM, nN, nwg, G, c;
    __host__ __device__ void init(int M, int N, int G_, int c_) { nM = M / BM; nN = N / BM; nwg = nM * nN; G = G_; c = c_; }
    __host__ __device__ bool next(int i, Unit& u) const {
        const int L = i * G + c; if (L >= nwg) return false;
        int wgid = (int)L; { const int q = nwg / NXCD, r = nwg % NXCD, xcd = wgid % NXCD, off = wgid / NXCD; wgid = (xcd < r ? xcd * (q + 1) : r * (q + 1) + (xcd - r) * q) + off; }
        const int nig = WGM * nN, gid = wgid / nig, fm = gid * WGM, gsz = (nM - fm) < WGM ? (nM - fm) : WGM;
        u.pm = fm + ((wgid % nig) % gsz); u.pn = (wgid % nig) / gsz; return true;
    }
    __device__ __forceinline__ void a_ready(const Unit&) const {}
    __device__ __forceinline__ void done(const Unit&) const {}
};
__device__ __forceinline__ unsigned cvt_pk_bf16(float lo, float hi) { unsigned r; asm volatile("v_cvt_pk_bf16_f32 %0, %1, %2" : "=v"(r) : "v"(lo), "v"(hi)); return r; }
template <class Epi, class Sched, bool STAMP = false>
__device__ __forceinline__ void gemm_phase(PG8_LAS unsigned char* lds, const Gemm g, const Sched& S, const Epi& E, unsigned long long* stamps) {
    int tid_o = threadIdx.x; asm volatile("" : "+v"(tid_o));
    const int tid = tid_o, wid = __builtin_amdgcn_readfirstlane(tid >> 6), lane = tid & 63, wr = wid >> 2, wc = wid & 3, fr = lane & 15, fq = lane >> 4;
    const int K = g.ld, nt = g.K / BK;
    int ts_lo = 0, ts_hi = 0, nts = 0; const unsigned long long rt_entry = STAMP ? (unsigned long long)wall_clock64() : 0ull;
#define PG8_STAMP() do { if (STAMP && wid == 0 && nts < 64) { const unsigned long long _c = (unsigned long long)clock64(); \
        ts_lo = (lane == nts) ? (int)(unsigned)_c : ts_lo; ts_hi = (lane == nts) ? (int)(unsigned)(_c >> 32) : ts_hi; ++nts; } } while (0)
    PG8_STAMP();
    unsigned voffA[2], voffB[2];
#pragma unroll
    for (int i = 0; i < 2; ++i) { int R, C; stage_rc(tid * 16 + i * 8192, R, C); const int Rb = Epi::PERM ? ((R & ~31) + perm32(R & 31)) : R;
        voffA[i] = (unsigned)(R * K + C) * 2u; voffB[i] = (unsigned)(Rb * K + C) * 2u; }
    const size_t kstep = (size_t)(BK * 2);
    const size_t hstep = (size_t)HALF * K * 2;
    const size_t tstep = 2 * hstep;
    const unsigned ldsw = (unsigned)wid * 1024u;
    const int aoff = lds_byte(wr * 64 + fr, fq * 8), boff = lds_byte(wc * 32 + fr, fq * 8);
#define PG8_SA(b, h) (((b) * 2 + (h)) * HTB)
#define PG8_SB(b, h) ((4 + (b) * 2 + (h)) * HTB)
#define PG8_STAGE(bufoff, gbase, voff) do { _Pragma("unroll") for (int _i = 0; _i < 2; ++_i) \
        __builtin_amdgcn_global_load_lds((const unsigned*)((const char*)(gbase) + (voff)[_i]), (PG8_LAS unsigned*)(lds + (bufoff) + ldsw + _i * 8192), 16, 0, 0); } while (0)
#define PG8_LDA(dst, b, h) do { _Pragma("unroll") for (int m = 0; m < 4; ++m) _Pragma("unroll") for (int k = 0; k < 2; ++k) dst[m][k] = *(const PG8_LAS bf16x8*)(lds + PG8_SA(b, h) + aoff + m * 2048 + k * 1024); } while (0)
#define PG8_LDB(dst, b, h) do { _Pragma("unroll") for (int n = 0; n < 2; ++n) _Pragma("unroll") for (int k = 0; k < 2; ++k) dst[n][k] = *(const PG8_LAS bf16x8*)(lds + PG8_SB(b, h) + boff + n * 2048 + k * 1024); } while (0)
#define PG8_MMA(ai, bj, At, Bt) do { __builtin_amdgcn_s_setprio(1); _Pragma("unroll") for (int m = 0; m < 4; ++m) _Pragma("unroll") for (int n = 0; n < 2; ++n) _Pragma("unroll") for (int k = 0; k < 2; ++k) \
        acc[ai][bj][m][n] = __builtin_amdgcn_mfma_f32_16x16x32_bf16(Bt[n][k], At[m][k], acc[ai][bj][m][n], 0, 0, 0); __builtin_amdgcn_s_setprio(0); } while (0)
#define PG8_WAIT_V(n) asm volatile("s_waitcnt vmcnt(" #n ")" ::: "memory")
#define PG8_WAIT_L(n) asm volatile("s_waitcnt lgkmcnt(" #n ")" ::: "memory")
#define PG8_BAR __builtin_amdgcn_s_barrier()
#define PG8_SCHED __builtin_amdgcn_sched_barrier(0)
    Unit cur, nxt; int ui = 0;
    if (!S.next(0, cur)) return;
    f32x4 acc[2][2][4][2];
#pragma unroll
    for (int a = 0; a < 2; ++a)
#pragma unroll
        for (int b = 0; b < 2; ++b)
#pragma unroll
            for (int m = 0; m < 4; ++m)
#pragma unroll
                for (int n = 0; n < 2; ++n) acc[a][b][m][n] = (f32x4){0.f, 0.f, 0.f, 0.f};
    bf16x8 At[4][2], B0[2][2], B1[2][2];
    const char* cA = (const char*)g.A + (size_t)cur.pm * tstep; const char* cB = (const char*)g.Bt + (size_t)cur.pn * tstep;
    S.a_ready(cur);
    PG8_STAGE(PG8_SB(0, 0), cB, voffB); PG8_STAGE(PG8_SA(0, 0), cA, voffA); PG8_STAGE(PG8_SB(0, 1), cB + hstep, voffB); PG8_STAGE(PG8_SA(0, 1), cA + hstep, voffA);
    if (wr == 1) PG8_BAR;
    PG8_WAIT_V(4); PG8_BAR;
    PG8_STAGE(PG8_SB(1, 0), cB + kstep, voffB); PG8_STAGE(PG8_SA(1, 0), cA + kstep, voffA); PG8_STAGE(PG8_SB(1, 1), cB + hstep + kstep, voffB);
    PG8_WAIT_V(6); PG8_BAR;
    PG8_STAMP();
    for (;;) {
        const bool has_next = S.next(ui + 1, nxt);
        const char* nA = has_next ? (const char*)g.A + (size_t)nxt.pm * tstep : cA; const char* nB = has_next ? (const char*)g.Bt + (size_t)nxt.pn * tstep : cB;
        for (int t = 0; t < nt; t += 2) {
            const bool last = (t == nt - 2);
            const char* a1 = cA + (size_t)(t + 1) * kstep;
            const char* a2 = last ? nA : cA + (size_t)(t + 2) * kstep; const char* b2 = last ? nB : cB + (size_t)(t + 2) * kstep;
            const char* a3 = a2 + kstep; const char* b3 = b2 + kstep;
            if (last && has_next) S.a_ready(nxt);
            PG8_LDB(B0, 0, 0); PG8_SCHED; PG8_LDA(At, 0, 0); PG8_STAGE(PG8_SA(1, 1), a1 + hstep, voffA);
            PG8_WAIT_L(8); PG8_BAR; PG8_WAIT_L(0); PG8_MMA(0, 0, At, B0); PG8_BAR; PG8_SCHED;
            PG8_LDB(B1, 0, 1); PG8_STAGE(PG8_SB(0, 0), b2, voffB);
            PG8_BAR; PG8_WAIT_L(0); PG8_MMA(0, 1, At, B1); PG8_BAR;
            PG8_LDA(At, 0, 1); PG8_STAGE(PG8_SA(0, 0), a2, voffA);
            PG8_BAR; PG8_WAIT_L(0); PG8_MMA(1, 0, At, B0); PG8_BAR; PG8_SCHED;
            PG8_STAGE(PG8_SB(0, 1), b2 + hstep, voffB);
            PG8_WAIT_V(6); PG8_BAR; PG8_MMA(1, 1, At, B1); PG8_BAR;
            PG8_LDB(B0, 1, 0); PG8_SCHED; PG8_LDA(At, 1, 0); PG8_STAGE(PG8_SA(0, 1), a2 + hstep, voffA);
            PG8_WAIT_L(8); PG8_BAR; PG8_WAIT_L(0); PG8_MMA(0, 0, At, B0); PG8_BAR; PG8_SCHED;
            PG8_LDB(B1, 1, 1); PG8_STAGE(PG8_SB(1, 0), b3, voffB);
            PG8_BAR; PG8_WAIT_L(0); PG8_MMA(0, 1, At, B1); PG8_BAR;
            PG8_LDA(At, 1, 1); PG8_STAGE(PG8_SA(1, 0), a3, voffA);
            PG8_BAR; PG8_WAIT_L(0); PG8_MMA(1, 0, At, B0); PG8_BAR; PG8_SCHED;
            PG8_STAGE(PG8_SB(1, 1), b3 + hstep, voffB);
            PG8_WAIT_V(6); PG8_BAR; PG8_MMA(1, 1, At, B1); PG8_BAR;
        }
        PG8_STAMP();
        if constexpr (!Epi::AFTER_DRAIN) { E(acc, cur, wr, wc, fr, fq); S.done(cur); }
        PG8_STAMP();
        if (!has_next) break;
#pragma unroll
        for (int a = 0; a < 2; ++a)
#pragma unroll
            for (int b = 0; b < 2; ++b)
#pragma unroll
                for (int m = 0; m < 4; ++m)
#pragma unroll
                    for (int n = 0; n < 2; ++n) acc[a][b][m][n] = (f32x4){0.f, 0.f, 0.f, 0.f};
        cur = nxt; cA = nA; cB = nB; ++ui;
    }
    PG8_WAIT_V(0);
    if (wr == 0) PG8_BAR;
    PG8_BAR;
    if constexpr (Epi::AFTER_DRAIN) { E.fused(acc, cur, wr, wc, fr, fq, lds, wid, lane); S.done(cur); }
    PG8_STAMP();
    if (STAMP && wid == 0) { stamps[lane] = lane < nts ? (((unsigned long long)(unsigned)ts_hi << 32) | (unsigned)ts_lo) : 0ull;
        if (lane == 62) stamps[62] = rt_entry; if (lane == 63) stamps[63] = (unsigned long long)wall_clock64(); }
#undef PG8_STAMP
#undef PG8_SA
#undef PG8_SB
#undef PG8_STAGE
#undef PG8_LDA
#undef PG8_LDB
#undef PG8_MMA
#undef PG8_WAIT_V
#undef PG8_WAIT_L
#undef PG8_BAR
#undef PG8_SCHED
}
}
#define XB_TMO      128
#define XB_XCNT(j)  (256  + 64 * (j))
#define XB_XSUB(j)  (1280 + 64 * (j))
#define XB_XGEN(j)  (2304 + 64 * (j))
#define XB_TOP      3328
#define XB_TOPGEN   3392
#define XCD_BAR_WORDS 3456
#define XB_SPIN_CAP (1u << 18)

__device__ __forceinline__ unsigned xb_ld(unsigned* p)              { return __hip_atomic_load(p, __ATOMIC_RELAXED, __HIP_MEMORY_SCOPE_AGENT); }
__device__ __forceinline__ unsigned xb_add(unsigned* p, unsigned v) { return __hip_atomic_fetch_add(p, v, __ATOMIC_RELAXED, __HIP_MEMORY_SCOPE_AGENT); }
__device__ __forceinline__ unsigned xb_xcc_id() { return (unsigned)__builtin_amdgcn_s_getreg((3 << 11) | 20) & 0xFu; }
#define XB_SPIN(cond, bar) do { unsigned _sp = 0; while (cond) { __builtin_amdgcn_s_sleep(1); \
    if ((++_sp & 255u) == 0u) { if (xb_ld(&(bar)[XB_TMO])) break; if (_sp > XB_SPIN_CAP) { atomicAdd(&(bar)[XB_TMO], 1u); break; } } } } while (0)

struct XcdBarrier {
    unsigned* bar; unsigned x;
    volatile LAS unsigned* st;
};

__device__ __forceinline__ XcdBarrier xcd_barrier_post(unsigned* bar, volatile LAS unsigned* st) {
    XcdBarrier b; b.bar = bar; b.x = xb_xcc_id(); b.st = st;
    if (threadIdx.x == 0) (void)xb_add(&bar[XB_XCNT(b.x)], 1u);
    return b;
}
__device__ __forceinline__ void xcd_barrier_complete(unsigned* bar, unsigned x, unsigned& nloc, unsigned& nx) {
    const unsigned G = gridDim.x * gridDim.y * gridDim.z;
    unsigned sum, cnt, mine, sp = 0u;
    for (;;) {
        sum = 0u; cnt = 0u; mine = 0u;
#pragma unroll
        for (unsigned j = 0; j < 16; ++j) { const unsigned c = xb_ld(&bar[XB_XCNT(j)]); sum += c; cnt += (c > 0u) ? 1u : 0u; mine = (j == x) ? c : mine; }
        if (sum == G) break;
        __builtin_amdgcn_s_sleep(1);
        if ((++sp & 255u) == 0u) { if (xb_ld(&bar[XB_TMO])) break; if (sp > XB_SPIN_CAP) { atomicAdd(&bar[XB_TMO], 1u); break; } }
    }
    nloc = mine > 0u ? mine : 1u; nx = cnt > 0u ? cnt : 1u;
}

__device__ __forceinline__ void xcd_barrier(const XcdBarrier& b) {
    asm volatile("s_waitcnt vmcnt(0)" ::: "memory");
    __syncthreads();
    if (threadIdx.x == 0) {
        unsigned* bar = b.bar;
        __builtin_amdgcn_s_waitcnt(0);
        unsigned nloc = b.st[0], nx = b.st[1];
        if (nloc == 0u) { xcd_barrier_complete(bar, b.x, nloc, nx); b.st[0] = nloc; b.st[1] = nx; }
        const unsigned old = xb_add(&bar[XB_XSUB(b.x)], 1u);
        const unsigned gen = old / nloc;
        if (old + 1u == (gen + 1u) * nloc) {
            __builtin_amdgcn_fence(__ATOMIC_RELEASE, "agent");
            asm volatile("s_waitcnt vmcnt(0)" ::: "memory");
            const unsigned og = xb_add(&bar[XB_TOP], 1u);
            const unsigned tg = og / nx;
            if (og + 1u == (tg + 1u) * nx) xb_add(&bar[XB_TOPGEN], 1u);
            else XB_SPIN(xb_ld(&bar[XB_TOPGEN]) == tg, bar);
            __builtin_amdgcn_fence(__ATOMIC_ACQUIRE, "agent");
            xb_add(&bar[XB_XGEN(b.x)], 1u);
            asm volatile("s_waitcnt vmcnt(0)" ::: "memory");
        } else {
            XB_SPIN(xb_ld(&bar[XB_XGEN(b.x)]) == gen, bar);
            __builtin_amdgcn_fence(__ATOMIC_ACQUIRE, "agent");
            asm volatile("s_waitcnt vmcnt(0)" ::: "memory");
        }
    }
    __syncthreads();
}

using pg8::bf16_t; using pg8::bf16x8; using pg8::f32x4; using pg8::u32x4; using pg8::Unit; using pg8::cvt_pk_bf16;
typedef unsigned u32x2 __attribute__((ext_vector_type(2)));
typedef float f32x2 __attribute__((ext_vector_type(2)));

#define GAS __attribute__((address_space(1)))
template <class T> __device__ __forceinline__ T gload(const T* p) { return *(const GAS T*)p; }
template <class T> __device__ __forceinline__ void gstore(T* p, const T& v) { *(GAS T*)p = v; }
constexpr int D = 1024, DFF = 2816, NGU = 5632, INDIM = 1280;
constexpr int LA = 4112, LB = 2064, NBA = 8, NBB = 32;
constexpr int TA = NBA * LA;
constexpr int T = TA + NBB * LB;
constexpr int TPAD = 99072;
constexpr int LPA = 4224, LPB = 2176;
constexpr int MPA = 4352, MPB = 2304;
constexpr int LDS_BYTES = 147456;

constexpr size_t al256(size_t x) { return (x + 255) & ~(size_t)255; }
constexpr size_t OFF_WGU = 0;
constexpr size_t OFF_WD = al256(OFF_WGU + (size_t)4 * NGU * D * 2);
constexpr size_t OFF_WIN = al256(OFF_WD + (size_t)4 * D * DFF * 2);
constexpr size_t OFF_WO = al256(OFF_WIN + (size_t)INDIM * D * 2);
constexpr size_t OFF_W2T = al256(OFF_WO + (size_t)D * D * 2);
constexpr size_t OFF_D1 = al256(OFF_W2T + (size_t)D * 2048 * 2);
constexpr size_t OFF_D2 = al256(OFF_D1 + (size_t)MPA * LPA * 2);
constexpr size_t OFF_HMETA = al256(OFF_D2 + (size_t)MPB * LPB * 2);
constexpr size_t OFF_RSS = al256(OFF_HMETA + (size_t)640 * D * 4);
constexpr size_t OFF_HB = al256(OFF_RSS + (size_t)TPAD * 16 * 4);
constexpr size_t OFF_BIG = al256(OFF_HB + (size_t)TPAD * D * 2);
constexpr size_t OFF_ACT = OFF_BIG;
constexpr size_t OFF_Z = OFF_BIG;
constexpr size_t OFF_AP = al256(OFF_Z + (size_t)TPAD * INDIM * 2);
constexpr size_t OFF_HNT = OFF_BIG;
constexpr size_t HNT_B = (size_t)NBA * D * LPA;
constexpr size_t OFF_X = al256(OFF_HNT + ((size_t)NBA * D * LPA + (size_t)NBB * D * LPB) * 2);
constexpr size_t OFF_SMALL = al256(OFF_X + (size_t)TPAD * 2048 * 2);
constexpr size_t OFF_BAR = al256(OFF_SMALL + 3072 * 4);
constexpr size_t OFF_PART = al256(OFF_BAR + (size_t)XCD_BAR_WORDS * 4);
constexpr size_t WS_NEED = al256(OFF_PART + (size_t)12 * 16 * 256 * 256 * 4);
static_assert(OFF_AP + (size_t)TPAD * D * 2 <= WS_NEED && OFF_ACT + (size_t)TPAD * DFF * 2 <= WS_NEED, "big region");

struct Params { const float* in[19]; float* out; unsigned char* ws; };

__device__ __forceinline__ void row_decode(int r, int& gb, int& l, int& L, int& rb) {
    if (r < TA) { gb = r / LA; l = r - gb * LA; L = LA; rb = gb * LA; }
    else { const int q = r - TA, b = q / LB; l = q - b * LB; gb = NBA + b; L = LB; rb = TA + b * LB; }
}
__device__ __forceinline__ float* hptr2(float* out, unsigned char* ws, int r) {
    int gb, l, L, rb; row_decode(r, gb, l, L, rb);
    if (l < 16) return (float*)(ws + OFF_HMETA) + (size_t)(gb * 16 + l) * D;
    return out + (size_t)(r - 16 * (gb + 1)) * D;
}
__device__ __forceinline__ float* hptr(const Params& p, int r) {
    int gb, l, L, rb; row_decode(r, gb, l, L, rb);
    if (l < 16) return (float*)(p.ws + OFF_HMETA) + (size_t)(gb * 16 + l) * D;
    return p.out + (size_t)(r - 16 * (gb + 1)) * D;
}
__device__ __forceinline__ int otid() { int t = threadIdx.x; asm volatile("" : "+v"(t)); return t; }
__device__ __forceinline__ bf16_t f2bf(float f) { unsigned u = __float_as_uint(f); u += 0x7FFFu + ((u >> 16) & 1u); return (bf16_t)(u >> 16); }
__device__ __forceinline__ float bflo(unsigned w) { return __uint_as_float(w << 16); }
__device__ __forceinline__ float bfhi(unsigned w) { return __uint_as_float(w & 0xFFFF0000u); }
__device__ __forceinline__ float wave_sum(float v) {
#pragma unroll
    for (int o = 1; o < 64; o <<= 1) v += __shfl_xor(v, o);
    return v;
}
__device__ __forceinline__ float rstd_of(float ss) { return __builtin_amdgcn_rsqf(ss * (1.0f / 1024.0f) + 1e-6f); }

struct EpiGateUp {
    static constexpr bool PERM = true, AFTER_DRAIN = false;
    bf16_t* act; const float* rss;
    __device__ __forceinline__ void operator()(const f32x4 (&acc)[2][2][4][2], const Unit& u, int wr, int wc, int fr, int fq) const {
        const int col = u.pn * 128 + wc * 32 + fq * 8;
        float rsc[2][4];
#pragma unroll
        for (int ai = 0; ai < 2; ++ai)
#pragma unroll
            for (int m = 0; m < 4; ++m) { const int r = u.pm * 256 + ai * 128 + wr * 64 + m * 16 + fr; const f32x4 q4 = gload((const f32x4*)(rss + (size_t)min(r, T - 1) * 4)); rsc[ai][m] = (q4[0] + q4[1]) + (q4[2] + q4[3]); }
#pragma unroll
        for (int ai = 0; ai < 2; ++ai)
#pragma unroll
            for (int m = 0; m < 4; ++m) rsc[ai][m] = rstd_of(rsc[ai][m]);
#pragma unroll
        for (int ai = 0; ai < 2; ++ai)
#pragma unroll
            for (int m = 0; m < 4; ++m) {
                const int r = u.pm * 256 + ai * 128 + wr * 64 + m * 16 + fr;
                const float rs = rsc[ai][m]; const f32x2 rs2 = {rs * rs, rs * rs}, nrl = {rs * -1.4426950408889634f, rs * -1.4426950408889634f}, one = {1.0f, 1.0f};
                unsigned w[4];
#pragma unroll
                for (int n = 0; n < 2; ++n)
#pragma unroll
                    for (int e = 0; e < 4; e += 2) {
                        const f32x2 g = {acc[ai][0][m][n][e], acc[ai][0][m][n][e + 1]}, uu = {acc[ai][1][m][n][e], acc[ai][1][m][n][e + 1]};
                        const f32x2 t = g * nrl; f32x2 ex; ex.x = __builtin_amdgcn_exp2f(t.x); ex.y = __builtin_amdgcn_exp2f(t.y);
                        const f32x2 dn = ex + one; f32x2 rc; rc.x = __builtin_amdgcn_rcpf(dn.x); rc.y = __builtin_amdgcn_rcpf(dn.y);
                        const f32x2 o2 = ((g * uu) * rs2) * rc;
                        w[n * 2 + (e >> 1)] = cvt_pk_bf16(o2.x, o2.y);
                    }
                u32x4 o; o.x = w[0]; o.y = w[1]; o.z = w[2]; o.w = w[3];
                if (r < T) gstore((u32x4*)(act + (size_t)r * DFF + col), o);
            }
    }
};
struct EpiScale {
    static constexpr bool PERM = true, AFTER_DRAIN = false;
    bf16_t* O; int ldc; const float* rss;
    __device__ __forceinline__ void operator()(const f32x4 (&acc)[2][2][4][2], const Unit& u, int wr, int wc, int fr, int fq) const {
        const int col = u.pn * 256 + wc * 32 + fq * 8;
        float rsv[2][4];
#pragma unroll
        for (int ai = 0; ai < 2; ++ai)
#pragma unroll
            for (int m = 0; m < 4; ++m) { const int r = u.pm * 256 + ai * 128 + wr * 64 + m * 16 + fr; { const f32x4 q4 = gload((const f32x4*)(rss + (size_t)min(r, T - 1) * 4)); rsv[ai][m] = (q4[0] + q4[1]) + (q4[2] + q4[3]); } }
#pragma unroll
        for (int ai = 0; ai < 2; ++ai)
#pragma unroll
            for (int m = 0; m < 4; ++m) {
                const int r = u.pm * 256 + ai * 128 + wr * 64 + m * 16 + fr;
                const float rs = rstd_of(rsv[ai][m]);
                if (r < T) {
#pragma unroll
                    for (int bj = 0; bj < 2; ++bj) {
                        const f32x4 v0 = acc[ai][bj][m][0] * rs, v1 = acc[ai][bj][m][1] * rs;
                        u32x4 o; o.x = cvt_pk_bf16(v0[0], v0[1]); o.y = cvt_pk_bf16(v0[2], v0[3]); o.z = cvt_pk_bf16(v1[0], v1[1]); o.w = cvt_pk_bf16(v1[2], v1[3]);
                        gstore((u32x4*)(O + (size_t)r * ldc + col + bj * 128), o);
                    }
                }
            }
    }
};
struct EpiNone {
    static constexpr bool PERM = true, AFTER_DRAIN = false;
    __device__ __forceinline__ void operator()(const f32x4 (&acc)[2][2][4][2], const Unit& u, int wr, int wc, int fr, int fq) const {
#pragma unroll
        for (int ai = 0; ai < 2; ++ai)
#pragma unroll
            for (int bj = 0; bj < 2; ++bj)
#pragma unroll
                for (int m = 0; m < 4; ++m)
#pragma unroll
                    for (int n = 0; n < 2; ++n) asm volatile("" :: "v"(acc[ai][bj][m][n]));
    }
};
template <bool LAST> struct EpiResid {
    static constexpr bool PERM = true, AFTER_DRAIN = false;
    float* out; unsigned char* ws; int half; float* rss4; LAS float* part;
    __device__ __forceinline__ void operator()(const f32x4 (&acc)[2][2][4][2], const Unit& u, int wr, int wc, int fr, int fq) const {
        const int col = u.pn * 256 + wc * 32 + fq * 8;
        bf16_t* hb = (bf16_t*)(ws + OFF_HB);
        u32x4 hv[2][4][2];
#pragma unroll
        for (int ai = 0; ai < 2; ++ai)
#pragma unroll
            for (int m = 0; m < 4; ++m) { const int r = u.pm * 256 + ai * 128 + wr * 64 + m * 16 + fr; const bf16_t* hp = hb + (size_t)min(r, T - 1) * D + col;
#pragma unroll
                for (int bj = 0; bj < 2; ++bj) hv[ai][m][bj] = gload((const u32x4*)(hp + bj * 128)); }
#pragma unroll
        for (int ai = 0; ai < 2; ++ai)
#pragma unroll
            for (int m = 0; m < 4; ++m) {
                const int r = u.pm * 256 + ai * 128 + wr * 64 + m * 16 + fr;
                f32x2 ss2 = {0.f, 0.f}; const float scale = half ? 0.5f : 1.0f; const f32x2 sc2 = {scale, scale};
#pragma unroll
                for (int bj = 0; bj < 2; ++bj) {
                    const u32x4 w = hv[ai][m][bj]; const f32x4 a0 = acc[ai][bj][m][0], a1 = acc[ai][bj][m][1];
                    f32x2 p0 = {bflo(w.x), bfhi(w.x)}, p1 = {bflo(w.y), bfhi(w.y)}, p2 = {bflo(w.z), bfhi(w.z)}, p3 = {bflo(w.w), bfhi(w.w)};
                    p0 += (f32x2){a0[0], a0[1]} * sc2; p1 += (f32x2){a0[2], a0[3]} * sc2; p2 += (f32x2){a1[0], a1[1]} * sc2; p3 += (f32x2){a1[2], a1[3]} * sc2;
                    ss2 += p0 * p0; ss2 += p1 * p1; ss2 += p2 * p2; ss2 += p3 * p3;
                    if (r < T) {
                        u32x4 o; o.x = cvt_pk_bf16(p0.x, p0.y); o.y = cvt_pk_bf16(p1.x, p1.y); o.z = cvt_pk_bf16(p2.x, p2.y); o.w = cvt_pk_bf16(p3.x, p3.y);
                        gstore((u32x4*)(hb + (size_t)r * D + col + bj * 128), o);
                    }
                }
                float ss = ss2.x + ss2.y;
                ss += __shfl_xor(ss, 16); ss += __shfl_xor(ss, 32);
                if (fq == 0) part[(ai * 128 + wr * 64 + m * 16 + fr) * 4 + wc] = ss;
            }
        asm volatile("s_waitcnt lgkmcnt(0)" ::: "memory"); __builtin_amdgcn_s_barrier(); asm volatile("" ::: "memory");
        const int lane = fq * 16 + fr;
        if (lane < 32) { const int rl = (lane >> 4) * 128 + wr * 64 + wc * 16 + (lane & 15), r = u.pm * 256 + rl;
            const f32x4 v = *(const LAS f32x4*)(part + rl * 4);
            if (r < T) gstore(rss4 + (size_t)r * 4 + u.pn, (v[0] + v[1]) + (v[2] + v[3])); }
    }
};
struct EpiDft {
    static constexpr bool PERM = true, AFTER_DRAIN = false;
    bf16_t* X; int L, rowbase;
    __device__ __forceinline__ void operator()(const f32x4 (&acc)[2][2][4][2], const Unit& u, int wr, int wc, int fr, int fq) const {
        const int b = u.pn >> 2, c0 = (u.pn & 3) * 256 + wc * 32 + fq * 8, H = L >> 1;
#pragma unroll
        for (int ai = 0; ai < 2; ++ai)
#pragma unroll
            for (int m = 0; m < 4; ++m) {
                const int kk = u.pm * 256 + ai * 128 + wr * 64 + m * 16 + fr;
                if (kk < L) {
                    const bool isc = kk <= H; const int k = isc ? kk : kk - H; const float sg = isc ? 1.f : -1.f;
                    bf16_t* x0 = X + (size_t)(rowbase + b * L + k) * 2048 + (isc ? 0 : 1024) + c0;
                    bf16_t* x1 = X + (size_t)(rowbase + b * L + (L - k)) * 2048 + (isc ? 0 : 1024) + c0;
                    const bool mir = (k >= 1) && (k < H);
#pragma unroll
                    for (int bj = 0; bj < 2; ++bj) {
                        const f32x4 v0 = acc[ai][bj][m][0] * sg, v1 = acc[ai][bj][m][1] * sg;
                        u32x4 o; o.x = cvt_pk_bf16(v0[0], v0[1]); o.y = cvt_pk_bf16(v0[2], v0[3]); o.z = cvt_pk_bf16(v1[0], v1[1]); o.w = cvt_pk_bf16(v1[2], v1[3]);
                        gstore((u32x4*)(x0 + bj * 128), o);
                        if (mir) { u32x4 q; if (isc) q = o; else { q.x = o.x ^ 0x80008000u; q.y = o.y ^ 0x80008000u; q.z = o.z ^ 0x80008000u; q.w = o.w ^ 0x80008000u; } gstore((u32x4*)(x1 + bj * 128), q); }
                        if (isc && !mir) { u32x4 zz; zz.x = 0; zz.y = 0; zz.z = 0; zz.w = 0; gstore((u32x4*)(x0 + 1024 + bj * 128), zz); }
                    }
                }
            }
    }
};

struct DftOrder : pg8::StaticOrder {
    int cc, GG, mode;
    __device__ void init2(int M, int N, int G_, int c_, int mode_) { init(M, N, 1, 0); cc = c_; GG = G_; mode = mode_; }
    __device__ bool next(int i, Unit& u) const { int L;
        if (mode == 0) { L = i * GG + cc; if (L >= nwg) return false; }
        else if (cc < 32) { if (i >= 3) return false; L = 1056 + cc * 3 + i; }
        else { const int d = cc - 32; if (i < 4) L = i * 224 + d; else if (i == 4 && d < 160) L = 896 + d; else return false; }
        return pg8::StaticOrder::next(L, u); }
};
constexpr int TAIL_L0 = 6 * 256, TAIL_UNITS = (TPAD / 256) * 4 - TAIL_L0;
struct CapOrder : pg8::StaticOrder {
    int cc, GG, cap;
    __device__ void init2(int M, int N, int G_, int c_, int cap_) { init(M, N, 1, 0); cc = c_; GG = G_; cap = cap_; }
    __device__ bool next(int i, Unit& u) const { const int L = i * GG + cc; if (L >= cap) return false; return pg8::StaticOrder::next(L, u); }
};
struct TailOrder : pg8::StaticOrder {
    int tu;
    __device__ void init2(int M, int N, int tu_) { init(M, N, 1, 0); tu = tu_; }
    __device__ bool next(int i, Unit& u) const { if (i != 0) return false; return pg8::StaticOrder::next(TAIL_L0 + tu, u); }
};
struct EpiPartial {
    static constexpr bool PERM = true, AFTER_DRAIN = false;
    float* P;
    __device__ __forceinline__ void operator()(const f32x4 (&acc)[2][2][4][2], const Unit& u, int wr, int wc, int fr, int fq) const {
#pragma unroll
        for (int ai = 0; ai < 2; ++ai)
#pragma unroll
            for (int m = 0; m < 4; ++m) { float* rowp = P + (size_t)(ai * 128 + wr * 64 + m * 16 + fr) * 256 + wc * 32 + fq * 8;
#pragma unroll
                for (int bj = 0; bj < 2; ++bj) { gstore((f32x4*)(rowp + bj * 128), acc[ai][bj][m][0]); gstore((f32x4*)(rowp + bj * 128 + 4), acc[ai][bj][m][1]); } }
    }
};
__device__ __forceinline__ void tail_fixup(unsigned char* ws, int nsl, int half) {
    const float scale = half ? 0.5f : 1.0f;
    const int tid = otid(), lane = tid & 63, gw = blockIdx.x * 8 + (tid >> 6), NGW = gridDim.x * 8;
    bf16_t* hb = (bf16_t*)(ws + OFF_HB); float* rss4 = (float*)(ws + OFF_RSS); const float* P0 = (const float*)(ws + OFF_PART);
    pg8::StaticOrder so; so.init(TPAD, D, 1, 0);
    for (int it = gw; it < TAIL_UNITS * 256; it += NGW) {
        const int tu = it >> 8, rl = it & 255; Unit u; so.next(TAIL_L0 + tu, u);
        const int r = u.pm * 256 + rl, col = u.pn * 256 + lane * 4;
        f32x4 a = {0.f, 0.f, 0.f, 0.f};
        f32x4 pv[11];
#pragma unroll
        for (int sl = 0; sl < 11; ++sl) pv[sl] = gload((const f32x4*)(P0 + ((size_t)(tu * 16 + min(sl, nsl - 1)) * 256 + rl) * 256 + lane * 4));
#pragma unroll
        for (int sl = 0; sl < 11; ++sl) { const float m = sl < nsl ? 1.0f : 0.0f; a += pv[sl] * m; }
        float ss = 0.f;
        if (r < T) { const u32x2 w = gload((const u32x2*)(hb + (size_t)r * D + col));
            f32x4 h; h[0] = bflo(w.x); h[1] = bfhi(w.x); h[2] = bflo(w.y); h[3] = bfhi(w.y); h += a * scale;
            ss = (h[0] * h[0] + h[1] * h[1]) + (h[2] * h[2] + h[3] * h[3]);
            u32x2 o; o.x = cvt_pk_bf16(h[0], h[1]); o.y = cvt_pk_bf16(h[2], h[3]); gstore((u32x2*)(hb + (size_t)r * D + col), o); }
        ss = wave_sum(ss);
        if (lane == 0 && r < T) rss4[(size_t)r * 4 + u.pn] = ss;
    }
}
struct LocalOrder : pg8::StaticOrder { __device__ bool next(int i, Unit& u) const { const bool ok = pg8::StaticOrder::next(i, u); u.pm &= 7; return ok; } };
template <class Epi>
__device__ __forceinline__ void run_gemm(LAS unsigned char* lds, const bf16_t* A, const bf16_t* Bt, int M, int N, int K, const Epi& E, int c) {
    pg8::Gemm g; g.A = A; g.Bt = Bt; g.M = M; g.N = N; g.K = K; g.ld = K;
    pg8::StaticOrder S; S.init(M, N, (int)gridDim.x, c);
    pg8::gemm_phase<Epi, pg8::StaticOrder, false>(lds, g, S, E, nullptr);
}

__device__ __forceinline__ void transpose_item(const float* W, int N, const float* gain, bf16_t* WT, int ldd, int k0, int n0, int drow0, LAS float* scr, int lane, float osc = 1.0f) {
#pragma unroll
    for (int i = 0; i < 32; ++i) { const int kk = 2 * i + (lane >> 5); f32x2 v = *(const f32x2*)(W + (size_t)(k0 + kk) * N + n0 + 2 * (lane & 31)); if (gain) v *= gain[k0 + kk] * osc; *(LAS f32x2*)(scr + kk * 66 + 2 * (lane & 31)) = v; }
    asm volatile("s_waitcnt lgkmcnt(0)" ::: "memory");
    const int c = lane & 7;
#pragma unroll
    for (int jj = 0; jj < 8; ++jj) { const int n = (lane >> 3) + 8 * jj; const LAS float* sp = scr + (8 * c) * 66 + n;
        u32x4 o; o.x = cvt_pk_bf16(sp[0 * 66], sp[1 * 66]); o.y = cvt_pk_bf16(sp[2 * 66], sp[3 * 66]); o.z = cvt_pk_bf16(sp[4 * 66], sp[5 * 66]); o.w = cvt_pk_bf16(sp[6 * 66], sp[7 * 66]);
        *(u32x4*)(WT + (size_t)(drow0 + n) * ldd + k0 + 8 * c) = o; }
    asm volatile("s_waitcnt lgkmcnt(0)" ::: "memory");
}
__device__ __forceinline__ void dft_item(bf16_t* Dm, int L, int LP, int witem, int lane) {
    const int cpr = LP >> 3, H = L >> 1; const int tix = witem * 64 + lane; const int kk = tix / cpr, c8 = tix - kk * cpr;
    const bool isc = kk <= H; const int k = isc ? kk : kk - H;
    const float sc = rsqrtf((float)L), invL = 1.0f / (float)L;
    int mm = (k * (c8 * 8)) % L;
    unsigned w[4];
#pragma unroll
    for (int e = 0; e < 8; e += 2) {
        float v[2];
#pragma unroll
        for (int q = 0; q < 2; ++q) { const int n = c8 * 8 + e + q; const float a = (float)mm * invL;
            const float x = (isc ? __builtin_amdgcn_cosf(a) : __builtin_amdgcn_sinf(a)) * sc;
            v[q] = (kk < L && n < L) ? x : 0.f;
            mm += k; mm = mm >= L ? mm - L : mm; }
        w[e >> 1] = cvt_pk_bf16(v[0], v[1]);
    }
    u32x4 o; o.x = w[0]; o.y = w[1]; o.z = w[2]; o.w = w[3];
    *(u32x4*)(Dm + (size_t)kk * LP + c8 * 8) = o;
}
__device__ __forceinline__ void prep_phase(const Params& p, LAS unsigned char* lds) {
    const int tid = otid(), lane = tid & 63, wave = __builtin_amdgcn_readfirstlane(tid >> 6);
    const int gw = blockIdx.x * 8 + wave, NGW = gridDim.x * 8;
    LAS float* scr = (LAS float*)(lds + wave * 16896);
    LAS float* tab = (LAS float*)(lds + 8 * 16896);
    if (tid < 256) { tab[tid] = cospif((float)tid * (1.0f / 128.0f)); tab[256 + tid] = sinpif((float)tid * (1.0f / 128.0f)); }
    __syncthreads();
    if (blockIdx.x == 0) { float* sm = (float*)(p.ws + OFF_SMALL); if (tid < 8) sm[tid] = p.in[9][tid]; for (int i = tid; i < 1024; i += 512) { sm[1024 + i] = p.in[7][D + i]; sm[2048 + i] = p.in[18][i]; } }
    bf16_t* Wgu = (bf16_t*)(p.ws + OFF_WGU); bf16_t* Wd = (bf16_t*)(p.ws + OFF_WD); bf16_t* Win = (bf16_t*)(p.ws + OFF_WIN);
    bf16_t* Wo = (bf16_t*)(p.ws + OFF_WO); bf16_t* W2t = (bf16_t*)(p.ws + OFF_W2T);
    constexpr int I_G = 16 * 44, I_D = 44 * 16;
    constexpr int N_TR_FFN = 4 * (2 * I_G + I_D);
    constexpr int I_IN = 16 * 20, I_WO = 8 * 16;
    constexpr int R0 = N_TR_FFN, R1 = R0 + I_IN, R2 = R1 + I_WO;
    constexpr int N_W3 = 256 * 8, N_W2 = 128 * 32;
    constexpr int R3 = R2 + N_W3, R4 = R3 + N_W2;
    constexpr int N_D1 = MPA * (LPA / 8) / 64, N_D2 = MPB * (LPB / 8) / 64;
    constexpr int R5 = R4 + N_D1, R6 = R5 + N_D2, R7 = R6 + T / 2;
    for (int it = gw; it < R7; it += NGW) {
        if (it < R0) {
            const int f = it / (2 * I_G + I_D); int r = it - f * (2 * I_G + I_D); const int layer = f >> 1, which = f & 1;
            if (r < 2 * I_G) { const int up = r >= I_G; if (up) r -= I_G;
                const float* src = p.in[which ? (up ? 16 : 15) : (up ? 5 : 4)] + (size_t)layer * D * DFF;
                const float* gain = p.in[which ? 14 : 3] + layer * D;
                const int kb = r / 44, nb = r - kb * 44, n0 = nb * 64;
                const int drow0 = (n0 >> 7) * 256 + (up ? 128 : 0) + (n0 & 127);
                transpose_item(src, DFF, gain, Wgu + (size_t)f * NGU * D, D, kb * 64, n0, drow0, scr, lane);
            } else { r -= 2 * I_G;
                const float* src = p.in[which ? 17 : 6] + (size_t)layer * DFF * D;
                const int kb = r / 16, nb = r - kb * 16;
                transpose_item(src, D, nullptr, Wd + (size_t)f * D * DFF, DFF, kb * 64, nb * 64, nb * 64, scr, lane);
            }
        } else if (it < R1) { const int r = it - R0, kb = r / 20, nb = r - kb * 20;
            transpose_item(p.in[8], INDIM, p.in[7], Win, D, kb * 64, nb * 64, nb * 64, scr, lane, nb < 8 ? 0.125f : 1.0f);
        } else if (it < R2) { const int r = it - R1, kb = r / 16, nb = r - kb * 16;
            transpose_item(p.in[12], D, nullptr, Wo, D, kb * 64, nb * 64, nb * 64, scr, lane);
        } else if (it < R3) {
            const int r = it - R2, j = (r & 255) * 4, kb = r >> 8, kk = kb * 64 + lane, g = kk >> 7, c = kk & 127;
            const float* pw = p.in[10] + (size_t)(g * 128 + c) * 128; const float* ps = p.in[11] + g * 128; const float* wo = p.in[12] + (size_t)(512 + g * 128) * D + j;
            f32x4 a = {0.f, 0.f, 0.f, 0.f};
#pragma unroll 16
            for (int d = 0; d < 128; ++d) { const f32x4 w = *(const f32x4*)(wo + (size_t)d * D); a += w * (pw[d] * ps[d]); }
#pragma unroll
            for (int q = 0; q < 4; ++q) Wo[(size_t)(j + q) * D + 512 + kk] = f2bf(a[q]);
        } else if (it < R4) {
            const int r = it - R3, j = (r & 127) * 8, kb = r >> 7, kk = kb * 64 + lane, part = kk >> 10, k2 = kk & 1023, g = k2 >> 8, c = k2 & 255;
            const float* wf = p.in[13] + (size_t)(g * 256) * D + j; const LAS float* tb = tab + part * 256;
            f32x4 a0 = {0.f, 0.f, 0.f, 0.f}, a1 = {0.f, 0.f, 0.f, 0.f};
#pragma unroll 8
            for (int d = 0; d < 256; ++d) { const f32x4 w0 = *(const f32x4*)(wf + (size_t)d * D), w1 = *(const f32x4*)(wf + (size_t)d * D + 4); const float t = tb[(c * d) & 255]; a0 += w0 * t; a1 += w1 * t; }
#pragma unroll
            for (int q = 0; q < 4; ++q) { W2t[(size_t)(j + q) * 2048 + kk] = f2bf(a0[q] * 0.0625f); W2t[(size_t)(j + 4 + q) * 2048 + kk] = f2bf(a1[q] * 0.0625f); }
        } else if (it < R5) { dft_item((bf16_t*)(p.ws + OFF_D1), LA, LPA, it - R4, lane);
        } else if (it < R6) { dft_item((bf16_t*)(p.ws + OFF_D2), LB, LPB, it - R5, lane);
        } else {
            const int r0 = (it - R6) * 2; const float* src[2]; f32x4 v[2][4];
#pragma unroll
            for (int q = 0; q < 2; ++q) { int gb, l, L, rb; row_decode(r0 + q, gb, l, L, rb);
                src[q] = (l < 16) ? p.in[2] + (size_t)l * D : (gb < NBA ? p.in[0] + ((size_t)gb * 4096 + (l - 16)) * D : p.in[1] + ((size_t)(gb - NBA) * 2048 + (l - 16)) * D); }
#pragma unroll
            for (int q = 0; q < 2; ++q)
#pragma unroll
                for (int i = 0; i < 4; ++i) v[q][i] = *(const f32x4*)(src[q] + (lane + 64 * i) * 4);
            float* rss0 = (float*)(p.ws + OFF_RSS);
#pragma unroll
            for (int q = 0; q < 2; ++q) { bf16_t* hb = (bf16_t*)(p.ws + OFF_HB) + (size_t)(r0 + q) * D; float ss = 0.f;
#pragma unroll
                for (int i = 0; i < 4; ++i) { ss += (v[q][i][0] * v[q][i][0] + v[q][i][1] * v[q][i][1]) + (v[q][i][2] * v[q][i][2] + v[q][i][3] * v[q][i][3]);
                    u32x2 o; o.x = cvt_pk_bf16(v[q][i][0], v[q][i][1]); o.y = cvt_pk_bf16(v[q][i][2], v[q][i][3]); *(u32x2*)(hb + (lane + 64 * i) * 4) = o; }
                ss = wave_sum(ss);
                if (lane == 0) { f32x4 q4 = {ss, 0.f, 0.f, 0.f}; *(f32x4*)(rss0 + (size_t)(r0 + q) * 4) = q4; } }
        }
    }
}

template <int HW> __device__ __forceinline__ void pool_item(const bf16_t* z, bf16_t* ap, int r, int ch) {
    int gb, l, L, rb; row_decode(r, gb, l, L, rb);
    const bf16_t* base = z + (size_t)r * INDIM + 768 + ch * 8;
    u32x4 v[2 * HW + 1];
#pragma unroll
    for (int o = 0; o <= 2 * HW; ++o) { const int s = l - HW + o; u32x4 t; t.x = 0; t.y = 0; t.z = 0; t.w = 0; if (s >= 0 && s < L) t = gload((const u32x4*)(base + (long)(o - HW) * INDIM)); v[o] = t; }
    float s0 = 0.f, s1 = 0.f, s2 = 0.f, s3 = 0.f, s4 = 0.f, s5 = 0.f, s6 = 0.f, s7 = 0.f;
#pragma unroll
    for (int o = 1; o < 2 * HW; ++o) { s0 += bflo(v[o].x); s1 += bfhi(v[o].x); s2 += bflo(v[o].y); s3 += bfhi(v[o].y); s4 += bflo(v[o].z); s5 += bfhi(v[o].z); s6 += bflo(v[o].w); s7 += bfhi(v[o].w); }
#pragma unroll
    for (int q = 0; q < 2; ++q) {
        const u32x4 ex = v[q ? 2 * HW : 0], me = v[HW + q]; const int lq = l + q;
        const float ic = 1.0f / (float)(min(lq + HW, L) - max(lq - HW, 0));
        u32x4 o; o.x = cvt_pk_bf16((s0 + bflo(ex.x)) * ic - bflo(me.x), (s1 + bfhi(ex.x)) * ic - bfhi(me.x)); o.y = cvt_pk_bf16((s2 + bflo(ex.y)) * ic - bflo(me.y), (s3 + bfhi(ex.y)) * ic - bfhi(me.y));
        o.z = cvt_pk_bf16((s4 + bflo(ex.z)) * ic - bflo(me.z), (s5 + bfhi(ex.z)) * ic - bfhi(me.z)); o.w = cvt_pk_bf16((s6 + bflo(ex.w)) * ic - bflo(me.w), (s7 + bfhi(ex.w)) * ic - bfhi(me.w));
        gstore((u32x4*)(ap + (size_t)(r + q) * D + 512 + ch * 8), o);
    }
}
struct PW { unsigned char* ws; float* out; };
__device__ __forceinline__ void attn_phase(const PW& p, LAS unsigned char* lds) {
    const bf16_t* z = (const bf16_t*)(p.ws + OFF_Z); bf16_t* ap = (bf16_t*)(p.ws + OFF_AP); const float* sink = (const float*)(p.ws + OFF_SMALL);
    const int tid = otid(), lane = tid & 63, wave = __builtin_amdgcn_readfirstlane(tid >> 6), fr = lane & 15, fq = lane >> 4;
    LAS unsigned char* Ks = lds;
    LAS unsigned char* Vt = lds + 55296;
    constexpr int NU = (NBA * 33 + NBB * 17) * 2;
    for (int unit = blockIdx.x; unit < NU; unit += gridDim.x) {
        const int kvh = unit & 1; int tt = unit >> 1; int sb, ti, L, rb;
        if (tt < NBA * 33) { sb = tt / 33; ti = tt - sb * 33; L = LA; rb = sb * LA; } else { tt -= NBA * 33; sb = tt / 17; ti = tt - sb * 17; L = LB; rb = TA + sb * LB; }
        const int l0 = ti * 128;
        __syncthreads();
        {
            typedef __attribute__((address_space(1))) const u32x4 gu32x4;
            u32x4 kreg[6], vreg[7];
#pragma unroll
            for (int i = 0; i < 6; ++i) { const int idx = tid + 512 * i, j = idx >> 3, ch = idx & 7, s = l0 - 128 + j; const bool ok = (s >= 0) && (s < L);
                kreg[i] = *(gu32x4*)(z + (size_t)(rb + (ok ? s : 0)) * INDIM + 512 + kvh * 64 + ch * 8); }
#pragma unroll
            for (int i = 0; i < 7; ++i) { const int idx = tid + 512 * i, ch = min(idx / 400, 7), j = idx - (idx / 400) * 400, s = l0 - 128 + j; const bool ok = (idx < 3200) && (j < 384) && (s >= 0) && (s < L);
                vreg[i] = *(gu32x4*)(z + (size_t)(rb + (ok ? s : 0)) * INDIM + 640 + kvh * 64 + ch * 8); }
            __builtin_amdgcn_sched_barrier(0);
#pragma unroll
            for (int i = 0; i < 6; ++i) { const int idx = tid + 512 * i, j = idx >> 3, s = l0 - 128 + j; const bool ok = (s >= 0) && (s < L);
                kreg[i].x = ok ? kreg[i].x : 0u; kreg[i].y = ok ? kreg[i].y : 0u; kreg[i].z = ok ? kreg[i].z : 0u; kreg[i].w = ok ? kreg[i].w : 0u; }
#pragma unroll
            for (int i = 0; i < 7; ++i) { const int idx = tid + 512 * i, j = idx - (idx / 400) * 400, s = l0 - 128 + j; const bool ok = (idx < 3200) && (j < 384) && (s >= 0) && (s < L);
                vreg[i].x = ok ? vreg[i].x : 0u; vreg[i].y = ok ? vreg[i].y : 0u; vreg[i].z = ok ? vreg[i].z : 0u; vreg[i].w = ok ? vreg[i].w : 0u; }
#pragma unroll
            for (int i = 0; i < 6; ++i) { const int idx = tid + 512 * i, j = idx >> 3, ch = idx & 7; *(LAS u32x4*)(Ks + j * 144 + ch * 16) = kreg[i]; }
#pragma unroll
            for (int i = 0; i < 7; ++i) { const int idx = tid + 512 * i; if (idx < 3200) { const int ch = idx / 400, j = idx - ch * 400; const u32x4 v = vreg[i];
                LAS bf16_t* dst = (LAS bf16_t*)Vt + (ch * 8) * 408 + j;
                dst[0 * 408] = (bf16_t)(v.x & 0xFFFFu); dst[1 * 408] = (bf16_t)(v.x >> 16); dst[2 * 408] = (bf16_t)(v.y & 0xFFFFu); dst[3 * 408] = (bf16_t)(v.y >> 16);
                dst[4 * 408] = (bf16_t)(v.z & 0xFFFFu); dst[5 * 408] = (bf16_t)(v.z >> 16); dst[6 * 408] = (bf16_t)(v.w & 0xFFFFu); dst[7 * 408] = (bf16_t)(v.w >> 16); } }
        }
        __syncthreads();
        const int lq0 = l0 + 16 * wave + fr;
        if (l0 + 16 * wave < L) {
#pragma unroll 1
            for (int g = 0; g < 4; ++g) {
                int lq = lq0; asm volatile("" : "+v"(lq)); const bool qok = lq < L;
                const int h = kvh * 4 + g; const float slope = exp2f(-(float)(h + 1)); const float sk = gload(sink + h);
                bf16x8 qf[2];
#pragma unroll
                for (int kk = 0; kk < 2; ++kk) { u32x4 q; q.x = 0; q.y = 0; q.z = 0; q.w = 0; if (qok) q = gload((const u32x4*)(z + (size_t)(rb + lq) * INDIM + h * 64 + kk * 32 + fq * 8)); qf[kk] = __builtin_bit_cast(bf16x8, q); }
                f32x4 sc[17];
#pragma unroll
                for (int t = 0; t < 17; ++t) { f32x4 a = {0.f, 0.f, 0.f, 0.f};
#pragma unroll
                    for (int kk = 0; kk < 2; ++kk) { const bf16x8 kf = *(const LAS bf16x8*)(Ks + (16 * wave + 16 * t + fr) * 144 + (kk * 32 + fq * 8) * 2); a = __builtin_amdgcn_mfma_f32_16x16x32_bf16(kf, qf[kk], a, 0, 0, 0); }
                    sc[t] = a; __builtin_amdgcn_sched_barrier(0); }
                float mx = -1e30f;
                int db = 128 + fr - 4 * fq, lob = 128 - l0 - 16 * wave - 4 * fq; asm volatile("" : "+v"(db), "+v"(lob));
#pragma unroll
                for (int t = 0; t < 17; ++t)
#pragma unroll
                    for (int e = 0; e < 4; ++e) { const int off = 16 * t + e; const int dist = abs(db - off);
                        bool valid = (unsigned)(off - lob) < (unsigned)L;
                        if (t == 0 || t == 16) valid = valid && (dist <= 128);
                        const float v = valid ? fmaf(-slope, (float)dist, sc[t][e]) : -1e30f; sc[t][e] = v; mx = fmaxf(mx, v); }
                mx = fmaxf(mx, __shfl_xor(mx, 16)); mx = fmaxf(mx, __shfl_xor(mx, 32)); mx = fmaxf(mx, sk);
                float sum = 0.f;
#pragma unroll
                for (int t = 0; t < 17; ++t)
#pragma unroll
                    for (int e = 0; e < 4; ++e) { const float pv = __expf(sc[t][e] - mx); sc[t][e] = pv; sum += pv; }
                sum += __shfl_xor(sum, 16); sum += __shfl_xor(sum, 32); sum += __expf(sk - mx);
                const float inv = 1.0f / sum;
                f32x4 o[4];
#pragma unroll
                for (int dt = 0; dt < 4; ++dt) o[dt] = (f32x4){0.f, 0.f, 0.f, 0.f};
#pragma unroll
                for (int u = 0; u < 9; ++u) {
                    u32x4 pw; pw.x = cvt_pk_bf16(sc[2 * u][0], sc[2 * u][1]); pw.y = cvt_pk_bf16(sc[2 * u][2], sc[2 * u][3]);
                    if (2 * u + 1 < 17) { pw.z = cvt_pk_bf16(sc[(2 * u + 1) % 17][0], sc[(2 * u + 1) % 17][1]); pw.w = cvt_pk_bf16(sc[(2 * u + 1) % 17][2], sc[(2 * u + 1) % 17][3]); } else { pw.z = 0; pw.w = 0; }
                    const bf16x8 pf = __builtin_bit_cast(bf16x8, pw);
#pragma unroll
                    for (int dt = 0; dt < 4; ++dt) { const LAS unsigned char* vp = Vt + (16 * dt + fr) * 816 + (16 * wave + 32 * u + 4 * fq) * 2;
                        const u32x2 lo = *(const LAS u32x2*)vp, hi = *(const LAS u32x2*)(vp + 32); u32x4 vv; vv.x = lo.x; vv.y = lo.y; vv.z = hi.x; vv.w = hi.y;
                        o[dt] = __builtin_amdgcn_mfma_f32_16x16x32_bf16(__builtin_bit_cast(bf16x8, vv), pf, o[dt], 0, 0, 0); }
                    __builtin_amdgcn_sched_barrier(0);
                }
                if (qok) {
#pragma unroll
                    for (int dt = 0; dt < 4; ++dt) { u32x2 w; w.x = cvt_pk_bf16(o[dt][0] * inv, o[dt][1] * inv); w.y = cvt_pk_bf16(o[dt][2] * inv, o[dt][3] * inv);
                        gstore((u32x2*)(ap + (size_t)(rb + lq) * D + h * 64 + 16 * dt + 4 * fq), w); }
                }
            }
        }
    }
    constexpr int PER_G = (T / 2) * 16;
    for (int it = blockIdx.x * 512 + tid; it < 4 * PER_G; it += gridDim.x * 512) {
        const int g = it / PER_G, rem = it - g * PER_G, r = (rem >> 4) * 2, ch = g * 16 + (rem & 15);
        if (g == 0) pool_item<1>(z, ap, r, ch); else if (g == 1) pool_item<2>(z, ap, r, ch); else if (g == 2) pool_item<4>(z, ap, r, ch); else pool_item<8>(z, ap, r, ch);
    }
}

__device__ __forceinline__ void normT_phase(const PW& p, LAS unsigned char* lds) {
    const int tid = otid(), lane = tid & 63, wave = __builtin_amdgcn_readfirstlane(tid >> 6);
    const float* gain = (const float*)(p.ws + OFF_SMALL) + 1024; bf16_t* HNT = (bf16_t*)(p.ws + OFF_HNT);
    LAS bf16_t* Tt = (LAS bf16_t*)lds;
    constexpr int NUA = NBA * (LPA / 64), NU = NUA + NBB * (LPB / 64);
    for (int unit = blockIdx.x; unit < NU; unit += gridDim.x) {
        int sb, ti, L, LP, rb; bf16_t* dst;
        if (unit < NUA) { sb = unit / (LPA / 64); ti = unit - sb * (LPA / 64); L = LA; LP = LPA; rb = sb * LA; dst = HNT + (size_t)sb * D * LPA; }
        else { const int uu = unit - NUA; sb = uu / (LPB / 64); ti = uu - sb * (LPB / 64); L = LB; LP = LPB; rb = TA + sb * LB; dst = HNT + HNT_B + (size_t)sb * D * LPB; }
        const int l0 = ti * 64;
        __syncthreads();
        {
            unsigned raw[8][8]; float rs[8];
#pragma unroll
            for (int rr = 0; rr < 8; ++rr) { const int l = l0 + wave * 8 + rr; const bool ok = l < L;
                const unsigned* hp = (const unsigned*)((const bf16_t*)(p.ws + OFF_HB) + (size_t)(rb + min(l, L - 1)) * D);
#pragma unroll
                for (int i = 0; i < 8; ++i) { unsigned t = gload(hp + lane + 64 * i); raw[rr][i] = ok ? t : 0u; } }
#pragma unroll
            for (int rr = 0; rr < 8; ++rr) { float ss = 0.f;
#pragma unroll
                for (int i = 0; i < 8; ++i) { const float a = bflo(raw[rr][i]), b = bfhi(raw[rr][i]); ss += a * a + b * b; }
                ss = wave_sum(ss); rs[rr] = __builtin_amdgcn_rsqf(ss * (1.0f / 1024.0f) + 1e-6f); }
            LAS unsigned* TtW = (LAS unsigned*)lds;
#pragma unroll
            for (int i = 0; i < 8; ++i) { const float g0 = gain[2 * lane + 128 * i], g1 = gain[2 * lane + 128 * i + 1]; const int c0 = 2 * lane + 128 * i;
#pragma unroll
                for (int q = 0; q < 4; ++q) {
                    TtW[c0 * 33 + wave * 4 + q] = cvt_pk_bf16(bflo(raw[2 * q][i]) * rs[2 * q] * g0, bflo(raw[2 * q + 1][i]) * rs[2 * q + 1] * g0);
                    TtW[(c0 + 1) * 33 + wave * 4 + q] = cvt_pk_bf16(bfhi(raw[2 * q][i]) * rs[2 * q] * g1, bfhi(raw[2 * q + 1][i]) * rs[2 * q + 1] * g1); } }
        }
        __syncthreads();
#pragma unroll 8
        for (int i = 0; i < 64; ++i) { const int idx = tid + 512 * i; const int c = idx >> 5, pr = idx & 31;
            const unsigned v = *(const LAS unsigned*)(Tt + c * 66 + 2 * pr); gstore((unsigned*)(dst + (size_t)c * LP + l0 + 2 * pr), v); }
    }
}

__device__ __forceinline__ void final_phase(const PW& p) {
    const int tid = otid(); const int lane = tid & 63, gw = blockIdx.x * 8 + (tid >> 6), NGW = gridDim.x * 8; const float* gf = (const float*)(p.ws + OFF_SMALL) + 2048;
    const bf16_t* hb = (const bf16_t*)(p.ws + OFF_HB); const float* rss = (const float*)(p.ws + OFF_RSS);
    f32x4 gv[4];
#pragma unroll
    for (int i = 0; i < 4; ++i) gv[i] = *(const f32x4*)(gf + lane * 8 + 512 * (i >> 1) + 4 * (i & 1));
    for (int row = gw; row < 98304; row += NGW) {
        int r; if (row < NBA * 4096) { const int gb = row >> 12; r = row + 16 * (gb + 1); } else { const int o2 = row - NBA * 4096, b = o2 >> 11; r = TA + b * LB + 16 + (o2 - (b << 11)); }
        const f32x4 q4 = gload((const f32x4*)(rss + (size_t)r * 4)); const float rs = rstd_of((q4[0] + q4[1]) + (q4[2] + q4[3]));
        const bf16_t* hp = hb + (size_t)r * D; float* op = p.out + (size_t)row * D;
        const u32x4 w0 = gload((const u32x4*)(hp + lane * 8)), w1 = gload((const u32x4*)(hp + 512 + lane * 8));
        f32x4 a, b2, c2, d2;
        a[0] = bflo(w0.x); a[1] = bfhi(w0.x); a[2] = bflo(w0.y); a[3] = bfhi(w0.y); b2[0] = bflo(w0.z); b2[1] = bfhi(w0.z); b2[2] = bflo(w0.w); b2[3] = bfhi(w0.w);
        c2[0] = bflo(w1.x); c2[1] = bfhi(w1.x); c2[2] = bflo(w1.y); c2[3] = bfhi(w1.y); d2[0] = bflo(w1.z); d2[1] = bfhi(w1.z); d2[2] = bflo(w1.w); d2[3] = bfhi(w1.w);
        gstore((f32x4*)(op + lane * 8), a * rs * gv[0]); gstore((f32x4*)(op + lane * 8 + 4), b2 * rs * gv[1]);
        gstore((f32x4*)(op + 512 + lane * 8), c2 * rs * gv[2]); gstore((f32x4*)(op + 512 + lane * 8 + 4), d2 * rs * gv[3]);
    }
}

enum { K_PREP = 0, K_GGU, K_DOWN, K_GZ, K_ATTN, K_APO, K_NORMT, K_DFT, K_FO, K_FINAL };
#ifndef REP_PREP
#define REP_PREP 1
#endif
__global__ void __launch_bounds__(512, 2) mega_fwd(Params p0) {
    extern __shared__ __attribute__((aligned(16))) unsigned char shm[];
    LAS unsigned char* lds = (LAS unsigned char*)shm;
    cg::grid_group grid = cg::this_grid();
    volatile LAS unsigned* xst = (volatile LAS unsigned*)(lds + (LDS_BYTES - 16));
    if (threadIdx.x == 0) { xst[0] = 0u; xst[1] = 0u; }
    __syncthreads();
    XcdBarrier xb = xcd_barrier_post((unsigned*)(p0.ws + OFF_BAR), xst);
    const int nrep = REP_PREP + (p0.out == nullptr ? 1 : 0);
#pragma unroll 1
    for (int rep = 0; rep < nrep; ++rep) { prep_phase(p0, lds); grid.sync(); }
#ifdef PROBE_SLEEP_TICKS
    { const unsigned long long t0 = __builtin_amdgcn_s_memrealtime(); while (__builtin_amdgcn_s_memrealtime() - t0 < (unsigned long long)PROBE_SLEEP_TICKS) __builtin_amdgcn_s_sleep(32); }
#endif
    PW p; p.ws = p0.ws; p.out = p0.out;
    { unsigned long long w = (unsigned long long)p.ws, o = (unsigned long long)p.out; asm volatile("" : "+s"(w), "+s"(o)); p.ws = (unsigned char*)w; p.out = (float*)o; }
#pragma unroll 1
    for (int ph = 1; ph < 16; ++ph) {
        int kind, f = 0, rbuf = 0;
        switch (ph) {
            case 0: kind = K_PREP; break;
            case 1: kind = K_GGU; f = 0; rbuf = 0; break;
            case 2: kind = K_DOWN; f = 0; rbuf = 1; break;
            case 3: kind = K_GZ; rbuf = 1; break;
            case 4: kind = K_ATTN; break;
            case 5: kind = K_APO; rbuf = 0; break;
            case 6: kind = K_GGU; f = 1; rbuf = 0; break;
            case 7: kind = K_DOWN; f = 1; rbuf = 1; break;
            case 8: kind = K_GGU; f = 2; rbuf = 1; break;
            case 9: kind = K_DOWN; f = 2; rbuf = 0; break;
            case 10: kind = K_NORMT; break;
            case 11: kind = K_DFT; break;
            case 12: kind = K_FO; rbuf = 1; break;
            case 13: kind = K_GGU; f = 3; rbuf = 1; break;
            case 14: kind = K_DOWN; f = 3; rbuf = 0; break;
            default: kind = K_FINAL; break;
        }
        const int c = (int)blockIdx.x;
        if (kind == K_PREP) {
        } else if (kind == K_GGU) {
#ifndef NO_GGU
            EpiGateUp E; E.act = (bf16_t*)(p.ws + OFF_ACT); E.rss = (const float*)(p.ws + OFF_RSS);
#ifndef REP_GGU
#define REP_GGU 1
#endif
#pragma unroll 1
            for (int rep = 0; rep < REP_GGU; ++rep) {
            run_gemm(lds, (const bf16_t*)(p.ws + OFF_HB), (const bf16_t*)(p.ws + OFF_WGU) + (size_t)f * NGU * D, TPAD, NGU, D, E, c);
            if (rep + 1 < REP_GGU) grid.sync(); }
#ifdef PROBE_KLOOP
            xcd_barrier(xb); { EpiNone EN; pg8::Gemm g; g.A = (const bf16_t*)(p.ws + OFF_HB); g.Bt = (const bf16_t*)(p.ws + OFF_WGU) + (size_t)f * NGU * D; g.M = TPAD; g.N = NGU; g.K = D; g.ld = D;
#if PROBE_KLOOP == 2
              LocalOrder S;
#else
              pg8::StaticOrder S;
#endif
              S.init(TPAD, NGU, (int)gridDim.x, c); pg8::gemm_phase<EpiNone, decltype(S), false>(lds, g, S, EN, nullptr); }
#endif
#endif
        } else if (kind == K_DOWN || kind == K_APO || kind == K_FO) {
#ifndef NO_GRES
            const bf16_t* A; const bf16_t* Bt; int K; float scale;
            if (kind == K_DOWN) { A = (const bf16_t*)(p.ws + OFF_ACT); Bt = (const bf16_t*)(p.ws + OFF_WD) + (size_t)f * D * DFF; K = DFF; scale = 0.5f; }
            else if (kind == K_APO) { A = (const bf16_t*)(p.ws + OFF_AP); Bt = (const bf16_t*)(p.ws + OFF_WO); K = D; scale = 1.0f; }
            else { A = (const bf16_t*)(p.ws + OFF_X); Bt = (const bf16_t*)(p.ws + OFF_W2T); K = 2048; scale = 1.0f; }
            { EpiResid<false> E; E.out = p.out; E.ws = p.ws; E.half = (kind == K_DOWN); E.rss4 = (float*)(p.ws + OFF_RSS); E.part = (LAS float*)(lds + 131072);
              pg8::Gemm g; g.A = A; g.Bt = Bt; g.M = TPAD; g.N = D; g.K = K; g.ld = K;
              const bool split = (int)gridDim.x == 256 && K >= 2048;
              CapOrder S; S.init2(TPAD, D, (int)gridDim.x, c, split ? TAIL_L0 : (TPAD / 256) * 4);
              pg8::gemm_phase<EpiResid<false>, CapOrder, false>(lds, g, S, E, nullptr);
              if (split) {
                  const int nsl = K / 256;
                  if (c < TAIL_UNITS * nsl) { const int tu = c / nsl, sl = c - tu * nsl;
                      EpiPartial EP; EP.P = (float*)(p.ws + OFF_PART) + (size_t)(tu * 16 + sl) * 65536;
                      pg8::Gemm g2; g2.A = A + sl * 256; g2.Bt = Bt + sl * 256; g2.M = TPAD; g2.N = D; g2.K = K / nsl; g2.ld = K;
                      TailOrder S2; S2.init2(TPAD, D, tu);
                      pg8::gemm_phase<EpiPartial, TailOrder, false>(lds, g2, S2, EP, nullptr); }
                  xcd_barrier(xb);
                  tail_fixup(p.ws, nsl, kind == K_DOWN);
              } }
#endif
        } else if (kind == K_GZ) {
#ifndef NO_GZ
            EpiScale E; E.O = (bf16_t*)(p.ws + OFF_Z); E.ldc = INDIM; E.rss = (const float*)(p.ws + OFF_RSS);
            run_gemm(lds, (const bf16_t*)(p.ws + OFF_HB), (const bf16_t*)(p.ws + OFF_WIN), TPAD, INDIM, D, E, c);
#endif
        } else if (kind == K_ATTN) {
#ifndef REP_ATTN
#define REP_ATTN 1
#endif
            for (int rep = 0; rep < REP_ATTN; ++rep) { attn_phase(p, lds); if (rep + 1 < REP_ATTN) grid.sync(); }
        } else if (kind == K_NORMT) {
#ifndef REP_NORMT
#define REP_NORMT 1
#endif
            for (int rep = 0; rep < REP_NORMT; ++rep) { normT_phase(p, lds); if (rep + 1 < REP_NORMT) grid.sync(); }
        } else if (kind == K_DFT) {
#ifndef NO_GDFT
#ifndef REP_DFT
#define REP_DFT 1
#endif
#pragma unroll 1
            for (int grp = 0; grp < 2; ++grp) {
                EpiDft E; E.X = (bf16_t*)(p.ws + OFF_X); E.L = grp ? LB : LA; E.rowbase = grp ? TA : 0;
                pg8::Gemm g; g.A = (const bf16_t*)(p.ws + (grp ? OFF_D2 : OFF_D1)); g.Bt = (const bf16_t*)(p.ws + OFF_HNT) + (grp ? HNT_B : 0); g.M = grp ? MPB : MPA; g.N = (grp ? NBB : NBA) * D; g.K = grp ? LPB : LPA; g.ld = g.K;
                const bool bal = grp && (int)gridDim.x == 256;
                DftOrder S; S.init2(g.M, g.N, (int)gridDim.x, (grp && !bal) ? (int)gridDim.x - 1 - c : c, bal ? 1 : 0);
                pg8::gemm_phase<EpiDft, DftOrder, false>(lds, g, S, E, nullptr);
            }
#endif
        } else {
#ifndef NO_FINAL
            final_phase(p);
#endif
        }
#ifdef USE_CG_SYNC
        if (ph != 15) grid.sync();
#else
        if (ph != 15) xcd_barrier(xb);
#endif
    }
}

extern "C" void kernel_launch(void* const* d_in, const int* in_sizes, int n_in, void* d_out, int out_size, void* d_ws, size_t ws_size, hipStream_t stream) {
    static int grid = 0;
    if (grid == 0) {
        if (n_in != 19 || ws_size < WS_NEED) { fprintf(stderr, "kernel_launch: need 19 inputs and %zu bytes of workspace (got %d, %zu)\n", (size_t)WS_NEED, n_in, ws_size); grid = -1; return; }
        int dev = 0, cus = 0, per_cu = 0;
        hipGetDevice(&dev); hipDeviceGetAttribute(&cus, hipDeviceAttributeMultiprocessorCount, dev);
        if (hipFuncSetAttribute((const void*)mega_fwd, hipFuncAttributeMaxDynamicSharedMemorySize, LDS_BYTES) != hipSuccess) { fprintf(stderr, "kernel_launch: hipFuncSetAttribute failed\n"); grid = -1; return; }
        if (hipOccupancyMaxActiveBlocksPerMultiprocessor(&per_cu, (const void*)mega_fwd, 512, LDS_BYTES) != hipSuccess || per_cu < 1) { fprintf(stderr, "kernel_launch: occupancy query gave %d\n", per_cu); per_cu = 1; (void)hipGetLastError(); }
        grid = cus * 1;
    }
    if (grid < 0) return;
    Params p{};
    for (int i = 0; i < 19; ++i) p.in[i] = (const float*)d_in[i];
    p.out = (float*)d_out; p.ws = (unsigned char*)d_ws;
    if (hipMemsetAsync((unsigned char*)d_ws + OFF_BAR, 0, (size_t)XCD_BAR_WORDS * 4, stream) != hipSuccess) { fprintf(stderr, "kernel_launch: memset of barrier words failed\n"); return; }
    void* args[] = {&p};
    hipError_t e = hipLaunchCooperativeKernel((const void*)mega_fwd, dim3(grid), dim3(512), args, LDS_BYTES, stream);
    if (e != hipSuccess) fprintf(stderr, "cooperative launch failed: %s (grid %d)\n", hipGetErrorString(e), grid);
}
```

```cpp
#include <hip/hip_runtime.h>
#include <hip/hip_cooperative_groups.h>
#include <cstdio>
namespace cg = cooperative_groups;
#define LAS __attribute__((address_space(3)))
namespace pg8 {
#define PG8_LAS __attribute__((address_space(3)))
typedef unsigned short bf16_t;
typedef short bf16x8 __attribute__((ext_vector_type(8)));
typedef float f32x4 __attribute__((ext_vector_type(4)));
typedef unsigned u32x4 __attribute__((ext_vector_type(4)));
constexpr int BM = 256, BK = 64, HALF = 128, HTB = HALF * BK * 2  , STAGE_BYTES = 8 * HTB, NXCD = 8, WGM = 8;

__host__ __device__ __forceinline__ int lds_byte(int r, int c) { const int st = (r >> 4) * 2 + (c >> 5), rr = r & 15, cc = c & 31, ob = rr * 64 + cc * 2; return st * 1024 + (ob ^ (((ob >> 9) & 1) << 5)); }
__host__ __device__ __forceinline__ void stage_rc(int b, int& R, int& C) { const int st = b / 1024, sb = b % 1024, swz = sb ^ (((sb >> 9) & 1) << 5); R = (st >> 1) * 16 + swz / 64; C = (st & 1) * 32 + (swz % 64) / 2; }
__host__ __device__ __forceinline__ int perm32(int rho) { const int n = rho >> 4, i = rho & 15; return 8 * (i >> 2) + 4 * n + (i & 3); }

struct Unit { int pm, pn; };
struct Gemm { const bf16_t* A; const bf16_t* Bt; int M, N, K, ld; };

struct StaticOrder {
    int nM, nN, nwg, G, c;
    __host__ __device__ void init(int M, int N, int G_, int c_) { nM = M / BM; nN = N / BM; nwg = nM * nN; G = G_; c = c_; }
    __host__ __device__ bool next(int i, Unit& u) const {
        const int L = i * G + c; if (L >= nwg) return false;
        int wgid = (int)L; { const int q = nwg / NXCD, r = nwg % NXCD, xcd = wgid % NXCD, off = wgid / NXCD; wgid = (xcd < r ? xcd * (q + 1) : r * (q + 1) + (xcd - r) * q) + off; }
        const int nig = WGM * nN, gid = wgid / nig, fm = gid * WGM, gsz = (nM - fm) < WGM ? (nM - fm) : WGM;
        u.pm = fm + ((wgid % nig) % gsz); u.pn = (wgid % nig) / gsz; return true;
    }
    __device__ __forceinline__ void a_ready(const Unit&) const {}
    __device__ __forceinline__ void done(const Unit&) const {}
};
__device__ __forceinline__ unsigned cvt_pk_bf16(float lo, float hi) { unsigned r; asm volatile("v_cvt_pk_bf16_f32 %0, %1, %2" : "=v"(r) : "v"(lo), "v"(hi)); return r; }
template <class Epi, class Sched, bool STAMP = false>
__device__ __forceinline__ void gemm_phase(PG8_LAS unsigned char* lds, const Gemm g, const Sched& S, const Epi& E, unsigned long long* stamps) {
    int tid_o = threadIdx.x; asm volatile("" : "+v"(tid_o));
    const int tid = tid_o, wid = __builtin_amdgcn_readfirstlane(tid >> 6), lane = tid & 63, wr = wid >> 2, wc = wid & 3, fr = lane & 15, fq = lane >> 4;
    const int K = g.ld, nt = g.K / BK;
    int ts_lo = 0, ts_hi = 0, nts = 0; const unsigned long long rt_entry = STAMP ? (unsigned long long)wall_clock64() : 0ull;
#define PG8_STAMP() do { if (STAMP && wid == 0 && nts < 64) { const unsigned long long _c = (unsigned long long)clock64(); \
        ts_lo = (lane == nts) ? (int)(unsigned)_c : ts_lo; ts_hi = (lane == nts) ? (int)(unsigned)(_c >> 32) : ts_hi; ++nts; } } while (0)
    PG8_STAMP();
    unsigned voffA[2], voffB[2];
#pragma unroll
    for (int i = 0; i < 2; ++i) { int R, C; stage_rc(tid * 16 + i * 8192, R, C); const int Rb = Epi::PERM ? ((R & ~31) + perm32(R & 31)) : R;
        voffA[i] = (unsigned)(R * K + C) * 2u; voffB[i] = (unsigned)(Rb * K + C) * 2u; }
    const size_t kstep = (size_t)(BK * 2);
    const size_t hstep = (size_t)HALF * K * 2;
    const size_t tstep = 2 * hstep;
    const unsigned ldsw = (unsigned)wid * 1024u;
    const int aoff = lds_byte(wr * 64 + fr, fq * 8), boff = lds_byte(wc * 32 + fr, fq * 8);
#define PG8_SA(b, h) (((b) * 2 + (h)) * HTB)
#define PG8_SB(b, h) ((4 + (b) * 2 + (h)) * HTB)
#define PG8_STAGE(bufoff, gbase, voff) do { _Pragma("unroll") for (int _i = 0; _i < 2; ++_i) \
        __builtin_amdgcn_global_load_lds((const unsigned*)((const char*)(gbase) + (voff)[_i]), (PG8_LAS unsigned*)(lds + (bufoff) + ldsw + _i * 8192), 16, 0, 0); } while (0)
#define PG8_LDA(dst, b, h) do { _Pragma("unroll") for (int m = 0; m < 4; ++m) _Pragma("unroll") for (int k = 0; k < 2; ++k) dst[m][k] = *(const PG8_LAS bf16x8*)(lds + PG8_SA(b, h) + aoff + m * 2048 + k * 1024); } while (0)
#define PG8_LDB(dst, b, h) do { _Pragma("unroll") for (int n = 0; n < 2; ++n) _Pragma("unroll") for (int k = 0; k < 2; ++k) dst[n][k] = *(const PG8_LAS bf16x8*)(lds + PG8_SB(b, h) + boff + n * 2048 + k * 1024); } while (0)
#define PG8_MMA(ai, bj, At, Bt) do { __builtin_amdgcn_s_setprio(1); _Pragma("unroll") for (int m = 0; m < 4; ++m) _Pragma("unroll") for (int n = 0; n < 2; ++n) _Pragma("unroll") for (int k = 0; k < 2; ++k) \
        acc[ai][bj][m][n] = __builtin_amdgcn_mfma_f32_16x16x32_bf16(Bt[n][k], At[m][k], acc[ai][bj][m][n], 0, 0, 0); __builtin_amdgcn_s_setprio(0); } while (0)
#define PG8_WAIT_V(n) asm volatile("s_waitcnt vmcnt(" #n ")" ::: "memory")
#define PG8_WAIT_L(n) asm volatile("s_waitcnt lgkmcnt(" #n ")" ::: "memory")
#define PG8_BAR __builtin_amdgcn_s_barrier()
#define PG8_SCHED __builtin_amdgcn_sched_barrier(0)
    Unit cur, nxt; int ui = 0;
    if (!S.next(0, cur)) return;
    f32x4 acc[2][2][4][2];
#pragma unroll
    for (int a = 0; a < 2; ++a)
#pragma unroll
        for (int b = 0; b < 2; ++b)
#pragma unroll
            for (int m = 0; m < 4; ++m)
#pragma unroll
                for (int n = 0; n < 2; ++n) acc[a][b][m][n] = (f32x4){0.f, 0.f, 0.f, 0.f};
    bf16x8 At[4][2], B0[2][2], B1[2][2];
    const char* cA = (const char*)g.A + (size_t)cur.pm * tstep; const char* cB = (const char*)g.Bt + (size_t)cur.pn * tstep;
    S.a_ready(cur);
    PG8_STAGE(PG8_SB(0, 0), cB, voffB); PG8_STAGE(PG8_SA(0, 0), cA, voffA); PG8_STAGE(PG8_SB(0, 1), cB + hstep, voffB); PG8_STAGE(PG8_SA(0, 1), cA + hstep, voffA);
    if (wr == 1) PG8_BAR;
    PG8_WAIT_V(4); PG8_BAR;
    PG8_STAGE(PG8_SB(1, 0), cB + kstep, voffB); PG8_STAGE(PG8_SA(1, 0), cA + kstep, voffA); PG8_STAGE(PG8_SB(1, 1), cB + hstep + kstep, voffB);
    PG8_WAIT_V(6); PG8_BAR;
    PG8_STAMP();
    for (;;) {
        const bool has_next = S.next(ui + 1, nxt);
        const char* nA = has_next ? (const char*)g.A + (size_t)nxt.pm * tstep : cA; const char* nB = has_next ? (const char*)g.Bt + (size_t)nxt.pn * tstep : cB;
        for (int t = 0; t < nt; t += 2) {
            const bool last = (t == nt - 2);
            const char* a1 = cA + (size_t)(t + 1) * kstep;
            const char* a2 = last ? nA : cA + (size_t)(t + 2) * kstep; const char* b2 = last ? nB : cB + (size_t)(t + 2) * kstep;
            const char* a3 = a2 + kstep; const char* b3 = b2 + kstep;
            if (last && has_next) S.a_ready(nxt);
            PG8_LDB(B0, 0, 0); PG8_SCHED; PG8_LDA(At, 0, 0); PG8_STAGE(PG8_SA(1, 1), a1 + hstep, voffA);
            PG8_WAIT_L(8); PG8_BAR; PG8_WAIT_L(0); PG8_MMA(0, 0, At, B0); PG8_BAR; PG8_SCHED;
            PG8_LDB(B1, 0, 1); PG8_STAGE(PG8_SB(0, 0), b2, voffB);
            PG8_BAR; PG8_WAIT_L(0); PG8_MMA(0, 1, At, B1); PG8_BAR;
            PG8_LDA(At, 0, 1); PG8_STAGE(PG8_SA(0, 0), a2, voffA);
            PG8_BAR; PG8_WAIT_L(0); PG8_MMA(1, 0, At, B0); PG8_BAR; PG8_SCHED;
            PG8_STAGE(PG8_SB(0, 1), b2 + hstep, voffB);
            PG8_WAIT_V(6); PG8_BAR; PG8_MMA(1, 1, At, B1); PG8_BAR;
            PG8_LDB(B0, 1, 0); PG8_SCHED; PG8_LDA(At, 1, 0); PG8_STAGE(PG8_SA(0, 1), a2 + hstep, voffA);
            PG8_WAIT_L(8); PG8_BAR; PG8_WAIT_L(0); PG8_MMA(0, 0, At, B0); PG8_BAR; PG8_SCHED;
            PG8_LDB(B1, 1, 1); PG8_STAGE(PG8_SB(1, 0), b3, voffB);
            PG8_BAR; PG8_WAIT_L(0); PG8_MMA(0, 1, At, B1); PG8_BAR;
            PG8_LDA(At, 1, 1); PG8_STAGE(PG8_SA(1, 0), a3, voffA);
            PG8_BAR; PG8_WAIT_L(0); PG8_MMA(1, 0, At, B0); PG8_BAR; PG8_SCHED;
            PG8_STAGE(PG8_SB(1, 1), b3 + hstep, voffB);
            PG8_WAIT_V(6); PG8_BAR; PG8_MMA(1, 1, At, B1); PG8_BAR;
        }
        PG8_STAMP();
        if constexpr (!Epi::AFTER_DRAIN) { E(acc, cur, wr, wc, fr, fq); S.done(cur); }
        PG8_STAMP();
        if (!has_next) break;
#pragma unroll
        for (int a = 0; a < 2; ++a)
#pragma unroll
            for (int b = 0; b < 2; ++b)
#pragma unroll
                for (int m = 0; m < 4; ++m)
#pragma unroll
                    for (int n = 0; n < 2; ++n) acc[a][b][m][n] = (f32x4){0.f, 0.f, 0.f, 0.f};
        cur = nxt; cA = nA; cB = nB; ++ui;
    }
    PG8_WAIT_V(0);
    if (wr == 0) PG8_BAR;
    PG8_BAR;
    if constexpr (Epi::AFTER_DRAIN) { E.fused(acc, cur, wr, wc, fr, fq, lds, wid, lane); S.done(cur); }
    PG8_STAMP();
    if (STAMP && wid == 0) { stamps[lane] = lane < nts ? (((unsigned long long)(unsigned)ts_hi << 32) | (unsigned)ts_lo) : 0ull;
        if (lane == 62) stamps[62] = rt_entry; if (lane == 63) stamps[63] = (unsigned long long)wall_clock64(); }
#undef PG8_STAMP
#undef PG8_SA
#undef PG8_SB
#undef PG8_STAGE
#undef PG8_LDA
#undef PG8_LDB
#undef PG8_MMA
#undef PG8_WAIT_V
#undef PG8_WAIT_L
#undef PG8_BAR
#undef PG8_SCHED
}
}
#define XB_TMO      128
#define XB_XCNT(j)  (256  + 64 * (j))
#define XB_XSUB(j)  (1280 + 64 * (j))
#define XB_XGEN(j)  (2304 + 64 * (j))
#define XB_TOP      3328
#define XB_TOPGEN   3392
#define XCD_BAR_WORDS 3456
#define XB_SPIN_CAP (1u << 18)

__device__ __forceinline__ unsigned xb_ld(unsigned* p)              { return __hip_atomic_load(p, __ATOMIC_RELAXED, __HIP_MEMORY_SCOPE_AGENT); }
__device__ __forceinline__ unsigned xb_add(unsigned* p, unsigned v) { return __hip_atomic_fetch_add(p, v, __ATOMIC_RELAXED, __HIP_MEMORY_SCOPE_AGENT); }
__device__ __forceinline__ unsigned xb_xcc_id() { return (unsigned)__builtin_amdgcn_s_getreg((3 << 11) | 20) & 0xFu; }
#define XB_SPIN(cond, bar) do { unsigned _sp = 0; while (cond) { __builtin_amdgcn_s_sleep(1); \
    if ((++_sp & 255u) == 0u) { if (xb_ld(&(bar)[XB_TMO])) break; if (_sp > XB_SPIN_CAP) { atomicAdd(&(bar)[XB_TMO], 1u); break; } } } } while (0)

struct XcdBarrier {
    unsigned* bar; unsigned x;
    volatile LAS unsigned* st;
};

__device__ __forceinline__ XcdBarrier xcd_barrier_post(unsigned* bar, volatile LAS unsigned* st) {
    XcdBarrier b; b.bar = bar; b.x = xb_xcc_id(); b.st = st;
    if (threadIdx.x == 0) (void)xb_add(&bar[XB_XCNT(b.x)], 1u);
    return b;
}
__device__ __forceinline__ void xcd_barrier_complete(unsigned* bar, unsigned x, unsigned& nloc, unsigned& nx) {
    const unsigned G = gridDim.x * gridDim.y * gridDim.z;
    unsigned sum, cnt, mine, sp = 0u;
    for (;;) {
        sum = 0u; cnt = 0u; mine = 0u;
#pragma unroll
        for (unsigned j = 0; j < 16; ++j) { const unsigned c = xb_ld(&bar[XB_XCNT(j)]); sum += c; cnt += (c > 0u) ? 1u : 0u; mine = (j == x) ? c : mine; }
        if (sum == G) break;
        __builtin_amdgcn_s_sleep(1);
        if ((++sp & 255u) == 0u) { if (xb_ld(&bar[XB_TMO])) break; if (sp > XB_SPIN_CAP) { atomicAdd(&bar[XB_TMO], 1u); break; } }
    }
    nloc = mine > 0u ? mine : 1u; nx = cnt > 0u ? cnt : 1u;
}

__device__ __forceinline__ void xcd_barrier(const XcdBarrier& b) {
    asm volatile("s_waitcnt vmcnt(0)" ::: "memory");
    __syncthreads();
    if (threadIdx.x == 0) {
        unsigned* bar = b.bar;
        __builtin_amdgcn_s_waitcnt(0);
        unsigned nloc = b.st[0], nx = b.st[1];
        if (nloc == 0u) { xcd_barrier_complete(bar, b.x, nloc, nx); b.st[0] = nloc; b.st[1] = nx; }
        const unsigned old = xb_add(&bar[XB_XSUB(b.x)], 1u);
        const unsigned gen = old / nloc;
        if (old + 1u == (gen + 1u) * nloc) {
            __builtin_amdgcn_fence(__ATOMIC_RELEASE, "agent");
            asm volatile("s_waitcnt vmcnt(0)" ::: "memory");
            const unsigned og = xb_add(&bar[XB_TOP], 1u);
            const unsigned tg = og / nx;
            if (og + 1u == (tg + 1u) * nx) xb_add(&bar[XB_TOPGEN], 1u);
            else XB_SPIN(xb_ld(&bar[XB_TOPGEN]) == tg, bar);
            __builtin_amdgcn_fence(__ATOMIC_ACQUIRE, "agent");
            xb_add(&bar[XB_XGEN(b.x)], 1u);
            asm volatile("s_waitcnt vmcnt(0)" ::: "memory");
        } else {
            XB_SPIN(xb_ld(&bar[XB_XGEN(b.x)]) == gen, bar);
            __builtin_amdgcn_fence(__ATOMIC_ACQUIRE, "agent");
            asm volatile("s_waitcnt vmcnt(0)" ::: "memory");
        }
    }
    __syncthreads();
}

using pg8::bf16_t; using pg8::bf16x8; using pg8::f32x4; using pg8::u32x4; using pg8::Unit; using pg8::cvt_pk_bf16;
typedef unsigned u32x2 __attribute__((ext_vector_type(2)));
typedef float f32x2 __attribute__((ext_vector_type(2)));

#define GAS __attribute__((address_space(1)))
template <class T> __device__ __forceinline__ T gload(const T* p) { return *(const GAS T*)p; }
template <class T> __device__ __forceinline__ void gstore(T* p, const T& v) { *(GAS T*)p = v; }
constexpr int D = 1024, DFF = 2816, NGU = 5632, INDIM = 1280;
constexpr int LA = 4112, LB = 2064, NBA = 8, NBB = 32;
constexpr int TA = NBA * LA;
constexpr int T = TA + NBB * LB;
constexpr int TPAD = 99072;
constexpr int LPA = 4224, LPB = 2176;
constexpr int MPA = 4352, MPB = 2304;
constexpr int LDS_BYTES = 147456;

constexpr size_t al256(size_t x) { return (x + 255) & ~(size_t)255; }
constexpr size_t OFF_WGU = 0;
constexpr size_t OFF_WD = al256(OFF_WGU + (size_t)4 * NGU * D * 2);
constexpr size_t OFF_WIN = al256(OFF_WD + (size_t)4 * D * DFF * 2);
constexpr size_t OFF_WO = al256(OFF_WIN + (size_t)INDIM * D * 2);
constexpr size_t OFF_W2T = al256(OFF_WO + (size_t)D * D * 2);
constexpr size_t OFF_D1 = al256(OFF_W2T + (size_t)D * 2048 * 2);
constexpr size_t OFF_D2 = al256(OFF_D1 + (size_t)MPA * LPA * 2);
constexpr size_t OFF_HMETA = al256(OFF_D2 + (size_t)MPB * LPB * 2);
constexpr size_t OFF_RSS = al256(OFF_HMETA + (size_t)640 * D * 4);
constexpr size_t OFF_HB = al256(OFF_RSS + (size_t)TPAD * 16 * 4);
constexpr size_t OFF_BIG = al256(OFF_HB + (size_t)TPAD * D * 2);
constexpr size_t OFF_ACT = OFF_BIG;
constexpr size_t OFF_Z = OFF_BIG;
constexpr size_t OFF_AP = al256(OFF_Z + (size_t)TPAD * INDIM * 2);
constexpr size_t OFF_HNT = OFF_BIG;
constexpr size_t HNT_B = (size_t)NBA * D * LPA;
constexpr size_t OFF_X = al256(OFF_HNT + ((size_t)NBA * D * LPA + (size_t)NBB * D * LPB) * 2);
constexpr size_t OFF_SMALL = al256(OFF_X + (size_t)TPAD * 2048 * 2);
constexpr size_t OFF_BAR = al256(OFF_SMALL + 3072 * 4);
constexpr size_t OFF_PART = al256(OFF_BAR + (size_t)XCD_BAR_WORDS * 4);
constexpr size_t WS_NEED = al256(OFF_PART + (size_t)12 * 16 * 256 * 256 * 4);
static_assert(OFF_AP + (size_t)TPAD * D * 2 <= WS_NEED && OFF_ACT + (size_t)TPAD * DFF * 2 <= WS_NEED, "big region");

struct Params { const float* in[19]; float* out; unsigned char* ws; };

__device__ __forceinline__ void row_decode(int r, int& gb, int& l, int& L, int& rb) {
    if (r < TA) { gb = r / LA; l = r - gb * LA; L = LA; rb = gb * LA; }
    else { const int q = r - TA, b = q / LB; l = q - b * LB; gb = NBA + b; L = LB; rb = TA + b * LB; }
}
__device__ __forceinline__ float* hptr2(float* out, unsigned char* ws, int r) {
    int gb, l, L, rb; row_decode(r, gb, l, L, rb);
    if (l < 16) return (float*)(ws + OFF_HMETA) + (size_t)(gb * 16 + l) * D;
    return out + (size_t)(r - 16 * (gb + 1)) * D;
}
__device__ __forceinline__ float* hptr(const Params& p, int r) {
    int gb, l, L, rb; row_decode(r, gb, l, L, rb);
    if (l < 16) return (float*)(p.ws + OFF_HMETA) + (size_t)(gb * 16 + l) * D;
    return p.out + (size_t)(r - 16 * (gb + 1)) * D;
}
__device__ __forceinline__ int otid() { int t = threadIdx.x; asm volatile("" : "+v"(t)); return t; }
__device__ __forceinline__ bf16_t f2bf(float f) { unsigned u = __float_as_uint(f); u += 0x7FFFu + ((u >> 16) & 1u); return (bf16_t)(u >> 16); }
__device__ __forceinline__ float bflo(unsigned w) { return __uint_as_float(w << 16); }
__device__ __forceinline__ float bfhi(unsigned w) { return __uint_as_float(w & 0xFFFF0000u); }
__device__ __forceinline__ float wave_sum(float v) {
#pragma unroll
    for (int o = 1; o < 64; o <<= 1) v += __shfl_xor(v, o);
    return v;
}
__device__ __forceinline__ float rstd_of(float ss) { return __builtin_amdgcn_rsqf(ss * (1.0f / 1024.0f) + 1e-6f); }

struct EpiGateUp {
    static constexpr bool PERM = true, AFTER_DRAIN = false;
    bf16_t* act; const float* rss;
    __device__ __forceinline__ void operator()(const f32x4 (&acc)[2][2][4][2], const Unit& u, int wr, int wc, int fr, int fq) const {
        const int col = u.pn * 128 + wc * 32 + fq * 8;
        float rsc[2][4];
#pragma unroll
        for (int ai = 0; ai < 2; ++ai)
#pragma unroll
            for (int m = 0; m < 4; ++m) { const int r = u.pm * 256 + ai * 128 + wr * 64 + m * 16 + fr; const f32x4 q4 = gload((const f32x4*)(rss + (size_t)min(r, T - 1) * 4)); rsc[ai][m] = (q4[0] + q4[1]) + (q4[2] + q4[3]); }
#pragma unroll
        for (int ai = 0; ai < 2; ++ai)
#pragma unroll
            for (int m = 0; m < 4; ++m) rsc[ai][m] = rstd_of(rsc[ai][m]);
#pragma unroll
        for (int ai = 0; ai < 2; ++ai)
#pragma unroll
            for (int m = 0; m < 4; ++m) {
                const int r = u.pm * 256 + ai * 128 + wr * 64 + m * 16 + fr;
                const float rs = rsc[ai][m]; const f32x2 rs2 = {rs * rs, rs * rs}, nrl = {rs * -1.4426950408889634f, rs * -1.4426950408889634f}, one = {1.0f, 1.0f};
                unsigned w[4];
#pragma unroll
                for (int n = 0; n < 2; ++n)
#pragma unroll
                    for (int e = 0; e < 4; e += 2) {
                        const f32x2 g = {acc[ai][0][m][n][e], acc[ai][0][m][n][e + 1]}, uu = {acc[ai][1][m][n][e], acc[ai][1][m][n][e + 1]};
                        const f32x2 t = g * nrl; f32x2 ex; ex.x = __builtin_amdgcn_exp2f(t.x); ex.y = __builtin_amdgcn_exp2f(t.y);
                        const f32x2 dn = ex + one; f32x2 rc; rc.x = __builtin_amdgcn_rcpf(dn.x); rc.y = __builtin_amdgcn_rcpf(dn.y);
                        const f32x2 o2 = ((g * uu) * rs2) * rc;
                        w[n * 2 + (e >> 1)] = cvt_pk_bf16(o2.x, o2.y);
                    }
                u32x4 o; o.x = w[0]; o.y = w[1]; o.z = w[2]; o.w = w[3];
                if (r < T) gstore((u32x4*)(act + (size_t)r * DFF + col), o);
            }
    }
};
struct EpiScale {
    static constexpr bool PERM = true, AFTER_DRAIN = false;
    bf16_t* O; int ldc; const float* rss;
    __device__ __forceinline__ void operator()(const f32x4 (&acc)[2][2][4][2], const Unit& u, int wr, int wc, int fr, int fq) const {
        const int col = u.pn * 256 + wc * 32 + fq * 8;
        float rsv[2][4];
#pragma unroll
        for (int ai = 0; ai < 2; ++ai)
#pragma unroll
            for (int m = 0; m < 4; ++m) { const int r = u.pm * 256 + ai * 128 + wr * 64 + m * 16 + fr; { const f32x4 q4 = gload((const f32x4*)(rss + (size_t)min(r, T - 1) * 4)); rsv[ai][m] = (q4[0] + q4[1]) + (q4[2] + q4[3]); } }
#pragma unroll
        for (int ai = 0; ai < 2; ++ai)
#pragma unroll
            for (int m = 0; m < 4; ++m) {
                const int r = u.pm * 256 + ai * 128 + wr * 64 + m * 16 + fr;
                const float rs = rstd_of(rsv[ai][m]);
                if (r < T) {
#pragma unroll
                    for (int bj = 0; bj < 2; ++bj) {
                        const f32x4 v0 = acc[ai][bj][m][0] * rs, v1 = acc[ai][bj][m][1] * rs;
                        u32x4 o; o.x = cvt_pk_bf16(v0[0], v0[1]); o.y = cvt_pk_bf16(v0[2], v0[3]); o.z = cvt_pk_bf16(v1[0], v1[1]); o.w = cvt_pk_bf16(v1[2], v1[3]);
                        gstore((u32x4*)(O + (size_t)r * ldc + col + bj * 128), o);
                    }
                }
            }
    }
};
struct EpiNone {
    static constexpr bool PERM = true, AFTER_DRAIN = false;
    __device__ __forceinline__ void operator()(const f32x4 (&acc)[2][2][4][2], const Unit& u, int wr, int wc, int fr, int fq) const {
#pragma unroll
        for (int ai = 0; ai < 2; ++ai)
#pragma unroll
            for (int bj = 0; bj < 2; ++bj)
#pragma unroll
                for (int m = 0; m < 4; ++m)
#pragma unroll
                    for (int n = 0; n < 2; ++n) asm volatile("" :: "v"(acc[ai][bj][m][n]));
    }
};
template <bool LAST> struct EpiResid {
    static constexpr bool PERM = true, AFTER_DRAIN = false;
    float* out; unsigned char* ws; int half; float* rss4; LAS float* part;
    __device__ __forceinline__ void operator()(const f32x4 (&acc)[2][2][4][2], const Unit& u, int wr, int wc, int fr, int fq) const {
        const int col = u.pn * 256 + wc * 32 + fq * 8;
        bf16_t* hb = (bf16_t*)(ws + OFF_HB);
        u32x4 hv[2][4][2];
#pragma unroll
        for (int ai = 0; ai < 2; ++ai)
#pragma unroll
            for (int m = 0; m < 4; ++m) { const int r = u.pm * 256 + ai * 128 + wr * 64 + m * 16 + fr; const bf16_t* hp = hb + (size_t)min(r, T - 1) * D + col;
#pragma unroll
                for (int bj = 0; bj < 2; ++bj) hv[ai][m][bj] = gload((const u32x4*)(hp + bj * 128)); }
#pragma unroll
        for (int ai = 0; ai < 2; ++ai)
#pragma unroll
            for (int m = 0; m < 4; ++m) {
                const int r = u.pm * 256 + ai * 128 + wr * 64 + m * 16 + fr;
                f32x2 ss2 = {0.f, 0.f}; const float scale = half ? 0.5f : 1.0f; const f32x2 sc2 = {scale, scale};
#pragma unroll
                for (int bj = 0; bj < 2; ++bj) {
                    const u32x4 w = hv[ai][m][bj]; const f32x4 a0 = acc[ai][bj][m][0], a1 = acc[ai][bj][m][1];
                    f32x2 p0 = {bflo(w.x), bfhi(w.x)}, p1 = {bflo(w.y), bfhi(w.y)}, p2 = {bflo(w.z), bfhi(w.z)}, p3 = {bflo(w.w), bfhi(w.w)};
                    p0 += (f32x2){a0[0], a0[1]} * sc2; p1 += (f32x2){a0[2], a0[3]} * sc2; p2 += (f32x2){a1[0], a1[1]} * sc2; p3 += (f32x2){a1[2], a1[3]} * sc2;
                    ss2 += p0 * p0; ss2 += p1 * p1; ss2 += p2 * p2; ss2 += p3 * p3;
                    if (r < T) {
                        u32x4 o; o.x = cvt_pk_bf16(p0.x, p0.y); o.y = cvt_pk_bf16(p1.x, p1.y); o.z = cvt_pk_bf16(p2.x, p2.y); o.w = cvt_pk_bf16(p3.x, p3.y);
                        gstore((u32x4*)(hb + (size_t)r * D + col + bj * 128), o);
                    }
                }
                float ss = ss2.x + ss2.y;
                ss += __shfl_xor(ss, 16); ss += __shfl_xor(ss, 32);
                if (fq == 0) part[(ai * 128 + wr * 64 + m * 16 + fr) * 4 + wc] = ss;
            }
        asm volatile("s_waitcnt lgkmcnt(0)" ::: "memory"); __builtin_amdgcn_s_barrier(); asm volatile("" ::: "memory");
        const int lane = fq * 16 + fr;
        if (lane < 32) { const int rl = (lane >> 4) * 128 + wr * 64 + wc * 16 + (lane & 15), r = u.pm * 256 + rl;
            const f32x4 v = *(const LAS f32x4*)(part + rl * 4);
            if (r < T) gstore(rss4 + (size_t)r * 4 + u.pn, (v[0] + v[1]) + (v[2] + v[3])); }
    }
};
struct EpiDft {
    static constexpr bool PERM = true, AFTER_DRAIN = false;
    bf16_t* X; int L, rowbase;
    __device__ __forceinline__ void operator()(const f32x4 (&acc)[2][2][4][2], const Unit& u, int wr, int wc, int fr, int fq) const {
        const int b = u.pn >> 2, c0 = (u.pn & 3) * 256 + wc * 32 + fq * 8, H = L >> 1;
#pragma unroll
        for (int ai = 0; ai < 2; ++ai)
#pragma unroll
            for (int m = 0; m < 4; ++m) {
                const int kk = u.pm * 256 + ai * 128 + wr * 64 + m * 16 + fr;
                if (kk < L) {
                    const bool isc = kk <= H; const int k = isc ? kk : kk - H; const float sg = isc ? 1.f : -1.f;
                    bf16_t* x0 = X + (size_t)(rowbase + b * L + k) * 2048 + (isc ? 0 : 1024) + c0;
                    bf16_t* x1 = X + (size_t)(rowbase + b * L + (L - k)) * 2048 + (isc ? 0 : 1024) + c0;
                    const bool mir = (k >= 1) && (k < H);
#pragma unroll
                    for (int bj = 0; bj < 2; ++bj) {
                        const f32x4 v0 = acc[ai][bj][m][0] * sg, v1 = acc[ai][bj][m][1] * sg;
                        u32x4 o; o.x = cvt_pk_bf16(v0[0], v0[1]); o.y = cvt_pk_bf16(v0[2], v0[3]); o.z = cvt_pk_bf16(v1[0], v1[1]); o.w = cvt_pk_bf16(v1[2], v1[3]);
                        gstore((u32x4*)(x0 + bj * 128), o);
                        if (mir) { u32x4 q; if (isc) q = o; else { q.x = o.x ^ 0x80008000u; q.y = o.y ^ 0x80008000u; q.z = o.z ^ 0x80008000u; q.w = o.w ^ 0x80008000u; } gstore((u32x4*)(x1 + bj * 128), q); }
                        if (isc && !mir) { u32x4 zz; zz.x = 0; zz.y = 0; zz.z = 0; zz.w = 0; gstore((u32x4*)(x0 + 1024 + bj * 128), zz); }
                    }
                }
            }
    }
};

struct DftOrder : pg8::StaticOrder {
    int cc, GG, mode;
    __device__ void init2(int M, int N, int G_, int c_, int mode_) { init(M, N, 1, 0); cc = c_; GG = G_; mode = mode_; }
    __device__ bool next(int i, Unit& u) const { int L;
        if (mode == 0) { L = i * GG + cc; if (L >= nwg) return false; }
        else if (cc < 32) { if (i >= 3) return false; L = 1056 + cc * 3 + i; }
        else { const int d = cc - 32; if (i < 4) L = i * 224 + d; else if (i == 4 && d < 160) L = 896 + d; else return false; }
        return pg8::StaticOrder::next(L, u); }
};
constexpr int TAIL_L0 = 6 * 256, TAIL_UNITS = (TPAD / 256) * 4 - TAIL_L0;
struct CapOrder : pg8::StaticOrder {
    int cc, GG, cap;
    __device__ void init2(int M, int N, int G_, int c_, int cap_) { init(M, N, 1, 0); cc = c_; GG = G_; cap = cap_; }
    __device__ bool next(int i, Unit& u) const { const int L = i * GG + cc; if (L >= cap) return false; return pg8::StaticOrder::next(L, u); }
};
struct TailOrder : pg8::StaticOrder {
    int tu;
    __device__ void init2(int M, int N, int tu_) { init(M, N, 1, 0); tu = tu_; }
    __device__ bool next(int i, Unit& u) const { if (i != 0) return false; return pg8::StaticOrder::next(TAIL_L0 + tu, u); }
};
struct EpiPartial {
    static constexpr bool PERM = true, AFTER_DRAIN = false;
    float* P;
    __device__ __forceinline__ void operator()(const f32x4 (&acc)[2][2][4][2], const Unit& u, int wr, int wc, int fr, int fq) const {
#pragma unroll
        for (int ai = 0; ai < 2; ++ai)
#pragma unroll
            for (int m = 0; m < 4; ++m) { float* rowp = P + (size_t)(ai * 128 + wr * 64 + m * 16 + fr) * 256 + wc * 32 + fq * 8;
#pragma unroll
                for (int bj = 0; bj < 2; ++bj) { gstore((f32x4*)(rowp + bj * 128), acc[ai][bj][m][0]); gstore((f32x4*)(rowp + bj * 128 + 4), acc[ai][bj][m][1]); } }
    }
};
__device__ __forceinline__ void tail_fixup(unsigned char* ws, int nsl, int half) {
    const float scale = half ? 0.5f : 1.0f;
    const int tid = otid(), lane = tid & 63, gw = blockIdx.x * 8 + (tid >> 6), NGW = gridDim.x * 8;
    bf16_t* hb = (bf16_t*)(ws + OFF_HB); float* rss4 = (float*)(ws + OFF_RSS); const float* P0 = (const float*)(ws + OFF_PART);
    pg8::StaticOrder so; so.init(TPAD, D, 1, 0);
    for (int it = gw; it < TAIL_UNITS * 256; it += NGW) {
        const int tu = it >> 8, rl = it & 255; Unit u; so.next(TAIL_L0 + tu, u);
        const int r = u.pm * 256 + rl, col = u.pn * 256 + lane * 4;
        f32x4 a = {0.f, 0.f, 0.f, 0.f};
        f32x4 pv[11];
#pragma unroll
        for (int sl = 0; sl < 11; ++sl) pv[sl] = gload((const f32x4*)(P0 + ((size_t)(tu * 16 + min(sl, nsl - 1)) * 256 + rl) * 256 + lane * 4));
#pragma unroll
        for (int sl = 0; sl < 11; ++sl) { const float m = sl < nsl ? 1.0f : 0.0f; a += pv[sl] * m; }
        float ss = 0.f;
        if (r < T) { const u32x2 w = gload((const u32x2*)(hb + (size_t)r * D + col));
            f32x4 h; h[0] = bflo(w.x); h[1] = bfhi(w.x); h[2] = bflo(w.y); h[3] = bfhi(w.y); h += a * scale;
            ss = (h[0] * h[0] + h[1] * h[1]) + (h[2] * h[2] + h[3] * h[3]);
            u32x2 o; o.x = cvt_pk_bf16(h[0], h[1]); o.y = cvt_pk_bf16(h[2], h[3]); gstore((u32x2*)(hb + (size_t)r * D + col), o); }
        ss = wave_sum(ss);
        if (lane == 0 && r < T) rss4[(size_t)r * 4 + u.pn] = ss;
    }
}
struct LocalOrder : pg8::StaticOrder { __device__ bool next(int i, Unit& u) const { const bool ok = pg8::StaticOrder::next(i, u); u.pm &= 7; return ok; } };
template <class Epi>
__device__ __forceinline__ void run_gemm(LAS unsigned char* lds, const bf16_t* A, const bf16_t* Bt, int M, int N, int K, const Epi& E, int c) {
    pg8::Gemm g; g.A = A; g.Bt = Bt; g.M = M; g.N = N; g.K = K; g.ld = K;
    pg8::StaticOrder S; S.init(M, N, (int)gridDim.x, c);
    pg8::gemm_phase<Epi, pg8::StaticOrder, false>(lds, g, S, E, nullptr);
}

__device__ __forceinline__ void transpose_item(const float* W, int N, const float* gain, bf16_t* WT, int ldd, int k0, int n0, int drow0, LAS float* scr, int lane, float osc = 1.0f) {
#pragma unroll
    for (int i = 0; i < 32; ++i) { const int kk = 2 * i + (lane >> 5); f32x2 v = *(const f32x2*)(W + (size_t)(k0 + kk) * N + n0 + 2 * (lane & 31)); if (gain) v *= gain[k0 + kk] * osc; *(LAS f32x2*)(scr + kk * 66 + 2 * (lane & 31)) = v; }
    asm volatile("s_waitcnt lgkmcnt(0)" ::: "memory");
    const int c = lane & 7;
#pragma unroll
    for (int jj = 0; jj < 8; ++jj) { const int n = (lane >> 3) + 8 * jj; const LAS float* sp = scr + (8 * c) * 66 + n;
        u32x4 o; o.x = cvt_pk_bf16(sp[0 * 66], sp[1 * 66]); o.y = cvt_pk_bf16(sp[2 * 66], sp[3 * 66]); o.z = cvt_pk_bf16(sp[4 * 66], sp[5 * 66]); o.w = cvt_pk_bf16(sp[6 * 66], sp[7 * 66]);
        *(u32x4*)(WT + (size_t)(drow0 + n) * ldd + k0 + 8 * c) = o; }
    asm volatile("s_waitcnt lgkmcnt(0)" ::: "memory");
}
__device__ __forceinline__ void dft_item(bf16_t* Dm, int L, int LP, int witem, int lane) {
    const int cpr = LP >> 3, H = L >> 1; const int tix = witem * 64 + lane; const int kk = tix / cpr, c8 = tix - kk * cpr;
    const bool isc = kk <= H; const int k = isc ? kk : kk - H;
    const float sc = rsqrtf((float)L), invL = 1.0f / (float)L;
    int mm = (k * (c8 * 8)) % L;
    unsigned w[4];
#pragma unroll
    for (int e = 0; e < 8; e += 2) {
        float v[2];
#pragma unroll
        for (int q = 0; q < 2; ++q) { const int n = c8 * 8 + e + q; const float a = (float)mm * invL;
            const float x = (isc ? __builtin_amdgcn_cosf(a) : __builtin_amdgcn_sinf(a)) * sc;
            v[q] = (kk < L && n < L) ? x : 0.f;
            mm += k; mm = mm >= L ? mm - L : mm; }
        w[e >> 1] = cvt_pk_bf16(v[0], v[1]);
    }
    u32x4 o; o.x = w[0]; o.y = w[1]; o.z = w[2]; o.w = w[3];
    *(u32x4*)(Dm + (size_t)kk * LP + c8 * 8) = o;
}
__device__ __forceinline__ void prep_phase(const Params& p, LAS unsigned char* lds) {
    const int tid = otid(), lane = tid & 63, wave = __builtin_amdgcn_readfirstlane(tid >> 6);
    const int gw = blockIdx.x * 8 + wave, NGW = gridDim.x * 8;
    LAS float* scr = (LAS float*)(lds + wave * 16896);
    LAS float* tab = (LAS float*)(lds + 8 * 16896);
    if (tid < 256) { tab[tid] = cospif((float)tid * (1.0f / 128.0f)); tab[256 + tid] = sinpif((float)tid * (1.0f / 128.0f)); }
    __syncthreads();
    if (blockIdx.x == 0) { float* sm = (float*)(p.ws + OFF_SMALL); if (tid < 8) sm[tid] = p.in[9][tid]; for (int i = tid; i < 1024; i += 512) { sm[1024 + i] = p.in[7][D + i]; sm[2048 + i] = p.in[18][i]; } }
    bf16_t* Wgu = (bf16_t*)(p.ws + OFF_WGU); bf16_t* Wd = (bf16_t*)(p.ws + OFF_WD); bf16_t* Win = (bf16_t*)(p.ws + OFF_WIN);
    bf16_t* Wo = (bf16_t*)(p.ws + OFF_WO); bf16_t* W2t = (bf16_t*)(p.ws + OFF_W2T);
    constexpr int I_G = 16 * 44, I_D = 44 * 16;
    constexpr int N_TR_FFN = 4 * (2 * I_G + I_D);
    constexpr int I_IN = 16 * 20, I_WO = 8 * 16;
    constexpr int R0 = N_TR_FFN, R1 = R0 + I_IN, R2 = R1 + I_WO;
    constexpr int N_W3 = 256 * 8, N_W2 = 128 * 32;
    constexpr int R3 = R2 + N_W3, R4 = R3 + N_W2;
    constexpr int N_D1 = MPA * (LPA / 8) / 64, N_D2 = MPB * (LPB / 8) / 64;
    constexpr int R5 = R4 + N_D1, R6 = R5 + N_D2, R7 = R6 + T / 2;
    for (int it = gw; it < R7; it += NGW) {
        if (it < R0) {
            const int f = it / (2 * I_G + I_D); int r = it - f * (2 * I_G + I_D); const int layer = f >> 1, which = f & 1;
            if (r < 2 * I_G) { const int up = r >= I_G; if (up) r -= I_G;
                const float* src = p.in[which ? (up ? 16 : 15) : (up ? 5 : 4)] + (size_t)layer * D * DFF;
                const float* gain = p.in[which ? 14 : 3] + layer * D;
                const int kb = r / 44, nb = r - kb * 44, n0 = nb * 64;
                const int drow0 = (n0 >> 7) * 256 + (up ? 128 : 0) + (n0 & 127);
                transpose_item(src, DFF, gain, Wgu + (size_t)f * NGU * D, D, kb * 64, n0, drow0, scr, lane);
            } else { r -= 2 * I_G;
                const float* src = p.in[which ? 17 : 6] + (size_t)layer * DFF * D;
                const int kb = r / 16, nb = r - kb * 16;
                transpose_item(src, D, nullptr, Wd + (size_t)f * D * DFF, DFF, kb * 64, nb * 64, nb * 64, scr, lane);
            }
        } else if (it < R1) { const int r = it - R0, kb = r / 20, nb = r - kb * 20;
            transpose_item(p.in[8], INDIM, p.in[7], Win, D, kb * 64, nb * 64, nb * 64, scr, lane, nb < 8 ? 0.125f : 1.0f);
        } else if (it < R2) { const int r = it - R1, kb = r / 16, nb = r - kb * 16;
            transpose_item(p.in[12], D, nullptr, Wo, D, kb * 64, nb * 64, nb * 64, scr, lane);
        } else if (it < R3) {
            const int r = it - R2, j = (r & 255) * 4, kb = r >> 8, kk = kb * 64 + lane, g = kk >> 7, c = kk & 127;
            const float* pw = p.in[10] + (size_t)(g * 128 + c) * 128; const float* ps = p.in[11] + g * 128; const float* wo = p.in[12] + (size_t)(512 + g * 128) * D + j;
            f32x4 a = {0.f, 0.f, 0.f, 0.f};
#pragma unroll 16
            for (int d = 0; d < 128; ++d) { const f32x4 w = *(const f32x4*)(wo + (size_t)d * D); a += w * (pw[d] * ps[d]); }
#pragma unroll
            for (int q = 0; q < 4; ++q) Wo[(size_t)(j + q) * D + 512 + kk] = f2bf(a[q]);
        } else if (it < R4) {
            const int r = it - R3, j = (r & 127) * 8, kb = r >> 7, kk = kb * 64 + lane, part = kk >> 10, k2 = kk & 1023, g = k2 >> 8, c = k2 & 255;
            const float* wf = p.in[13] + (size_t)(g * 256) * D + j; const LAS float* tb = tab + part * 256;
            f32x4 a0 = {0.f, 0.f, 0.f, 0.f}, a1 = {0.f, 0.f, 0.f, 0.f};
#pragma unroll 8
            for (int d = 0; d < 256; ++d) { const f32x4 w0 = *(const f32x4*)(wf + (size_t)d * D), w1 = *(const f32x4*)(wf + (size_t)d * D + 4); const float t = tb[(c * d) & 255]; a0 += w0 * t; a1 += w1 * t; }
#pragma unroll
            for (int q = 0; q < 4; ++q) { W2t[(size_t)(j + q) * 2048 + kk] = f2bf(a0[q] * 0.0625f); W2t[(size_t)(j + 4 + q) * 2048 + kk] = f2bf(a1[q] * 0.0625f); }
        } else if (it < R5) { dft_item((bf16_t*)(p.ws + OFF_D1), LA, LPA, it - R4, lane);
        } else if (it < R6) { dft_item((bf16_t*)(p.ws + OFF_D2), LB, LPB, it - R5, lane);
        } else {
            const int r0 = (it - R6) * 2; const float* src[2]; f32x4 v[2][4];
#pragma unroll
            for (int q = 0; q < 2; ++q) { int gb, l, L, rb; row_decode(r0 + q, gb, l, L, rb);
                src[q] = (l < 16) ? p.in[2] + (size_t)l * D : (gb < NBA ? p.in[0] + ((size_t)gb * 4096 + (l - 16)) * D : p.in[1] + ((size_t)(gb - NBA) * 2048 + (l - 16)) * D); }
#pragma unroll
            for (int q = 0; q < 2; ++q)
#pragma unroll
                for (int i = 0; i < 4; ++i) v[q][i] = *(const f32x4*)(src[q] + (lane + 64 * i) * 4);
            float* rss0 = (float*)(p.ws + OFF_RSS);
#pragma unroll
            for (int q = 0; q < 2; ++q) { bf16_t* hb = (bf16_t*)(p.ws + OFF_HB) + (size_t)(r0 + q) * D; float ss = 0.f;
#pragma unroll
                for (int i = 0; i < 4; ++i) { ss += (v[q][i][0] * v[q][i][0] + v[q][i][1] * v[q][i][1]) + (v[q][i][2] * v[q][i][2] + v[q][i][3] * v[q][i][3]);
                    u32x2 o; o.x = cvt_pk_bf16(v[q][i][0], v[q][i][1]); o.y = cvt_pk_bf16(v[q][i][2], v[q][i][3]); *(u32x2*)(hb + (lane + 64 * i) * 4) = o; }
                ss = wave_sum(ss);
                if (lane == 0) { f32x4 q4 = {ss, 0.f, 0.f, 0.f}; *(f32x4*)(rss0 + (size_t)(r0 + q) * 4) = q4; } }
        }
    }
}

template <int HW> __device__ __forceinline__ void pool_item(const bf16_t* z, bf16_t* ap, int r, int ch) {
    int gb, l, L, rb; row_decode(r, gb, l, L, rb);
    const bf16_t* base = z + (size_t)r * INDIM + 768 + ch * 8;
    u32x4 v[2 * HW + 1];
#pragma unroll
    for (int o = 0; o <= 2 * HW; ++o) { const int s = l - HW + o; u32x4 t; t.x = 0; t.y = 0; t.z = 0; t.w = 0; if (s >= 0 && s < L) t = gload((const u32x4*)(base + (long)(o - HW) * INDIM)); v[o] = t; }
    float s0 = 0.f, s1 = 0.f, s2 = 0.f, s3 = 0.f, s4 = 0.f, s5 = 0.f, s6 = 0.f, s7 = 0.f;
#pragma unroll
    for (int o = 1; o < 2 * HW; ++o) { s0 += bflo(v[o].x); s1 += bfhi(v[o].x); s2 += bflo(v[o].y); s3 += bfhi(v[o].y); s4 += bflo(v[o].z); s5 += bfhi(v[o].z); s6 += bflo(v[o].w); s7 += bfhi(v[o].w); }
#pragma unroll
    for (int q = 0; q < 2; ++q) {
        const u32x4 ex = v[q ? 2 * HW : 0], me = v[HW + q]; const int lq = l + q;
        const float ic = 1.0f / (float)(min(lq + HW, L) - max(lq - HW, 0));
        u32x4 o; o.x = cvt_pk_bf16((s0 + bflo(ex.x)) * ic - bflo(me.x), (s1 + bfhi(ex.x)) * ic - bfhi(me.x)); o.y = cvt_pk_bf16((s2 + bflo(ex.y)) * ic - bflo(me.y), (s3 + bfhi(ex.y)) * ic - bfhi(me.y));
        o.z = cvt_pk_bf16((s4 + bflo(ex.z)) * ic - bflo(me.z), (s5 + bfhi(ex.z)) * ic - bfhi(me.z)); o.w = cvt_pk_bf16((s6 + bflo(ex.w)) * ic - bflo(me.w), (s7 + bfhi(ex.w)) * ic - bfhi(me.w));
        gstore((u32x4*)(ap + (size_t)(r + q) * D + 512 + ch * 8), o);
    }
}
struct PW { unsigned char* ws; float* out; };
__device__ __forceinline__ void attn_phase(const PW& p, LAS unsigned char* lds) {
    const bf16_t* z = (const bf16_t*)(p.ws + OFF_Z); bf16_t* ap = (bf16_t*)(p.ws + OFF_AP); const float* sink = (const float*)(p.ws + OFF_SMALL);
    const int tid = otid(), lane = tid & 63, wave = __builtin_amdgcn_readfirstlane(tid >> 6), fr = lane & 15, fq = lane >> 4;
    LAS unsigned char* Ks = lds;
    LAS unsigned char* Vt = lds + 55296;
    constexpr int NU = (NBA * 33 + NBB * 17) * 2;
    for (int unit = blockIdx.x; unit < NU; unit += gridDim.x) {
        const int kvh = unit & 1; int tt = unit >> 1; int sb, ti, L, rb;
        if (tt < NBA * 33) { sb = tt / 33; ti = tt - sb * 33; L = LA; rb = sb * LA; } else { tt -= NBA * 33; sb = tt / 17; ti = tt - sb * 17; L = LB; rb = TA + sb * LB; }
        const int l0 = ti * 128;
        __syncthreads();
        {
            typedef __attribute__((address_space(1))) const u32x4 gu32x4;
            u32x4 kreg[6], vreg[7];
#pragma unroll
            for (int i = 0; i < 6; ++i) { const int idx = tid + 512 * i, j = idx >> 3, ch = idx & 7, s = l0 - 128 + j; const bool ok = (s >= 0) && (s < L);
                kreg[i] = *(gu32x4*)(z + (size_t)(rb + (ok ? s : 0)) * INDIM + 512 + kvh * 64 + ch * 8); }
#pragma unroll
            for (int i = 0; i < 7; ++i) { const int idx = tid + 512 * i, ch = min(idx / 400, 7), j = idx - (idx / 400) * 400, s = l0 - 128 + j; const bool ok = (idx < 3200) && (j < 384) && (s >= 0) && (s < L);
                vreg[i] = *(gu32x4*)(z + (size_t)(rb + (ok ? s : 0)) * INDIM + 640 + kvh * 64 + ch * 8); }
            __builtin_amdgcn_sched_barrier(0);
#pragma unroll
            for (int i = 0; i < 6; ++i) { const int idx = tid + 512 * i, j = idx >> 3, s = l0 - 128 + j; const bool ok = (s >= 0) && (s < L);
                kreg[i].x = ok ? kreg[i].x : 0u; kreg[i].y = ok ? kreg[i].y : 0u; kreg[i].z = ok ? kreg[i].z : 0u; kreg[i].w = ok ? kreg[i].w : 0u; }
#pragma unroll
            for (int i = 0; i < 7; ++i) { const int idx = tid + 512 * i, j = idx - (idx / 400) * 400, s = l0 - 128 + j; const bool ok = (idx < 3200) && (j < 384) && (s >= 0) && (s < L);
                vreg[i].x = ok ? vreg[i].x : 0u; vreg[i].y = ok ? vreg[i].y : 0u; vreg[i].z = ok ? vreg[i].z : 0u; vreg[i].w = ok ? vreg[i].w : 0u; }
#pragma unroll
            for (int i = 0; i < 6; ++i) { const int idx = tid + 512 * i, j = idx >> 3, ch = idx & 7; *(LAS u32x4*)(Ks + j * 144 + ch * 16) = kreg[i]; }
#pragma unroll
            for (int i = 0; i < 7; ++i) { const int idx = tid + 512 * i; if (idx < 3200) { const int ch = idx / 400, j = idx - ch * 400; const u32x4 v = vreg[i];
                LAS bf16_t* dst = (LAS bf16_t*)Vt + (ch * 8) * 408 + j;
                dst[0 * 408] = (bf16_t)(v.x & 0xFFFFu); dst[1 * 408] = (bf16_t)(v.x >> 16); dst[2 * 408] = (bf16_t)(v.y & 0xFFFFu); dst[3 * 408] = (bf16_t)(v.y >> 16);
                dst[4 * 408] = (bf16_t)(v.z & 0xFFFFu); dst[5 * 408] = (bf16_t)(v.z >> 16); dst[6 * 408] = (bf16_t)(v.w & 0xFFFFu); dst[7 * 408] = (bf16_t)(v.w >> 16); } }
        }
        __syncthreads();
        const int lq0 = l0 + 16 * wave + fr;
        if (l0 + 16 * wave < L) {
#pragma unroll 1
            for (int g = 0; g < 4; ++g) {
                int lq = lq0; asm volatile("" : "+v"(lq)); const bool qok = lq < L;
                const int h = kvh * 4 + g; const float slope = exp2f(-(float)(h + 1)); const float sk = gload(sink + h);
                bf16x8 qf[2];
#pragma unroll
                for (int kk = 0; kk < 2; ++kk) { u32x4 q; q.x = 0; q.y = 0; q.z = 0; q.w = 0; if (qok) q = gload((const u32x4*)(z + (size_t)(rb + lq) * INDIM + h * 64 + kk * 32 + fq * 8)); qf[kk] = __builtin_bit_cast(bf16x8, q); }
                f32x4 sc[17];
                {
                    const LAS unsigned char* kb = Ks + (16 * wave + fr) * 144 + fq * 16;
                    bf16x8 kc0 = *(const LAS bf16x8*)(kb), kc1 = *(const LAS bf16x8*)(kb + 64);
#pragma unroll
                    for (int t = 0; t < 17; ++t) { bf16x8 kn0 = kc0, kn1 = kc1;
                        if (t < 16) { kn0 = *(const LAS bf16x8*)(kb + (t + 1) * 2304); kn1 = *(const LAS bf16x8*)(kb + (t + 1) * 2304 + 64); }
                        f32x4 a = {0.f, 0.f, 0.f, 0.f};
                        a = __builtin_amdgcn_mfma_f32_16x16x32_bf16(kc0, qf[0], a, 0, 0, 0); a = __builtin_amdgcn_mfma_f32_16x16x32_bf16(kc1, qf[1], a, 0, 0, 0);
                        sc[t] = a; kc0 = kn0; kc1 = kn1; __builtin_amdgcn_sched_barrier(0); }
                }
                float mx = -1e30f;
                int db = 128 + fr - 4 * fq, lob = 128 - l0 - 16 * wave - 4 * fq; asm volatile("" : "+v"(db), "+v"(lob));
#pragma unroll
                for (int t = 0; t < 17; ++t)
#pragma unroll
                    for (int e = 0; e < 4; ++e) { const int off = 16 * t + e; const int dist = abs(db - off);
                        bool valid = (unsigned)(off - lob) < (unsigned)L;
                        if (t == 0 || t == 16) valid = valid && (dist <= 128);
                        const float v = valid ? fmaf(-slope, (float)dist, sc[t][e]) : -1e30f; sc[t][e] = v; mx = fmaxf(mx, v); }
                mx = fmaxf(mx, __shfl_xor(mx, 16)); mx = fmaxf(mx, __shfl_xor(mx, 32)); mx = fmaxf(mx, sk);
                float sum = 0.f;
#pragma unroll
                for (int t = 0; t < 17; ++t)
#pragma unroll
                    for (int e = 0; e < 4; ++e) { const float pv = __expf(sc[t][e] - mx); sc[t][e] = pv; sum += pv; }
                sum += __shfl_xor(sum, 16); sum += __shfl_xor(sum, 32); sum += __expf(sk - mx);
                const float inv = 1.0f / sum;
                f32x4 o[4];
#pragma unroll
                for (int dt = 0; dt < 4; ++dt) o[dt] = (f32x4){0.f, 0.f, 0.f, 0.f};
                {
                    const LAS unsigned char* vb = Vt + fr * 816 + (16 * wave + 4 * fq) * 2;
                    u32x2 vlo[4], vhi[4];
#pragma unroll
                    for (int dt = 0; dt < 4; ++dt) { vlo[dt] = *(const LAS u32x2*)(vb + dt * 13056); vhi[dt] = *(const LAS u32x2*)(vb + dt * 13056 + 32); }
#pragma unroll
                    for (int u = 0; u < 9; ++u) {
                        u32x2 nlo[4], nhi[4];
#pragma unroll
                        for (int dt = 0; dt < 4; ++dt) { nlo[dt] = vlo[dt]; nhi[dt] = vhi[dt]; }
                        if (u < 8) {
#pragma unroll
                            for (int dt = 0; dt < 4; ++dt) { nlo[dt] = *(const LAS u32x2*)(vb + dt * 13056 + (u + 1) * 64); nhi[dt] = *(const LAS u32x2*)(vb + dt * 13056 + (u + 1) * 64 + 32); } }
                        u32x4 pw; pw.x = cvt_pk_bf16(sc[2 * u][0], sc[2 * u][1]); pw.y = cvt_pk_bf16(sc[2 * u][2], sc[2 * u][3]);
                        if (2 * u + 1 < 17) { pw.z = cvt_pk_bf16(sc[(2 * u + 1) % 17][0], sc[(2 * u + 1) % 17][1]); pw.w = cvt_pk_bf16(sc[(2 * u + 1) % 17][2], sc[(2 * u + 1) % 17][3]); } else { pw.z = 0; pw.w = 0; }
                        const bf16x8 pf = __builtin_bit_cast(bf16x8, pw);
#pragma unroll
                        for (int dt = 0; dt < 4; ++dt) { u32x4 vv; vv.x = vlo[dt].x; vv.y = vlo[dt].y; vv.z = vhi[dt].x; vv.w = vhi[dt].y;
                            o[dt] = __builtin_amdgcn_mfma_f32_16x16x32_bf16(__builtin_bit_cast(bf16x8, vv), pf, o[dt], 0, 0, 0); }
#pragma unroll
                        for (int dt = 0; dt < 4; ++dt) { vlo[dt] = nlo[dt]; vhi[dt] = nhi[dt]; }
                        __builtin_amdgcn_sched_barrier(0);
                    }
                }
                if (qok) {
#pragma unroll
                    for (int dt = 0; dt < 4; ++dt) { u32x2 w; w.x = cvt_pk_bf16(o[dt][0] * inv, o[dt][1] * inv); w.y = cvt_pk_bf16(o[dt][2] * inv, o[dt][3] * inv);
                        gstore((u32x2*)(ap + (size_t)(rb + lq) * D + h * 64 + 16 * dt + 4 * fq), w); }
                }
            }
        }
    }
    constexpr int PER_G = (T / 2) * 16;
    for (int it = blockIdx.x * 512 + tid; it < 4 * PER_G; it += gridDim.x * 512) {
        const int g = it / PER_G, rem = it - g * PER_G, r = (rem >> 4) * 2, ch = g * 16 + (rem & 15);
        if (g == 0) pool_item<1>(z, ap, r, ch); else if (g == 1) pool_item<2>(z, ap, r, ch); else if (g == 2) pool_item<4>(z, ap, r, ch); else pool_item<8>(z, ap, r, ch);
    }
}

__device__ __forceinline__ void normT_phase(const PW& p, LAS unsigned char* lds) {
    const int tid = otid(), lane = tid & 63, wave = __builtin_amdgcn_readfirstlane(tid >> 6);
    const float* gain = (const float*)(p.ws + OFF_SMALL) + 1024; bf16_t* HNT = (bf16_t*)(p.ws + OFF_HNT);
    LAS bf16_t* Tt = (LAS bf16_t*)lds;
    constexpr int NUA = NBA * (LPA / 64), NU = NUA + NBB * (LPB / 64);
    for (int unit = blockIdx.x; unit < NU; unit += gridDim.x) {
        int sb, ti, L, LP, rb; bf16_t* dst;
        if (unit < NUA) { sb = unit / (LPA / 64); ti = unit - sb * (LPA / 64); L = LA; LP = LPA; rb = sb * LA; dst = HNT + (size_t)sb * D * LPA; }
        else { const int uu = unit - NUA; sb = uu / (LPB / 64); ti = uu - sb * (LPB / 64); L = LB; LP = LPB; rb = TA + sb * LB; dst = HNT + HNT_B + (size_t)sb * D * LPB; }
        const int l0 = ti * 64;
        __syncthreads();
        {
            unsigned raw[8][8]; float rs[8];
#pragma unroll
            for (int rr = 0; rr < 8; ++rr) { const int l = l0 + wave * 8 + rr; const bool ok = l < L;
                const unsigned* hp = (const unsigned*)((const bf16_t*)(p.ws + OFF_HB) + (size_t)(rb + min(l, L - 1)) * D);
#pragma unroll
                for (int i = 0; i < 8; ++i) { unsigned t = gload(hp + lane + 64 * i); raw[rr][i] = ok ? t : 0u; } }
#pragma unroll
            for (int rr = 0; rr < 8; ++rr) { float ss = 0.f;
#pragma unroll
                for (int i = 0; i < 8; ++i) { const float a = bflo(raw[rr][i]), b = bfhi(raw[rr][i]); ss += a * a + b * b; }
                ss = wave_sum(ss); rs[rr] = __builtin_amdgcn_rsqf(ss * (1.0f / 1024.0f) + 1e-6f); }
            LAS unsigned* TtW = (LAS unsigned*)lds;
#pragma unroll
            for (int i = 0; i < 8; ++i) { const float g0 = gain[2 * lane + 128 * i], g1 = gain[2 * lane + 128 * i + 1]; const int c0 = 2 * lane + 128 * i;
#pragma unroll
                for (int q = 0; q < 4; ++q) {
                    TtW[c0 * 33 + wave * 4 + q] = cvt_pk_bf16(bflo(raw[2 * q][i]) * rs[2 * q] * g0, bflo(raw[2 * q + 1][i]) * rs[2 * q + 1] * g0);
                    TtW[(c0 + 1) * 33 + wave * 4 + q] = cvt_pk_bf16(bfhi(raw[2 * q][i]) * rs[2 * q] * g1, bfhi(raw[2 * q + 1][i]) * rs[2 * q + 1] * g1); } }
        }
        __syncthreads();
#pragma unroll 8
        for (int i = 0; i < 64; ++i) { const int idx = tid + 512 * i; const int c = idx >> 5, pr = idx & 31;
            const unsigned v = *(const LAS unsigned*)(Tt + c * 66 + 2 * pr); gstore((unsigned*)(dst + (size_t)c * LP + l0 + 2 * pr), v); }
    }
}

__device__ __forceinline__ void final_phase(const PW& p) {
    const int tid = otid(); const int lane = tid & 63, gw = blockIdx.x * 8 + (tid >> 6), NGW = gridDim.x * 8; const float* gf = (const float*)(p.ws + OFF_SMALL) + 2048;
    const bf16_t* hb = (const bf16_t*)(p.ws + OFF_HB); const float* rss = (const float*)(p.ws + OFF_RSS);
    f32x4 gv[4];
#pragma unroll
    for (int i = 0; i < 4; ++i) gv[i] = *(const f32x4*)(gf + lane * 8 + 512 * (i >> 1) + 4 * (i & 1));
    for (int row = gw; row < 98304; row += NGW) {
        int r; if (row < NBA * 4096) { const int gb = row >> 12; r = row + 16 * (gb + 1); } else { const int o2 = row - NBA * 4096, b = o2 >> 11; r = TA + b * LB + 16 + (o2 - (b << 11)); }
        const f32x4 q4 = gload((const f32x4*)(rss + (size_t)r * 4)); const float rs = rstd_of((q4[0] + q4[1]) + (q4[2] + q4[3]));
        const bf16_t* hp = hb + (size_t)r * D; float* op = p.out + (size_t)row * D;
        const u32x4 w0 = gload((const u32x4*)(hp + lane * 8)), w1 = gload((const u32x4*)(hp + 512 + lane * 8));
        f32x4 a, b2, c2, d2;
        a[0] = bflo(w0.x); a[1] = bfhi(w0.x); a[2] = bflo(w0.y); a[3] = bfhi(w0.y); b2[0] = bflo(w0.z); b2[1] = bfhi(w0.z); b2[2] = bflo(w0.w); b2[3] = bfhi(w0.w);
        c2[0] = bflo(w1.x); c2[1] = bfhi(w1.x); c2[2] = bflo(w1.y); c2[3] = bfhi(w1.y); d2[0] = bflo(w1.z); d2[1] = bfhi(w1.z); d2[2] = bflo(w1.w); d2[3] = bfhi(w1.w);
        gstore((f32x4*)(op + lane * 8), a * rs * gv[0]); gstore((f32x4*)(op + lane * 8 + 4), b2 * rs * gv[1]);
        gstore((f32x4*)(op + 512 + lane * 8), c2 * rs * gv[2]); gstore((f32x4*)(op + 512 + lane * 8 + 4), d2 * rs * gv[3]);
    }
}

enum { K_PREP = 0, K_GGU, K_DOWN, K_GZ, K_ATTN, K_APO, K_NORMT, K_DFT, K_FO, K_FINAL };
#ifndef REP_PREP
#define REP_PREP 1
#endif
__global__ void __launch_bounds__(512, 2) mega_fwd(Params p0) {
    extern __shared__ __attribute__((aligned(16))) unsigned char shm[];
    LAS unsigned char* lds = (LAS unsigned char*)shm;
    cg::grid_group grid = cg::this_grid();
    volatile LAS unsigned* xst = (volatile LAS unsigned*)(lds + (LDS_BYTES - 16));
    if (threadIdx.x == 0) { xst[0] = 0u; xst[1] = 0u; }
    __syncthreads();
    XcdBarrier xb = xcd_barrier_post((unsigned*)(p0.ws + OFF_BAR), xst);
    const int nrep = REP_PREP + (p0.out == nullptr ? 1 : 0);
#pragma unroll 1
    for (int rep = 0; rep < nrep; ++rep) { prep_phase(p0, lds); grid.sync(); }
#ifdef PROBE_SLEEP_TICKS
    { const unsigned long long t0 = __builtin_amdgcn_s_memrealtime(); while (__builtin_amdgcn_s_memrealtime() - t0 < (unsigned long long)PROBE_SLEEP_TICKS) __builtin_amdgcn_s_sleep(32); }
#endif
    PW p; p.ws = p0.ws; p.out = p0.out;
    { unsigned long long w = (unsigned long long)p.ws, o = (unsigned long long)p.out; asm volatile("" : "+s"(w), "+s"(o)); p.ws = (unsigned char*)w; p.out = (float*)o; }
#pragma unroll 1
    for (int ph = 1; ph < 16; ++ph) {
        int kind, f = 0, rbuf = 0;
        switch (ph) {
            case 0: kind = K_PREP; break;
            case 1: kind = K_GGU; f = 0; rbuf = 0; break;
            case 2: kind = K_DOWN; f = 0; rbuf = 1; break;
            case 3: kind = K_GZ; rbuf = 1; break;
            case 4: kind = K_ATTN; break;
            case 5: kind = K_APO; rbuf = 0; break;
            case 6: kind = K_GGU; f = 1; rbuf = 0; break;
            case 7: kind = K_DOWN; f = 1; rbuf = 1; break;
            case 8: kind = K_GGU; f = 2; rbuf = 1; break;
            case 9: kind = K_DOWN; f = 2; rbuf = 0; break;
            case 10: kind = K_NORMT; break;
            case 11: kind = K_DFT; break;
            case 12: kind = K_FO; rbuf = 1; break;
            case 13: kind = K_GGU; f = 3; rbuf = 1; break;
            case 14: kind = K_DOWN; f = 3; rbuf = 0; break;
            default: kind = K_FINAL; break;
        }
        const int c = (int)blockIdx.x;
        if (kind == K_PREP) {
        } else if (kind == K_GGU) {
#ifndef NO_GGU
            EpiGateUp E; E.act = (bf16_t*)(p.ws + OFF_ACT); E.rss = (const float*)(p.ws + OFF_RSS);
#ifndef REP_GGU
#define REP_GGU 1
#endif
#pragma unroll 1
            for (int rep = 0; rep < REP_GGU; ++rep) {
            run_gemm(lds, (const bf16_t*)(p.ws + OFF_HB), (const bf16_t*)(p.ws + OFF_WGU) + (size_t)f * NGU * D, TPAD, NGU, D, E, c);
            if (rep + 1 < REP_GGU) grid.sync(); }
#ifdef PROBE_KLOOP
            xcd_barrier(xb); { EpiNone EN; pg8::Gemm g; g.A = (const bf16_t*)(p.ws + OFF_HB); g.Bt = (const bf16_t*)(p.ws + OFF_WGU) + (size_t)f * NGU * D; g.M = TPAD; g.N = NGU; g.K = D; g.ld = D;
#if PROBE_KLOOP == 2
              LocalOrder S;
#else
              pg8::StaticOrder S;
#endif
              S.init(TPAD, NGU, (int)gridDim.x, c); pg8::gemm_phase<EpiNone, decltype(S), false>(lds, g, S, EN, nullptr); }
#endif
#endif
        } else if (kind == K_DOWN || kind == K_APO || kind == K_FO) {
#ifndef NO_GRES
            const bf16_t* A; const bf16_t* Bt; int K; float scale;
            if (kind == K_DOWN) { A = (const bf16_t*)(p.ws + OFF_ACT); Bt = (const bf16_t*)(p.ws + OFF_WD) + (size_t)f * D * DFF; K = DFF; scale = 0.5f; }
            else if (kind == K_APO) { A = (const bf16_t*)(p.ws + OFF_AP); Bt = (const bf16_t*)(p.ws + OFF_WO); K = D; scale = 1.0f; }
            else { A = (const bf16_t*)(p.ws + OFF_X); Bt = (const bf16_t*)(p.ws + OFF_W2T); K = 2048; scale = 1.0f; }
            { EpiResid<false> E; E.out = p.out; E.ws = p.ws; E.half = (kind == K_DOWN); E.rss4 = (float*)(p.ws + OFF_RSS); E.part = (LAS float*)(lds + 131072);
              pg8::Gemm g; g.A = A; g.Bt = Bt; g.M = TPAD; g.N = D; g.K = K; g.ld = K;
              const bool split = (int)gridDim.x == 256 && K >= 2048;
              CapOrder S; S.init2(TPAD, D, (int)gridDim.x, c, split ? TAIL_L0 : (TPAD / 256) * 4);
              pg8::gemm_phase<EpiResid<false>, CapOrder, false>(lds, g, S, E, nullptr);
              if (split) {
                  const int nsl = K / 256;
                  if (c < TAIL_UNITS * nsl) { const int tu = c / nsl, sl = c - tu * nsl;
                      EpiPartial EP; EP.P = (float*)(p.ws + OFF_PART) + (size_t)(tu * 16 + sl) * 65536;
                      pg8::Gemm g2; g2.A = A + sl * 256; g2.Bt = Bt + sl * 256; g2.M = TPAD; g2.N = D; g2.K = K / nsl; g2.ld = K;
                      TailOrder S2; S2.init2(TPAD, D, tu);
                      pg8::gemm_phase<EpiPartial, TailOrder, false>(lds, g2, S2, EP, nullptr); }
                  xcd_barrier(xb);
                  tail_fixup(p.ws, nsl, kind == K_DOWN);
              } }
#endif
        } else if (kind == K_GZ) {
#ifndef NO_GZ
            EpiScale E; E.O = (bf16_t*)(p.ws + OFF_Z); E.ldc = INDIM; E.rss = (const float*)(p.ws + OFF_RSS);
            run_gemm(lds, (const bf16_t*)(p.ws + OFF_HB), (const bf16_t*)(p.ws + OFF_WIN), TPAD, INDIM, D, E, c);
#endif
        } else if (kind == K_ATTN) {
#ifndef REP_ATTN
#define REP_ATTN 1
#endif
            for (int rep = 0; rep < REP_ATTN; ++rep) { attn_phase(p, lds); if (rep + 1 < REP_ATTN) grid.sync(); }
        } else if (kind == K_NORMT) {
#ifndef REP_NORMT
#define REP_NORMT 1
#endif
            for (int rep = 0; rep < REP_NORMT; ++rep) { normT_phase(p, lds); if (rep + 1 < REP_NORMT) grid.sync(); }
        } else if (kind == K_DFT) {
#ifndef NO_GDFT
#ifndef REP_DFT
#define REP_DFT 1
#endif
#pragma unroll 1
            for (int grp = 0; grp < 2; ++grp) {
                EpiDft E; E.X = (bf16_t*)(p.ws + OFF_X); E.L = grp ? LB : LA; E.rowbase = grp ? TA : 0;
                pg8::Gemm g; g.A = (const bf16_t*)(p.ws + (grp ? OFF_D2 : OFF_D1)); g.Bt = (const bf16_t*)(p.ws + OFF_HNT) + (grp ? HNT_B : 0); g.M = grp ? MPB : MPA; g.N = (grp ? NBB : NBA) * D; g.K = grp ? LPB : LPA; g.ld = g.K;
                const bool bal = grp && (int)gridDim.x == 256;
                DftOrder S; S.init2(g.M, g.N, (int)gridDim.x, (grp && !bal) ? (int)gridDim.x - 1 - c : c, bal ? 1 : 0);
                pg8::gemm_phase<EpiDft, DftOrder, false>(lds, g, S, E, nullptr);
            }
#endif
        } else {
#ifndef NO_FINAL
            final_phase(p);
#endif
        }
#ifdef USE_CG_SYNC
        if (ph != 15) grid.sync();
#else
        if (ph != 15) xcd_barrier(xb);
#endif
    }
}

extern "C" void kernel_launch(void* const* d_in, const int* in_sizes, int n_in, void* d_out, int out_size, void* d_ws, size_t ws_size, hipStream_t stream) {
    static int grid = 0;
    if (grid == 0) {
        if (n_in != 19 || ws_size < WS_NEED) { fprintf(stderr, "kernel_launch: need 19 inputs and %zu bytes of workspace (got %d, %zu)\n", (size_t)WS_NEED, n_in, ws_size); grid = -1; return; }
        int dev = 0, cus = 0, per_cu = 0;
        hipGetDevice(&dev); hipDeviceGetAttribute(&cus, hipDeviceAttributeMultiprocessorCount, dev);
        if (hipFuncSetAttribute((const void*)mega_fwd, hipFuncAttributeMaxDynamicSharedMemorySize, LDS_BYTES) != hipSuccess) { fprintf(stderr, "kernel_launch: hipFuncSetAttribute failed\n"); grid = -1; return; }
        if (hipOccupancyMaxActiveBlocksPerMultiprocessor(&per_cu, (const void*)mega_fwd, 512, LDS_BYTES) != hipSuccess || per_cu < 1) { fprintf(stderr, "kernel_launch: occupancy query gave %d\n", per_cu); per_cu = 1; (void)hipGetLastError(); }
        grid = cus * 1;
    }
    if (grid < 0) return;
    Params p{};
    for (int i = 0; i < 19; ++i) p.in[i] = (const float*)d_in[i];
    p.out = (float*)d_out; p.ws = (unsigned char*)d_ws;
    if (hipMemsetAsync((unsigned char*)d_ws + OFF_BAR, 0, (size_t)XCD_BAR_WORDS * 4, stream) != hipSuccess) { fprintf(stderr, "kernel_launch: memset of barrier words failed\n"); return; }
    void* args[] = {&p};
    hipError_t e = hipLaunchCooperativeKernel((const void*)mega_fwd, dim3(grid), dim3(512), args, LDS_BYTES, stream);
    if (e != hipSuccess) fprintf(stderr, "cooperative launch failed: %s (grid %d)\n", hipGetErrorString(e), grid);
}
```

```cpp
#include <hip/hip_runtime.h>
#include <hip/hip_cooperative_groups.h>
#include <cstdio>
namespace cg = cooperative_groups;
#define LAS __attribute__((address_space(3)))
namespace pg8 {
#define PG8_LAS __attribute__((address_space(3)))
typedef unsigned short bf16_t;
typedef short bf16x8 __attribute__((ext_vector_type(8)));
typedef float f32x4 __attribute__((ext_vector_type(4)));
typedef unsigned u32x4 __attribute__((ext_vector_type(4)));
constexpr int BM = 256, BK = 64, HALF = 128, HTB = HALF * BK * 2  , STAGE_BYTES = 8 * HTB, NXCD = 8, WGM = 8;

__host__ __device__ __forceinline__ int lds_byte(int r, int c) { const int st = (r >> 4) * 2 + (c >> 5), rr = r & 15, cc = c & 31, ob = rr * 64 + cc * 2; return st * 1024 + (ob ^ (((ob >> 9) & 1) << 5)); }
__host__ __device__ __forceinline__ void stage_rc(int b, int& R, int& C) { const int st = b / 1024, sb = b % 1024, swz = sb ^ (((sb >> 9) & 1) << 5); R = (st >> 1) * 16 + swz / 64; C = (st & 1) * 32 + (swz % 64) / 2; }
__host__ __device__ __forceinline__ int perm32(int rho) { const int n = rho >> 4, i = rho & 15; return 8 * (i >> 2) + 4 * n + (i & 3); }

struct Unit { int pm, pn; };
struct Gemm { const bf16_t* A; const bf16_t* Bt; int M, N, K, ld; };

struct StaticOrder {
    int nM, nN, nwg, G, c;
    __host__ __device__ void init(int M, int N, int G_, int c_) { nM = M / BM; nN = N / BM; nwg = nM * nN; G = G_; c = c_; }
    __host__ __device__ bool next(int i, Unit& u) const {
        const int L = i * G + c; if (L >= nwg) return false;
        int wgid = (int)L; { const int q = nwg / NXCD, r = nwg % NXCD, xcd = wgid % NXCD, off = wgid / NXCD; wgid = (xcd < r ? xcd * (q + 1) : r * (q + 1) + (xcd - r) * q) + off; }
        const int nig = WGM * nN, gid = wgid / nig, fm = gid * WGM, gsz = (nM - fm) < WGM ? (nM - fm) : WGM;
        u.pm = fm + ((wgid % nig) % gsz); u.pn = (wgid % nig) / gsz; return true;
    }
    __device__ __forceinline__ void a_ready(const Unit&) const {}
    __device__ __forceinline__ void done(const Unit&) const {}
};
__device__ __forceinline__ unsigned cvt_pk_bf16(float lo, float hi) { unsigned r; asm volatile("v_cvt_pk_bf16_f32 %0, %1, %2" : "=v"(r) : "v"(lo), "v"(hi)); return r; }
template <class Epi, class Sched, bool STAMP = false>
__device__ __forceinline__ void gemm_phase(PG8_LAS unsigned char* lds, const Gemm g, const Sched& S, const Epi& E, unsigned long long* stamps) {
    int tid_o = threadIdx.x; asm volatile("" : "+v"(tid_o));
    const int tid = tid_o, wid = __builtin_amdgcn_readfirstlane(tid >> 6), lane = tid & 63, wr = wid >> 2, wc = wid & 3, fr = lane & 15, fq = lane >> 4;
    const int K = g.ld, nt = g.K / BK;
    int ts_lo = 0, ts_hi = 0, nts = 0; const unsigned long long rt_entry = STAMP ? (unsigned long long)wall_clock64() : 0ull;
#define PG8_STAMP() do { if (STAMP && wid == 0 && nts < 64) { const unsigned long long _c = (unsigned long long)clock64(); \
        ts_lo = (lane == nts) ? (int)(unsigned)_c : ts_lo; ts_hi = (lane == nts) ? (int)(unsigned)(_c >> 32) : ts_hi; ++nts; } } while (0)
    PG8_STAMP();
    unsigned voffA[2], voffB[2];
#pragma unroll
    for (int i = 0; i < 2; ++i) { int R, C; stage_rc(tid * 16 + i * 8192, R, C); const int Rb = Epi::PERM ? ((R & ~31) + perm32(R & 31)) : R;
        voffA[i] = (unsigned)(R * K + C) * 2u; voffB[i] = (unsigned)(Rb * K + C) * 2u; }
    const size_t kstep = (size_t)(BK * 2);
    const size_t hstep = (size_t)HALF * K * 2;
    const size_t tstep = 2 * hstep;
    const unsigned ldsw = (unsigned)wid * 1024u;
    const int aoff = lds_byte(wr * 64 + fr, fq * 8), boff = lds_byte(wc * 32 + fr, fq * 8);
#define PG8_SA(b, h) (((b) * 2 + (h)) * HTB)
#define PG8_SB(b, h) ((4 + (b) * 2 + (h)) * HTB)
#define PG8_STAGE(bufoff, gbase, voff) do { _Pragma("unroll") for (int _i = 0; _i < 2; ++_i) \
        __builtin_amdgcn_global_load_lds((const unsigned*)((const char*)(gbase) + (voff)[_i]), (PG8_LAS unsigned*)(lds + (bufoff) + ldsw + _i * 8192), 16, 0, 0); } while (0)
#define PG8_LDA(dst, b, h) do { _Pragma("unroll") for (int m = 0; m < 4; ++m) _Pragma("unroll") for (int k = 0; k < 2; ++k) dst[m][k] = *(const PG8_LAS bf16x8*)(lds + PG8_SA(b, h) + aoff + m * 2048 + k * 1024); } while (0)
#define PG8_LDB(dst, b, h) do { _Pragma("unroll") for (int n = 0; n < 2; ++n) _Pragma("unroll") for (int k = 0; k < 2; ++k) dst[n][k] = *(const PG8_LAS bf16x8*)(lds + PG8_SB(b, h) + boff + n * 2048 + k * 1024); } while (0)
#define PG8_MMA(ai, bj, At, Bt) do { __builtin_amdgcn_s_setprio(1); _Pragma("unroll") for (int m = 0; m < 4; ++m) _Pragma("unroll") for (int n = 0; n < 2; ++n) _Pragma("unroll") for (int k = 0; k < 2; ++k) \
        acc[ai][bj][m][n] = __builtin_amdgcn_mfma_f32_16x16x32_bf16(Bt[n][k], At[m][k], acc[ai][bj][m][n], 0, 0, 0); __builtin_amdgcn_s_setprio(0); } while (0)
#define PG8_WAIT_V(n) asm volatile("s_waitcnt vmcnt(" #n ")" ::: "memory")
#define PG8_WAIT_L(n) asm volatile("s_waitcnt lgkmcnt(" #n ")" ::: "memory")
#define PG8_BAR __builtin_amdgcn_s_barrier()
#define PG8_SCHED __builtin_amdgcn_sched_barrier(0)
    Unit cur, nxt; int ui = 0;
    if (!S.next(0, cur)) return;
    f32x4 acc[2][2][4][2];
#pragma unroll
    for (int a = 0; a < 2; ++a)
#pragma unroll
        for (int b = 0; b < 2; ++b)
#pragma unroll
            for (int m = 0; m < 4; ++m)
#pragma unroll
                for (int n = 0; n < 2; ++n) acc[a][b][m][n] = (f32x4){0.f, 0.f, 0.f, 0.f};
    bf16x8 At[4][2], B0[2][2], B1[2][2];
    const char* cA = (const char*)g.A + (size_t)cur.pm * tstep; const char* cB = (const char*)g.Bt + (size_t)cur.pn * tstep;
    S.a_ready(cur);
    PG8_STAGE(PG8_SB(0, 0), cB, voffB); PG8_STAGE(PG8_SA(0, 0), cA, voffA); PG8_STAGE(PG8_SB(0, 1), cB + hstep, voffB); PG8_STAGE(PG8_SA(0, 1), cA + hstep, voffA);
    if (wr == 1) PG8_BAR;
    PG8_WAIT_V(4); PG8_BAR;
    PG8_STAGE(PG8_SB(1, 0), cB + kstep, voffB); PG8_STAGE(PG8_SA(1, 0), cA + kstep, voffA); PG8_STAGE(PG8_SB(1, 1), cB + hstep + kstep, voffB);
    PG8_WAIT_V(6); PG8_BAR;
    PG8_STAMP();
    for (;;) {
        const bool has_next = S.next(ui + 1, nxt);
        const char* nA = has_next ? (const char*)g.A + (size_t)nxt.pm * tstep : cA; const char* nB = has_next ? (const char*)g.Bt + (size_t)nxt.pn * tstep : cB;
        for (int t = 0; t < nt; t += 2) {
            const bool last = (t == nt - 2);
            const char* a1 = cA + (size_t)(t + 1) * kstep;
            const char* a2 = last ? nA : cA + (size_t)(t + 2) * kstep; const char* b2 = last ? nB : cB + (size_t)(t + 2) * kstep;
            const char* a3 = a2 + kstep; const char* b3 = b2 + kstep;
            if (last && has_next) S.a_ready(nxt);
            PG8_LDB(B0, 0, 0); PG8_SCHED; PG8_LDA(At, 0, 0); PG8_STAGE(PG8_SA(1, 1), a1 + hstep, voffA);
            PG8_WAIT_L(8); PG8_BAR; PG8_WAIT_L(0); PG8_MMA(0, 0, At, B0); PG8_BAR; PG8_SCHED;
            PG8_LDB(B1, 0, 1); PG8_STAGE(PG8_SB(0, 0), b2, voffB);
            PG8_BAR; PG8_WAIT_L(0); PG8_MMA(0, 1, At, B1); PG8_BAR;
            PG8_LDA(At, 0, 1); PG8_STAGE(PG8_SA(0, 0), a2, voffA);
            PG8_BAR; PG8_WAIT_L(0); PG8_MMA(1, 0, At, B0); PG8_BAR; PG8_SCHED;
            PG8_STAGE(PG8_SB(0, 1), b2 + hstep, voffB);
            PG8_WAIT_V(6); PG8_BAR; PG8_MMA(1, 1, At, B1); PG8_BAR;
            PG8_LDB(B0, 1, 0); PG8_SCHED; PG8_LDA(At, 1, 0); PG8_STAGE(PG8_SA(0, 1), a2 + hstep, voffA);
            PG8_WAIT_L(8); PG8_BAR; PG8_WAIT_L(0); PG8_MMA(0, 0, At, B0); PG8_BAR; PG8_SCHED;
            PG8_LDB(B1, 1, 1); PG8_STAGE(PG8_SB(1, 0), b3, voffB);
            PG8_BAR; PG8_WAIT_L(0); PG8_MMA(0, 1, At, B1); PG8_BAR;
            PG8_LDA(At, 1, 1); PG8_STAGE(PG8_SA(1, 0), a3, voffA);
            PG8_BAR; PG8_WAIT_L(0); PG8_MMA(1, 0, At, B0); PG8_BAR; PG8_SCHED;
            PG8_STAGE(PG8_SB(1, 1), b3 + hstep, voffB);
            PG8_WAIT_V(6); PG8_BAR; PG8_MMA(1, 1, At, B1); PG8_BAR;
        }
        PG8_STAMP();
        if constexpr (!Epi::AFTER_DRAIN) { E(acc, cur, wr, wc, fr, fq); S.done(cur); }
        PG8_STAMP();
        if (!has_next) break;
#pragma unroll
        for (int a = 0; a < 2; ++a)
#pragma unroll
            for (int b = 0; b < 2; ++b)
#pragma unroll
                for (int m = 0; m < 4; ++m)
#pragma unroll
                    for (int n = 0; n < 2; ++n) acc[a][b][m][n] = (f32x4){0.f, 0.f, 0.f, 0.f};
        cur = nxt; cA = nA; cB = nB; ++ui;
    }
    PG8_WAIT_V(0);
    if (wr == 0) PG8_BAR;
    PG8_BAR;
    if constexpr (Epi::AFTER_DRAIN) { E.fused(acc, cur, wr, wc, fr, fq, lds, wid, lane); S.done(cur); }
    PG8_STAMP();
    if (STAMP && wid == 0) { stamps[lane] = lane < nts ? (((unsigned long long)(unsigned)ts_hi << 32) | (unsigned)ts_lo) : 0ull;
        if (lane == 62) stamps[62] = rt_entry; if (lane == 63) stamps[63] = (unsigned long long)wall_clock64(); }
#undef PG8_STAMP
#undef PG8_SA
#undef PG8_SB
#undef PG8_STAGE
#undef PG8_LDA
#undef PG8_LDB
#undef PG8_MMA
#undef PG8_WAIT_V
#undef PG8_WAIT_L
#undef PG8_BAR
#undef PG8_SCHED
}
}
#define XB_TMO      128
#define XB_XCNT(j)  (256  + 64 * (j))
#define XB_XSUB(j)  (1280 + 64 * (j))
#define XB_XGEN(j)  (2304 + 64 * (j))
#define XB_TOP      3328
#define XB_TOPGEN   3392
#define XCD_BAR_WORDS 3456
#define XB_SPIN_CAP (1u << 18)

__device__ __forceinline__ unsigned xb_ld(unsigned* p)              { return __hip_atomic_load(p, __ATOMIC_RELAXED, __HIP_MEMORY_SCOPE_AGENT); }
__device__ __forceinline__ unsigned xb_add(unsigned* p, unsigned v) { return __hip_atomic_fetch_add(p, v, __ATOMIC_RELAXED, __HIP_MEMORY_SCOPE_AGENT); }
__device__ __forceinline__ unsigned xb_xcc_id() { return (unsigned)__builtin_amdgcn_s_getreg((3 << 11) | 20) & 0xFu; }
#define XB_SPIN(cond, bar) do { unsigned _sp = 0; while (cond) { __builtin_amdgcn_s_sleep(1); \
    if ((++_sp & 255u) == 0u) { if (xb_ld(&(bar)[XB_TMO])) break; if (_sp > XB_SPIN_CAP) { atomicAdd(&(bar)[XB_TMO], 1u); break; } } } } while (0)

struct XcdBarrier {
    unsigned* bar; unsigned x;
    volatile LAS unsigned* st;
};

__device__ __forceinline__ XcdBarrier xcd_barrier_post(unsigned* bar, volatile LAS unsigned* st) {
    XcdBarrier b; b.bar = bar; b.x = xb_xcc_id(); b.st = st;
    if (threadIdx.x == 0) (void)xb_add(&bar[XB_XCNT(b.x)], 1u);
    return b;
}
__device__ __forceinline__ void xcd_barrier_complete(unsigned* bar, unsigned x, unsigned& nloc, unsigned& nx) {
    const unsigned G = gridDim.x * gridDim.y * gridDim.z;
    unsigned sum, cnt, mine, sp = 0u;
    for (;;) {
        sum = 0u; cnt = 0u; mine = 0u;
#pragma unroll
        for (unsigned j = 0; j < 16; ++j) { const unsigned c = xb_ld(&bar[XB_XCNT(j)]); sum += c; cnt += (c > 0u) ? 1u : 0u; mine = (j == x) ? c : mine; }
        if (sum == G) break;
        __builtin_amdgcn_s_sleep(1);
        if ((++sp & 255u) == 0u) { if (xb_ld(&bar[XB_TMO])) break; if (sp > XB_SPIN_CAP) { atomicAdd(&bar[XB_TMO], 1u); break; } }
    }
    nloc = mine > 0u ? mine : 1u; nx = cnt > 0u ? cnt : 1u;
}

__device__ __forceinline__ void xcd_barrier(const XcdBarrier& b) {
    asm volatile("s_waitcnt vmcnt(0)" ::: "memory");
    __syncthreads();
    if (threadIdx.x == 0) {
        unsigned* bar = b.bar;
        __builtin_amdgcn_s_waitcnt(0);
        unsigned nloc = b.st[0], nx = b.st[1];
        if (nloc == 0u) { xcd_barrier_complete(bar, b.x, nloc, nx); b.st[0] = nloc; b.st[1] = nx; }
        const unsigned old = xb_add(&bar[XB_XSUB(b.x)], 1u);
        const unsigned gen = old / nloc;
        if (old + 1u == (gen + 1u) * nloc) {
            __builtin_amdgcn_fence(__ATOMIC_RELEASE, "agent");
            asm volatile("s_waitcnt vmcnt(0)" ::: "memory");
            const unsigned og = xb_add(&bar[XB_TOP], 1u);
            const unsigned tg = og / nx;
            if (og + 1u == (tg + 1u) * nx) xb_add(&bar[XB_TOPGEN], 1u);
            else XB_SPIN(xb_ld(&bar[XB_TOPGEN]) == tg, bar);
            __builtin_amdgcn_fence(__ATOMIC_ACQUIRE, "agent");
            xb_add(&bar[XB_XGEN(b.x)], 1u);
            asm volatile("s_waitcnt vmcnt(0)" ::: "memory");
        } else {
            XB_SPIN(xb_ld(&bar[XB_XGEN(b.x)]) == gen, bar);
            __builtin_amdgcn_fence(__ATOMIC_ACQUIRE, "agent");
            asm volatile("s_waitcnt vmcnt(0)" ::: "memory");
        }
    }
    __syncthreads();
}

using pg8::bf16_t; using pg8::bf16x8; using pg8::f32x4; using pg8::u32x4; using pg8::Unit; using pg8::cvt_pk_bf16;
typedef unsigned u32x2 __attribute__((ext_vector_type(2)));
typedef float f32x2 __attribute__((ext_vector_type(2)));

#define GAS __attribute__((address_space(1)))
template <class T> __device__ __forceinline__ T gload(const T* p) { return *(const GAS T*)p; }
template <class T> __device__ __forceinline__ void gstore(T* p, const T& v) { *(GAS T*)p = v; }
constexpr int D = 1024, DFF = 2816, NGU = 5632, INDIM = 1280;
constexpr int LA = 4112, LB = 2064, NBA = 8, NBB = 32;
constexpr int TA = NBA * LA;
constexpr int T = TA + NBB * LB;
constexpr int TPAD = 99072;
constexpr int LPA = 4224, LPB = 2176;
constexpr int MPA = 4352, MPB = 2304;
constexpr int LDS_BYTES = 147456;

constexpr size_t al256(size_t x) { return (x + 255) & ~(size_t)255; }
constexpr size_t OFF_WGU = 0;
constexpr size_t OFF_WD = al256(OFF_WGU + (size_t)4 * NGU * D * 2);
constexpr size_t OFF_WIN = al256(OFF_WD + (size_t)4 * D * DFF * 2);
constexpr size_t OFF_WO = al256(OFF_WIN + (size_t)INDIM * D * 2);
constexpr size_t OFF_W2T = al256(OFF_WO + (size_t)D * D * 2);
constexpr size_t OFF_D1 = al256(OFF_W2T + (size_t)D * 2048 * 2);
constexpr size_t OFF_D2 = al256(OFF_D1 + (size_t)MPA * LPA * 2);
constexpr size_t OFF_HMETA = al256(OFF_D2 + (size_t)MPB * LPB * 2);
constexpr size_t OFF_RSS = al256(OFF_HMETA + (size_t)640 * D * 4);
constexpr size_t OFF_HB = al256(OFF_RSS + (size_t)TPAD * 16 * 4);
constexpr size_t OFF_BIG = al256(OFF_HB + (size_t)TPAD * D * 2);
constexpr size_t OFF_ACT = OFF_BIG;
constexpr size_t OFF_Z = OFF_BIG;
constexpr size_t OFF_AP = al256(OFF_Z + (size_t)TPAD * INDIM * 2);
constexpr size_t OFF_HNT = OFF_BIG;
constexpr size_t HNT_B = (size_t)NBA * D * LPA;
constexpr size_t OFF_X = al256(OFF_HNT + ((size_t)NBA * D * LPA + (size_t)NBB * D * LPB) * 2);
constexpr size_t OFF_SMALL = al256(OFF_X + (size_t)TPAD * 2048 * 2);
constexpr size_t OFF_BAR = al256(OFF_SMALL + 3072 * 4);
constexpr size_t OFF_PART = al256(OFF_BAR + (size_t)XCD_BAR_WORDS * 4);
constexpr size_t WS_NEED = al256(OFF_PART + (size_t)12 * 16 * 256 * 256 * 4);
static_assert(OFF_AP + (size_t)TPAD * D * 2 <= WS_NEED && OFF_ACT + (size_t)TPAD * DFF * 2 <= WS_NEED, "big region");

struct Params { const float* in[19]; float* out; unsigned char* ws; };

__device__ __forceinline__ void row_decode(int r, int& gb, int& l, int& L, int& rb) {
    if (r < TA) { gb = r / LA; l = r - gb * LA; L = LA; rb = gb * LA; }
    else { const int q = r - TA, b = q / LB; l = q - b * LB; gb = NBA + b; L = LB; rb = TA + b * LB; }
}
__device__ __forceinline__ float* hptr2(float* out, unsigned char* ws, int r) {
    int gb, l, L, rb; row_decode(r, gb, l, L, rb);
    if (l < 16) return (float*)(ws + OFF_HMETA) + (size_t)(gb * 16 + l) * D;
    return out + (size_t)(r - 16 * (gb + 1)) * D;
}
__device__ __forceinline__ float* hptr(const Params& p, int r) {
    int gb, l, L, rb; row_decode(r, gb, l, L, rb);
    if (l < 16) return (float*)(p.ws + OFF_HMETA) + (size_t)(gb * 16 + l) * D;
    return p.out + (size_t)(r - 16 * (gb + 1)) * D;
}
__device__ __forceinline__ int otid() { int t = threadIdx.x; asm volatile("" : "+v"(t)); return t; }
__device__ __forceinline__ bf16_t f2bf(float f) { unsigned u = __float_as_uint(f); u += 0x7FFFu + ((u >> 16) & 1u); return (bf16_t)(u >> 16); }
__device__ __forceinline__ float bflo(unsigned w) { return __uint_as_float(w << 16); }
__device__ __forceinline__ float bfhi(unsigned w) { return __uint_as_float(w & 0xFFFF0000u); }
__device__ __forceinline__ float wave_sum(float v) {
#pragma unroll
    for (int o = 1; o < 64; o <<= 1) v += __shfl_xor(v, o);
    return v;
}
__device__ __forceinline__ float rstd_of(float ss) { return __builtin_amdgcn_rsqf(ss * (1.0f / 1024.0f) + 1e-6f); }

struct EpiGateUp {
    static constexpr bool PERM = true, AFTER_DRAIN = false;
    bf16_t* act; const float* rss;
    __device__ __forceinline__ void operator()(const f32x4 (&acc)[2][2][4][2], const Unit& u, int wr, int wc, int fr, int fq) const {
        const int col = u.pn * 128 + wc * 32 + fq * 8;
        float rsc[2][4];
#pragma unroll
        for (int ai = 0; ai < 2; ++ai)
#pragma unroll
            for (int m = 0; m < 4; ++m) { const int r = u.pm * 256 + ai * 128 + wr * 64 + m * 16 + fr; const f32x4 q4 = gload((const f32x4*)(rss + (size_t)min(r, T - 1) * 4)); rsc[ai][m] = (q4[0] + q4[1]) + (q4[2] + q4[3]); }
#pragma unroll
        for (int ai = 0; ai < 2; ++ai)
#pragma unroll
            for (int m = 0; m < 4; ++m) rsc[ai][m] = rstd_of(rsc[ai][m]);
#pragma unroll
        for (int ai = 0; ai < 2; ++ai)
#pragma unroll
            for (int m = 0; m < 4; ++m) {
                const int r = u.pm * 256 + ai * 128 + wr * 64 + m * 16 + fr;
                const float rs = rsc[ai][m]; const f32x2 rs2 = {rs * rs, rs * rs}, nrl = {rs * -1.4426950408889634f, rs * -1.4426950408889634f}, one = {1.0f, 1.0f};
                unsigned w[4];
#pragma unroll
                for (int n = 0; n < 2; ++n)
#pragma unroll
                    for (int e = 0; e < 4; e += 2) {
                        const f32x2 g = {acc[ai][0][m][n][e], acc[ai][0][m][n][e + 1]}, uu = {acc[ai][1][m][n][e], acc[ai][1][m][n][e + 1]};
                        const f32x2 t = g * nrl; f32x2 ex; ex.x = __builtin_amdgcn_exp2f(t.x); ex.y = __builtin_amdgcn_exp2f(t.y);
                        const f32x2 dn = ex + one; f32x2 rc; rc.x = __builtin_amdgcn_rcpf(dn.x); rc.y = __builtin_amdgcn_rcpf(dn.y);
                        const f32x2 o2 = ((g * uu) * rs2) * rc;
                        w[n * 2 + (e >> 1)] = cvt_pk_bf16(o2.x, o2.y);
                    }
                u32x4 o; o.x = w[0]; o.y = w[1]; o.z = w[2]; o.w = w[3];
                if (r < T) gstore((u32x4*)(act + (size_t)r * DFF + col), o);
            }
    }
};
struct EpiScale {
    static constexpr bool PERM = true, AFTER_DRAIN = false;
    bf16_t* O; int ldc; const float* rss;
    __device__ __forceinline__ void operator()(const f32x4 (&acc)[2][2][4][2], const Unit& u, int wr, int wc, int fr, int fq) const {
        const int col = u.pn * 256 + wc * 32 + fq * 8;
        float rsv[2][4];
#pragma unroll
        for (int ai = 0; ai < 2; ++ai)
#pragma unroll
            for (int m = 0; m < 4; ++m) { const int r = u.pm * 256 + ai * 128 + wr * 64 + m * 16 + fr; { const f32x4 q4 = gload((const f32x4*)(rss + (size_t)min(r, T - 1) * 4)); rsv[ai][m] = (q4[0] + q4[1]) + (q4[2] + q4[3]); } }
#pragma unroll
        for (int ai = 0; ai < 2; ++ai)
#pragma unroll
            for (int m = 0; m < 4; ++m) {
                const int r = u.pm * 256 + ai * 128 + wr * 64 + m * 16 + fr;
                const float rs = rstd_of(rsv[ai][m]);
                if (r < T) {
#pragma unroll
                    for (int bj = 0; bj < 2; ++bj) {
                        const f32x4 v0 = acc[ai][bj][m][0] * rs, v1 = acc[ai][bj][m][1] * rs;
                        u32x4 o; o.x = cvt_pk_bf16(v0[0], v0[1]); o.y = cvt_pk_bf16(v0[2], v0[3]); o.z = cvt_pk_bf16(v1[0], v1[1]); o.w = cvt_pk_bf16(v1[2], v1[3]);
                        gstore((u32x4*)(O + (size_t)r * ldc + col + bj * 128), o);
                    }
                }
            }
    }
};
struct EpiNone {
    static constexpr bool PERM = true, AFTER_DRAIN = false;
    __device__ __forceinline__ void operator()(const f32x4 (&acc)[2][2][4][2], const Unit& u, int wr, int wc, int fr, int fq) const {
#pragma unroll
        for (int ai = 0; ai < 2; ++ai)
#pragma unroll
            for (int bj = 0; bj < 2; ++bj)
#pragma unroll
                for (int m = 0; m < 4; ++m)
#pragma unroll
                    for (int n = 0; n < 2; ++n) asm volatile("" :: "v"(acc[ai][bj][m][n]));
    }
};
template <bool LAST> struct EpiResid {
    static constexpr bool PERM = true, AFTER_DRAIN = false;
    float* out; unsigned char* ws; int half; float* rss4; LAS float* part;
    __device__ __forceinline__ void operator()(const f32x4 (&acc)[2][2][4][2], const Unit& u, int wr, int wc, int fr, int fq) const {
        const int col = u.pn * 256 + wc * 32 + fq * 8;
        bf16_t* hb = (bf16_t*)(ws + OFF_HB);
        u32x4 hv[2][4][2];
#pragma unroll
        for (int ai = 0; ai < 2; ++ai)
#pragma unroll
            for (int m = 0; m < 4; ++m) { const int r = u.pm * 256 + ai * 128 + wr * 64 + m * 16 + fr; const bf16_t* hp = hb + (size_t)min(r, T - 1) * D + col;
#pragma unroll
                for (int bj = 0; bj < 2; ++bj) hv[ai][m][bj] = gload((const u32x4*)(hp + bj * 128)); }
#pragma unroll
        for (int ai = 0; ai < 2; ++ai)
#pragma unroll
            for (int m = 0; m < 4; ++m) {
                const int r = u.pm * 256 + ai * 128 + wr * 64 + m * 16 + fr;
                f32x2 ss2 = {0.f, 0.f}; const float scale = half ? 0.5f : 1.0f; const f32x2 sc2 = {scale, scale};
#pragma unroll
                for (int bj = 0; bj < 2; ++bj) {
                    const u32x4 w = hv[ai][m][bj]; const f32x4 a0 = acc[ai][bj][m][0], a1 = acc[ai][bj][m][1];
                    f32x2 p0 = {bflo(w.x), bfhi(w.x)}, p1 = {bflo(w.y), bfhi(w.y)}, p2 = {bflo(w.z), bfhi(w.z)}, p3 = {bflo(w.w), bfhi(w.w)};
                    p0 += (f32x2){a0[0], a0[1]} * sc2; p1 += (f32x2){a0[2], a0[3]} * sc2; p2 += (f32x2){a1[0], a1[1]} * sc2; p3 += (f32x2){a1[2], a1[3]} * sc2;
                    ss2 += p0 * p0; ss2 += p1 * p1; ss2 += p2 * p2; ss2 += p3 * p3;
                    if (r < T) {
                        u32x4 o; o.x = cvt_pk_bf16(p0.x, p0.y); o.y = cvt_pk_bf16(p1.x, p1.y); o.z = cvt_pk_bf16(p2.x, p2.y); o.w = cvt_pk_bf16(p3.x, p3.y);
                        gstore((u32x4*)(hb + (size_t)r * D + col + bj * 128), o);
                    }
                }
                float ss = ss2.x + ss2.y;
                ss += __shfl_xor(ss, 16); ss += __shfl_xor(ss, 32);
                if (fq == 0) part[(ai * 128 + wr * 64 + m * 16 + fr) * 4 + wc] = ss;
            }
        asm volatile("s_waitcnt lgkmcnt(0)" ::: "memory"); __builtin_amdgcn_s_barrier(); asm volatile("" ::: "memory");
        const int lane = fq * 16 + fr;
        if (lane < 32) { const int rl = (lane >> 4) * 128 + wr * 64 + wc * 16 + (lane & 15), r = u.pm * 256 + rl;
            const f32x4 v = *(const LAS f32x4*)(part + rl * 4);
            if (r < T) gstore(rss4 + (size_t)r * 4 + u.pn, (v[0] + v[1]) + (v[2] + v[3])); }
    }
};
struct EpiDft {
    static constexpr bool PERM = true, AFTER_DRAIN = false;
    bf16_t* X; int L, rowbase;
    __device__ __forceinline__ void operator()(const f32x4 (&acc)[2][2][4][2], const Unit& u, int wr, int wc, int fr, int fq) const {
        const int b = u.pn >> 2, c0 = (u.pn & 3) * 256 + wc * 32 + fq * 8, H = L >> 1;
#pragma unroll
        for (int ai = 0; ai < 2; ++ai)
#pragma unroll
            for (int m = 0; m < 4; ++m) {
                const int kk = u.pm * 256 + ai * 128 + wr * 64 + m * 16 + fr;
                if (kk < L) {
                    const bool isc = kk <= H; const int k = isc ? kk : kk - H; const float sg = isc ? 1.f : -1.f;
                    bf16_t* x0 = X + (size_t)(rowbase + b * L + k) * 2048 + (isc ? 0 : 1024) + c0;
                    bf16_t* x1 = X + (size_t)(rowbase + b * L + (L - k)) * 2048 + (isc ? 0 : 1024) + c0;
                    const bool mir = (k >= 1) && (k < H);
#pragma unroll
                    for (int bj = 0; bj < 2; ++bj) {
                        const f32x4 v0 = acc[ai][bj][m][0] * sg, v1 = acc[ai][bj][m][1] * sg;
                        u32x4 o; o.x = cvt_pk_bf16(v0[0], v0[1]); o.y = cvt_pk_bf16(v0[2], v0[3]); o.z = cvt_pk_bf16(v1[0], v1[1]); o.w = cvt_pk_bf16(v1[2], v1[3]);
                        gstore((u32x4*)(x0 + bj * 128), o);
                        if (mir) { u32x4 q; if (isc) q = o; else { q.x = o.x ^ 0x80008000u; q.y = o.y ^ 0x80008000u; q.z = o.z ^ 0x80008000u; q.w = o.w ^ 0x80008000u; } gstore((u32x4*)(x1 + bj * 128), q); }
                        if (isc && !mir) { u32x4 zz; zz.x = 0; zz.y = 0; zz.z = 0; zz.w = 0; gstore((u32x4*)(x0 + 1024 + bj * 128), zz); }
                    }
                }
            }
    }
};

struct DftOrder : pg8::StaticOrder {
    int cc, GG, mode;
    __device__ void init2(int M, int N, int G_, int c_, int mode_) { init(M, N, 1, 0); cc = c_; GG = G_; mode = mode_; }
    __device__ bool next(int i, Unit& u) const { int L;
        if (mode == 0) { L = i * GG + cc; if (L >= nwg) return false; }
        else if (cc < 32) { if (i >= 3) return false; L = 1056 + cc * 3 + i; }
        else { const int d = cc - 32; if (i < 4) L = i * 224 + d; else if (i == 4 && d < 160) L = 896 + d; else return false; }
        return pg8::StaticOrder::next(L, u); }
};
constexpr int TAIL_L0 = 6 * 256, TAIL_UNITS = (TPAD / 256) * 4 - TAIL_L0;
struct CapOrder : pg8::StaticOrder {
    int cc, GG, cap;
    __device__ void init2(int M, int N, int G_, int c_, int cap_) { init(M, N, 1, 0); cc = c_; GG = G_; cap = cap_; }
    __device__ bool next(int i, Unit& u) const { const int L = i * GG + cc; if (L >= cap) return false; return pg8::StaticOrder::next(L, u); }
};
struct TailOrder : pg8::StaticOrder {
    int tu;
    __device__ void init2(int M, int N, int tu_) { init(M, N, 1, 0); tu = tu_; }
    __device__ bool next(int i, Unit& u) const { if (i != 0) return false; return pg8::StaticOrder::next(TAIL_L0 + tu, u); }
};
struct EpiPartial {
    static constexpr bool PERM = true, AFTER_DRAIN = false;
    float* P;
    __device__ __forceinline__ void operator()(const f32x4 (&acc)[2][2][4][2], const Unit& u, int wr, int wc, int fr, int fq) const {
#pragma unroll
        for (int ai = 0; ai < 2; ++ai)
#pragma unroll
            for (int m = 0; m < 4; ++m) { float* rowp = P + (size_t)(ai * 128 + wr * 64 + m * 16 + fr) * 256 + wc * 32 + fq * 8;
#pragma unroll
                for (int bj = 0; bj < 2; ++bj) { gstore((f32x4*)(rowp + bj * 128), acc[ai][bj][m][0]); gstore((f32x4*)(rowp + bj * 128 + 4), acc[ai][bj][m][1]); } }
    }
};
__device__ __forceinline__ void tail_fixup(unsigned char* ws, int nsl, int half) {
    const float scale = half ? 0.5f : 1.0f;
    const int tid = otid(), lane = tid & 63, gw = blockIdx.x * 8 + (tid >> 6), NGW = gridDim.x * 8;
    bf16_t* hb = (bf16_t*)(ws + OFF_HB); float* rss4 = (float*)(ws + OFF_RSS); const float* P0 = (const float*)(ws + OFF_PART);
    pg8::StaticOrder so; so.init(TPAD, D, 1, 0);
    for (int it = gw; it < TAIL_UNITS * 256; it += NGW) {
        const int tu = it >> 8, rl = it & 255; Unit u; so.next(TAIL_L0 + tu, u);
        const int r = u.pm * 256 + rl, col = u.pn * 256 + lane * 4;
        f32x4 a = {0.f, 0.f, 0.f, 0.f};
        f32x4 pv[11];
#pragma unroll
        for (int sl = 0; sl < 11; ++sl) pv[sl] = gload((const f32x4*)(P0 + ((size_t)(tu * 16 + min(sl, nsl - 1)) * 256 + rl) * 256 + lane * 4));
#pragma unroll
        for (int sl = 0; sl < 11; ++sl) { const float m = sl < nsl ? 1.0f : 0.0f; a += pv[sl] * m; }
        float ss = 0.f;
        if (r < T) { const u32x2 w = gload((const u32x2*)(hb + (size_t)r * D + col));
            f32x4 h; h[0] = bflo(w.x); h[1] = bfhi(w.x); h[2] = bflo(w.y); h[3] = bfhi(w.y); h += a * scale;
            ss = (h[0] * h[0] + h[1] * h[1]) + (h[2] * h[2] + h[3] * h[3]);
            u32x2 o; o.x = cvt_pk_bf16(h[0], h[1]); o.y = cvt_pk_bf16(h[2], h[3]); gstore((u32x2*)(hb + (size_t)r * D + col), o); }
        ss = wave_sum(ss);
        if (lane == 0 && r < T) rss4[(size_t)r * 4 + u.pn] = ss;
    }
}
struct LocalOrder : pg8::StaticOrder { __device__ bool next(int i, Unit& u) const { const bool ok = pg8::StaticOrder::next(i, u); u.pm &= 7; return ok; } };
template <class Epi>
__device__ __forceinline__ void run_gemm(LAS unsigned char* lds, const bf16_t* A, const bf16_t* Bt, int M, int N, int K, const Epi& E, int c) {
    pg8::Gemm g; g.A = A; g.Bt = Bt; g.M = M; g.N = N; g.K = K; g.ld = K;
    pg8::StaticOrder S; S.init(M, N, (int)gridDim.x, c);
    pg8::gemm_phase<Epi, pg8::StaticOrder, false>(lds, g, S, E, nullptr);
}

__device__ __forceinline__ void transpose_item(const float* W, int N, const float* gain, bf16_t* WT, int ldd, int k0, int n0, int drow0, LAS float* scr, int lane, float osc = 1.0f) {
#pragma unroll
    for (int i = 0; i < 32; ++i) { const int kk = 2 * i + (lane >> 5); f32x2 v = *(const f32x2*)(W + (size_t)(k0 + kk) * N + n0 + 2 * (lane & 31)); if (gain) v *= gain[k0 + kk] * osc; *(LAS f32x2*)(scr + kk * 66 + 2 * (lane & 31)) = v; }
    asm volatile("s_waitcnt lgkmcnt(0)" ::: "memory");
    const int c = lane & 7;
#pragma unroll
    for (int jj = 0; jj < 8; ++jj) { const int n = (lane >> 3) + 8 * jj; const LAS float* sp = scr + (8 * c) * 66 + n;
        u32x4 o; o.x = cvt_pk_bf16(sp[0 * 66], sp[1 * 66]); o.y = cvt_pk_bf16(sp[2 * 66], sp[3 * 66]); o.z = cvt_pk_bf16(sp[4 * 66], sp[5 * 66]); o.w = cvt_pk_bf16(sp[6 * 66], sp[7 * 66]);
        *(u32x4*)(WT + (size_t)(drow0 + n) * ldd + k0 + 8 * c) = o; }
    asm volatile("s_waitcnt lgkmcnt(0)" ::: "memory");
}
__device__ __forceinline__ void dft_item(bf16_t* Dm, int L, int LP, int witem, int lane) {
    const int cpr = LP >> 3, H = L >> 1; const int tix = witem * 64 + lane; const int kk = tix / cpr, c8 = tix - kk * cpr;
    const bool isc = kk <= H; const int k = isc ? kk : kk - H;
    const float sc = rsqrtf((float)L), invL = 1.0f / (float)L;
    int mm = (k * (c8 * 8)) % L;
    unsigned w[4];
#pragma unroll
    for (int e = 0; e < 8; e += 2) {
        float v[2];
#pragma unroll
        for (int q = 0; q < 2; ++q) { const int n = c8 * 8 + e + q; const float a = (float)mm * invL;
            const float x = (isc ? __builtin_amdgcn_cosf(a) : __builtin_amdgcn_sinf(a)) * sc;
            v[q] = (kk < L && n < L) ? x : 0.f;
            mm += k; mm = mm >= L ? mm - L : mm; }
        w[e >> 1] = cvt_pk_bf16(v[0], v[1]);
    }
    u32x4 o; o.x = w[0]; o.y = w[1]; o.z = w[2]; o.w = w[3];
    *(u32x4*)(Dm + (size_t)kk * LP + c8 * 8) = o;
}
__device__ __forceinline__ void prep_phase(const Params& p, LAS unsigned char* lds) {
    const int tid = otid(), lane = tid & 63, wave = __builtin_amdgcn_readfirstlane(tid >> 6);
    const int gw = blockIdx.x * 8 + wave, NGW = gridDim.x * 8;
    LAS float* scr = (LAS float*)(lds + wave * 16896);
    LAS float* tab = (LAS float*)(lds + 8 * 16896);
    if (tid < 256) { tab[tid] = cospif((float)tid * (1.0f / 128.0f)); tab[256 + tid] = sinpif((float)tid * (1.0f / 128.0f)); }
    __syncthreads();
    if (blockIdx.x == 0) { float* sm = (float*)(p.ws + OFF_SMALL); if (tid < 8) sm[tid] = p.in[9][tid]; for (int i = tid; i < 1024; i += 512) { sm[1024 + i] = p.in[7][D + i]; sm[2048 + i] = p.in[18][i]; } }
    bf16_t* Wgu = (bf16_t*)(p.ws + OFF_WGU); bf16_t* Wd = (bf16_t*)(p.ws + OFF_WD); bf16_t* Win = (bf16_t*)(p.ws + OFF_WIN);
    bf16_t* Wo = (bf16_t*)(p.ws + OFF_WO); bf16_t* W2t = (bf16_t*)(p.ws + OFF_W2T);
    constexpr int I_G = 16 * 44, I_D = 44 * 16;
    constexpr int N_TR_FFN = 4 * (2 * I_G + I_D);
    constexpr int I_IN = 16 * 20, I_WO = 8 * 16;
    constexpr int R0 = N_TR_FFN, R1 = R0 + I_IN, R2 = R1 + I_WO;
    constexpr int N_W3 = 256 * 8, N_W2 = 128 * 32;
    constexpr int R3 = R2 + N_W3, R4 = R3 + N_W2;
    constexpr int N_D1 = MPA * (LPA / 8) / 64, N_D2 = MPB * (LPB / 8) / 64;
    constexpr int R5 = R4 + N_D1, R6 = R5 + N_D2, R7 = R6 + T / 2;
    for (int it = gw; it < R7; it += NGW) {
        if (it < R0) {
            const int f = it / (2 * I_G + I_D); int r = it - f * (2 * I_G + I_D); const int layer = f >> 1, which = f & 1;
            if (r < 2 * I_G) { const int up = r >= I_G; if (up) r -= I_G;
                const float* src = p.in[which ? (up ? 16 : 15) : (up ? 5 : 4)] + (size_t)layer * D * DFF;
                const float* gain = p.in[which ? 14 : 3] + layer * D;
                const int kb = r / 44, nb = r - kb * 44, n0 = nb * 64;
                const int drow0 = (n0 >> 7) * 256 + (up ? 128 : 0) + (n0 & 127);
                transpose_item(src, DFF, gain, Wgu + (size_t)f * NGU * D, D, kb * 64, n0, drow0, scr, lane);
            } else { r -= 2 * I_G;
                const float* src = p.in[which ? 17 : 6] + (size_t)layer * DFF * D;
                const int kb = r / 16, nb = r - kb * 16;
                transpose_item(src, D, nullptr, Wd + (size_t)f * D * DFF, DFF, kb * 64, nb * 64, nb * 64, scr, lane);
            }
        } else if (it < R1) { const int r = it - R0, kb = r / 20, nb = r - kb * 20;
            transpose_item(p.in[8], INDIM, p.in[7], Win, D, kb * 64, nb * 64, nb * 64, scr, lane, nb < 8 ? 0.125f : 1.0f);
        } else if (it < R2) { const int r = it - R1, kb = r / 16, nb = r - kb * 16;
            transpose_item(p.in[12], D, nullptr, Wo, D, kb * 64, nb * 64, nb * 64, scr, lane);
        } else if (it < R3) {
            const int r = it - R2, j = (r & 255) * 4, kb = r >> 8, kk = kb * 64 + lane, g = kk >> 7, c = kk & 127;
            const float* pw = p.in[10] + (size_t)(g * 128 + c) * 128; const float* ps = p.in[11] + g * 128; const float* wo = p.in[12] + (size_t)(512 + g * 128) * D + j;
            f32x4 a = {0.f, 0.f, 0.f, 0.f};
#pragma unroll 16
            for (int d = 0; d < 128; ++d) { const f32x4 w = *(const f32x4*)(wo + (size_t)d * D); a += w * (pw[d] * ps[d]); }
#pragma unroll
            for (int q = 0; q < 4; ++q) Wo[(size_t)(j + q) * D + 512 + kk] = f2bf(a[q]);
        } else if (it < R4) {
            const int r = it - R3, j = (r & 127) * 8, kb = r >> 7, kk = kb * 64 + lane, part = kk >> 10, k2 = kk & 1023, g = k2 >> 8, c = k2 & 255;
            const float* wf = p.in[13] + (size_t)(g * 256) * D + j; const LAS float* tb = tab + part * 256;
            f32x4 a0 = {0.f, 0.f, 0.f, 0.f}, a1 = {0.f, 0.f, 0.f, 0.f};
#pragma unroll 8
            for (int d = 0; d < 256; ++d) { const f32x4 w0 = *(const f32x4*)(wf + (size_t)d * D), w1 = *(const f32x4*)(wf + (size_t)d * D + 4); const float t = tb[(c * d) & 255]; a0 += w0 * t; a1 += w1 * t; }
#pragma unroll
            for (int q = 0; q < 4; ++q) { W2t[(size_t)(j + q) * 2048 + kk] = f2bf(a0[q] * 0.0625f); W2t[(size_t)(j + 4 + q) * 2048 + kk] = f2bf(a1[q] * 0.0625f); }
        } else if (it < R5) { dft_item((bf16_t*)(p.ws + OFF_D1), LA, LPA, it - R4, lane);
        } else if (it < R6) { dft_item((bf16_t*)(p.ws + OFF_D2), LB, LPB, it - R5, lane);
        } else {
            const int r0 = (it - R6) * 2; const float* src[2]; f32x4 v[2][4];
#pragma unroll
            for (int q = 0; q < 2; ++q) { int gb, l, L, rb; row_decode(r0 + q, gb, l, L, rb);
                src[q] = (l < 16) ? p.in[2] + (size_t)l * D : (gb < NBA ? p.in[0] + ((size_t)gb * 4096 + (l - 16)) * D : p.in[1] + ((size_t)(gb - NBA) * 2048 + (l - 16)) * D); }
#pragma unroll
            for (int q = 0; q < 2; ++q)
#pragma unroll
                for (int i = 0; i < 4; ++i) v[q][i] = *(const f32x4*)(src[q] + (lane + 64 * i) * 4);
            float* rss0 = (float*)(p.ws + OFF_RSS);
#pragma unroll
            for (int q = 0; q < 2; ++q) { bf16_t* hb = (bf16_t*)(p.ws + OFF_HB) + (size_t)(r0 + q) * D; float ss = 0.f;
#pragma unroll
                for (int i = 0; i < 4; ++i) { ss += (v[q][i][0] * v[q][i][0] + v[q][i][1] * v[q][i][1]) + (v[q][i][2] * v[q][i][2] + v[q][i][3] * v[q][i][3]);
                    u32x2 o; o.x = cvt_pk_bf16(v[q][i][0], v[q][i][1]); o.y = cvt_pk_bf16(v[q][i][2], v[q][i][3]); *(u32x2*)(hb + (lane + 64 * i) * 4) = o; }
                ss = wave_sum(ss);
                if (lane == 0) { f32x4 q4 = {ss, 0.f, 0.f, 0.f}; *(f32x4*)(rss0 + (size_t)(r0 + q) * 4) = q4; } }
        }
    }
}

template <int HW> __device__ __forceinline__ void pool_item(const bf16_t* z, bf16_t* ap, int r, int ch) {
    int gb, l, L, rb; row_decode(r, gb, l, L, rb);
    const bf16_t* base = z + (size_t)r * INDIM + 768 + ch * 8;
    u32x4 v[2 * HW + 3];
#pragma unroll
    for (int o = 0; o < 2 * HW + 3; ++o) { const int s = l - HW + o; u32x4 t; t.x = 0; t.y = 0; t.z = 0; t.w = 0; if (s >= 0 && s < L) t = gload((const u32x4*)(base + (long)(o - HW) * INDIM)); v[o] = t; }
    float s0 = 0.f, s1 = 0.f, s2 = 0.f, s3 = 0.f, s4 = 0.f, s5 = 0.f, s6 = 0.f, s7 = 0.f;
#pragma unroll
    for (int o = 0; o < 2 * HW; ++o) { s0 += bflo(v[o].x); s1 += bfhi(v[o].x); s2 += bflo(v[o].y); s3 += bfhi(v[o].y); s4 += bflo(v[o].z); s5 += bfhi(v[o].z); s6 += bflo(v[o].w); s7 += bfhi(v[o].w); }
#pragma unroll
    for (int q = 0; q < 4; ++q) {
        const u32x4 me = v[HW + q]; const int lq = l + q;
        const float ic = 1.0f / (float)(min(lq + HW, L) - max(lq - HW, 0));
        u32x4 o; o.x = cvt_pk_bf16(s0 * ic - bflo(me.x), s1 * ic - bfhi(me.x)); o.y = cvt_pk_bf16(s2 * ic - bflo(me.y), s3 * ic - bfhi(me.y));
        o.z = cvt_pk_bf16(s4 * ic - bflo(me.z), s5 * ic - bfhi(me.z)); o.w = cvt_pk_bf16(s6 * ic - bflo(me.w), s7 * ic - bfhi(me.w));
        gstore((u32x4*)(ap + (size_t)(r + q) * D + 512 + ch * 8), o);
        if (q < 3) { const u32x4 out = v[q], in = v[q + 2 * HW];
            s0 += bflo(in.x) - bflo(out.x); s1 += bfhi(in.x) - bfhi(out.x); s2 += bflo(in.y) - bflo(out.y); s3 += bfhi(in.y) - bfhi(out.y);
            s4 += bflo(in.z) - bflo(out.z); s5 += bfhi(in.z) - bfhi(out.z); s6 += bflo(in.w) - bflo(out.w); s7 += bfhi(in.w) - bfhi(out.w); }
    }
}
struct PW { unsigned char* ws; float* out; };
__device__ __forceinline__ void attn_phase(const PW& p, LAS unsigned char* lds) {
    const bf16_t* z = (const bf16_t*)(p.ws + OFF_Z); bf16_t* ap = (bf16_t*)(p.ws + OFF_AP); const float* sink = (const float*)(p.ws + OFF_SMALL);
    const int tid = otid(), lane = tid & 63, wave = __builtin_amdgcn_readfirstlane(tid >> 6), fr = lane & 15, fq = lane >> 4;
    LAS unsigned char* Ks = lds;
    LAS unsigned char* Vt = lds + 55296;
    constexpr int NU = (NBA * 33 + NBB * 17) * 2;
    for (int unit = blockIdx.x; unit < NU; unit += gridDim.x) {
        const int kvh = unit & 1; int tt = unit >> 1; int sb, ti, L, rb;
        if (tt < NBA * 33) { sb = tt / 33; ti = tt - sb * 33; L = LA; rb = sb * LA; } else { tt -= NBA * 33; sb = tt / 17; ti = tt - sb * 17; L = LB; rb = TA + sb * LB; }
        const int l0 = ti * 128;
        __syncthreads();
        {
            typedef __attribute__((address_space(1))) const u32x4 gu32x4;
            u32x4 kreg[6], vreg[7];
#pragma unroll
            for (int i = 0; i < 6; ++i) { const int idx = tid + 512 * i, j = idx >> 3, ch = idx & 7, s = l0 - 128 + j; const bool ok = (s >= 0) && (s < L);
                kreg[i] = *(gu32x4*)(z + (size_t)(rb + (ok ? s : 0)) * INDIM + 512 + kvh * 64 + ch * 8); }
#pragma unroll
            for (int i = 0; i < 7; ++i) { const int idx = tid + 512 * i, ch = min(idx / 400, 7), j = idx - (idx / 400) * 400, s = l0 - 128 + j; const bool ok = (idx < 3200) && (j < 384) && (s >= 0) && (s < L);
                vreg[i] = *(gu32x4*)(z + (size_t)(rb + (ok ? s : 0)) * INDIM + 640 + kvh * 64 + ch * 8); }
            __builtin_amdgcn_sched_barrier(0);
#pragma unroll
            for (int i = 0; i < 6; ++i) { const int idx = tid + 512 * i, j = idx >> 3, s = l0 - 128 + j; const bool ok = (s >= 0) && (s < L);
                kreg[i].x = ok ? kreg[i].x : 0u; kreg[i].y = ok ? kreg[i].y : 0u; kreg[i].z = ok ? kreg[i].z : 0u; kreg[i].w = ok ? kreg[i].w : 0u; }
#pragma unroll
            for (int i = 0; i < 7; ++i) { const int idx = tid + 512 * i, j = idx - (idx / 400) * 400, s = l0 - 128 + j; const bool ok = (idx < 3200) && (j < 384) && (s >= 0) && (s < L);
                vreg[i].x = ok ? vreg[i].x : 0u; vreg[i].y = ok ? vreg[i].y : 0u; vreg[i].z = ok ? vreg[i].z : 0u; vreg[i].w = ok ? vreg[i].w : 0u; }
#pragma unroll
            for (int i = 0; i < 6; ++i) { const int idx = tid + 512 * i, j = idx >> 3, ch = idx & 7; *(LAS u32x4*)(Ks + j * 144 + ch * 16) = kreg[i]; }
#pragma unroll
            for (int i = 0; i < 7; ++i) { const int idx = tid + 512 * i; if (idx < 3200) { const int ch = idx / 400, j = idx - ch * 400; const u32x4 v = vreg[i];
                LAS bf16_t* dst = (LAS bf16_t*)Vt + (ch * 8) * 408 + j;
                dst[0 * 408] = (bf16_t)(v.x & 0xFFFFu); dst[1 * 408] = (bf16_t)(v.x >> 16); dst[2 * 408] = (bf16_t)(v.y & 0xFFFFu); dst[3 * 408] = (bf16_t)(v.y >> 16);
                dst[4 * 408] = (bf16_t)(v.z & 0xFFFFu); dst[5 * 408] = (bf16_t)(v.z >> 16); dst[6 * 408] = (bf16_t)(v.w & 0xFFFFu); dst[7 * 408] = (bf16_t)(v.w >> 16); } }
        }
        __syncthreads();
        const int lq0 = l0 + 16 * wave + fr;
        if (l0 + 16 * wave < L) {
#pragma unroll 1
            for (int g = 0; g < 4; ++g) {
                int lq = lq0; asm volatile("" : "+v"(lq)); const bool qok = lq < L;
                const int h = kvh * 4 + g; const float slope = exp2f(-(float)(h + 1)); const float sk = gload(sink + h);
                bf16x8 qf[2];
#pragma unroll
                for (int kk = 0; kk < 2; ++kk) { u32x4 q; q.x = 0; q.y = 0; q.z = 0; q.w = 0; if (qok) q = gload((const u32x4*)(z + (size_t)(rb + lq) * INDIM + h * 64 + kk * 32 + fq * 8)); qf[kk] = __builtin_bit_cast(bf16x8, q); }
                f32x4 sc[17];
                {
                    const LAS unsigned char* kb = Ks + (16 * wave + fr) * 144 + fq * 16;
                    bf16x8 kc0 = *(const LAS bf16x8*)(kb), kc1 = *(const LAS bf16x8*)(kb + 64);
#pragma unroll
                    for (int t = 0; t < 17; ++t) { bf16x8 kn0 = kc0, kn1 = kc1;
                        if (t < 16) { kn0 = *(const LAS bf16x8*)(kb + (t + 1) * 2304); kn1 = *(const LAS bf16x8*)(kb + (t + 1) * 2304 + 64); }
                        f32x4 a = {0.f, 0.f, 0.f, 0.f};
                        a = __builtin_amdgcn_mfma_f32_16x16x32_bf16(kc0, qf[0], a, 0, 0, 0); a = __builtin_amdgcn_mfma_f32_16x16x32_bf16(kc1, qf[1], a, 0, 0, 0);
                        sc[t] = a; kc0 = kn0; kc1 = kn1; __builtin_amdgcn_sched_barrier(0); }
                }
                float mx = -1e30f;
                int db = 128 + fr - 4 * fq, lob = 128 - l0 - 16 * wave - 4 * fq; asm volatile("" : "+v"(db), "+v"(lob));
#pragma unroll
                for (int t = 0; t < 17; ++t)
#pragma unroll
                    for (int e = 0; e < 4; ++e) { const int off = 16 * t + e; const int dist = abs(db - off);
                        bool valid = (unsigned)(off - lob) < (unsigned)L;
                        if (t == 0 || t == 16) valid = valid && (dist <= 128);
                        const float v = valid ? fmaf(-slope, (float)dist, sc[t][e]) : -1e30f; sc[t][e] = v; mx = fmaxf(mx, v); }
                mx = fmaxf(mx, __shfl_xor(mx, 16)); mx = fmaxf(mx, __shfl_xor(mx, 32)); mx = fmaxf(mx, sk);
                float sum = 0.f;
#pragma unroll
                for (int t = 0; t < 17; ++t)
#pragma unroll
                    for (int e = 0; e < 4; ++e) { const float pv = __expf(sc[t][e] - mx); sc[t][e] = pv; sum += pv; }
                sum += __shfl_xor(sum, 16); sum += __shfl_xor(sum, 32); sum += __expf(sk - mx);
                const float inv = 1.0f / sum;
                f32x4 o[4];
#pragma unroll
                for (int dt = 0; dt < 4; ++dt) o[dt] = (f32x4){0.f, 0.f, 0.f, 0.f};
                {
                    const LAS unsigned char* vb = Vt + fr * 816 + (16 * wave + 4 * fq) * 2;
                    u32x2 vlo[4], vhi[4];
#pragma unroll
                    for (int dt = 0; dt < 4; ++dt) { vlo[dt] = *(const LAS u32x2*)(vb + dt * 13056); vhi[dt] = *(const LAS u32x2*)(vb + dt * 13056 + 32); }
#pragma unroll
                    for (int u = 0; u < 9; ++u) {
                        u32x2 nlo[4], nhi[4];
#pragma unroll
                        for (int dt = 0; dt < 4; ++dt) { nlo[dt] = vlo[dt]; nhi[dt] = vhi[dt]; }
                        if (u < 8) {
#pragma unroll
                            for (int dt = 0; dt < 4; ++dt) { nlo[dt] = *(const LAS u32x2*)(vb + dt * 13056 + (u + 1) * 64); nhi[dt] = *(const LAS u32x2*)(vb + dt * 13056 + (u + 1) * 64 + 32); } }
                        u32x4 pw; pw.x = cvt_pk_bf16(sc[2 * u][0], sc[2 * u][1]); pw.y = cvt_pk_bf16(sc[2 * u][2], sc[2 * u][3]);
                        if (2 * u + 1 < 17) { pw.z = cvt_pk_bf16(sc[(2 * u + 1) % 17][0], sc[(2 * u + 1) % 17][1]); pw.w = cvt_pk_bf16(sc[(2 * u + 1) % 17][2], sc[(2 * u + 1) % 17][3]); } else { pw.z = 0; pw.w = 0; }
                        const bf16x8 pf = __builtin_bit_cast(bf16x8, pw);
#pragma unroll
                        for (int dt = 0; dt < 4; ++dt) { u32x4 vv; vv.x = vlo[dt].x; vv.y = vlo[dt].y; vv.z = vhi[dt].x; vv.w = vhi[dt].y;
                            o[dt] = __builtin_amdgcn_mfma_f32_16x16x32_bf16(__builtin_bit_cast(bf16x8, vv), pf, o[dt], 0, 0, 0); }
#pragma unroll
                        for (int dt = 0; dt < 4; ++dt) { vlo[dt] = nlo[dt]; vhi[dt] = nhi[dt]; }
                        __builtin_amdgcn_sched_barrier(0);
                    }
                }
                if (qok) {
#pragma unroll
                    for (int dt = 0; dt < 4; ++dt) { u32x2 w; w.x = cvt_pk_bf16(o[dt][0] * inv, o[dt][1] * inv); w.y = cvt_pk_bf16(o[dt][2] * inv, o[dt][3] * inv);
                        gstore((u32x2*)(ap + (size_t)(rb + lq) * D + h * 64 + 16 * dt + 4 * fq), w); }
                }
            }
        }
    }
    constexpr int PER_G = (T / 4) * 16;
    for (int it = blockIdx.x * 512 + tid; it < 4 * PER_G; it += gridDim.x * 512) {
        const int g = it / PER_G, rem = it - g * PER_G, r = (rem >> 4) * 4, ch = g * 16 + (rem & 15);
        if (g == 0) pool_item<1>(z, ap, r, ch); else if (g == 1) pool_item<2>(z, ap, r, ch); else if (g == 2) pool_item<4>(z, ap, r, ch); else pool_item<8>(z, ap, r, ch);
    }
}

__device__ __forceinline__ void normT_phase(const PW& p, LAS unsigned char* lds) {
    const int tid = otid(), lane = tid & 63, wave = __builtin_amdgcn_readfirstlane(tid >> 6);
    const float* gain = (const float*)(p.ws + OFF_SMALL) + 1024; bf16_t* HNT = (bf16_t*)(p.ws + OFF_HNT);
    LAS bf16_t* Tt = (LAS bf16_t*)lds;
    constexpr int NUA = NBA * (LPA / 64), NU = NUA + NBB * (LPB / 64);
    for (int unit = blockIdx.x; unit < NU; unit += gridDim.x) {
        int sb, ti, L, LP, rb; bf16_t* dst;
        if (unit < NUA) { sb = unit / (LPA / 64); ti = unit - sb * (LPA / 64); L = LA; LP = LPA; rb = sb * LA; dst = HNT + (size_t)sb * D * LPA; }
        else { const int uu = unit - NUA; sb = uu / (LPB / 64); ti = uu - sb * (LPB / 64); L = LB; LP = LPB; rb = TA + sb * LB; dst = HNT + HNT_B + (size_t)sb * D * LPB; }
        const int l0 = ti * 64;
        __syncthreads();
        {
            unsigned raw[8][8]; float rs[8];
#pragma unroll
            for (int rr = 0; rr < 8; ++rr) { const int l = l0 + wave * 8 + rr; const bool ok = l < L;
                const unsigned* hp = (const unsigned*)((const bf16_t*)(p.ws + OFF_HB) + (size_t)(rb + min(l, L - 1)) * D);
#pragma unroll
                for (int i = 0; i < 8; ++i) { unsigned t = gload(hp + lane + 64 * i); raw[rr][i] = ok ? t : 0u; } }
#pragma unroll
            for (int rr = 0; rr < 8; ++rr) { float ss = 0.f;
#pragma unroll
                for (int i = 0; i < 8; ++i) { const float a = bflo(raw[rr][i]), b = bfhi(raw[rr][i]); ss += a * a + b * b; }
                ss = wave_sum(ss); rs[rr] = __builtin_amdgcn_rsqf(ss * (1.0f / 1024.0f) + 1e-6f); }
            LAS unsigned* TtW = (LAS unsigned*)lds;
#pragma unroll
            for (int i = 0; i < 8; ++i) { const float g0 = gain[2 * lane + 128 * i], g1 = gain[2 * lane + 128 * i + 1]; const int c0 = 2 * lane + 128 * i;
#pragma unroll
                for (int q = 0; q < 4; ++q) {
                    TtW[c0 * 33 + wave * 4 + q] = cvt_pk_bf16(bflo(raw[2 * q][i]) * rs[2 * q] * g0, bflo(raw[2 * q + 1][i]) * rs[2 * q + 1] * g0);
                    TtW[(c0 + 1) * 33 + wave * 4 + q] = cvt_pk_bf16(bfhi(raw[2 * q][i]) * rs[2 * q] * g1, bfhi(raw[2 * q + 1][i]) * rs[2 * q + 1] * g1); } }
        }
        __syncthreads();
#pragma unroll 8
        for (int i = 0; i < 64; ++i) { const int idx = tid + 512 * i; const int c = idx >> 5, pr = idx & 31;
            const unsigned v = *(const LAS unsigned*)(Tt + c * 66 + 2 * pr); gstore((unsigned*)(dst + (size_t)c * LP + l0 + 2 * pr), v); }
    }
}

__device__ __forceinline__ void final_phase(const PW& p) {
    const int tid = otid(); const int lane = tid & 63, gw = blockIdx.x * 8 + (tid >> 6), NGW = gridDim.x * 8; const float* gf = (const float*)(p.ws + OFF_SMALL) + 2048;
    const bf16_t* hb = (const bf16_t*)(p.ws + OFF_HB); const float* rss = (const float*)(p.ws + OFF_RSS);
    f32x4 gv[4];
#pragma unroll
    for (int i = 0; i < 4; ++i) gv[i] = *(const f32x4*)(gf + lane * 8 + 512 * (i >> 1) + 4 * (i & 1));
    for (int row = gw; row < 98304; row += NGW) {
        int r; if (row < NBA * 4096) { const int gb = row >> 12; r = row + 16 * (gb + 1); } else { const int o2 = row - NBA * 4096, b = o2 >> 11; r = TA + b * LB + 16 + (o2 - (b << 11)); }
        const f32x4 q4 = gload((const f32x4*)(rss + (size_t)r * 4)); const float rs = rstd_of((q4[0] + q4[1]) + (q4[2] + q4[3]));
        const bf16_t* hp = hb + (size_t)r * D; float* op = p.out + (size_t)row * D;
        const u32x4 w0 = gload((const u32x4*)(hp + lane * 8)), w1 = gload((const u32x4*)(hp + 512 + lane * 8));
        f32x4 a, b2, c2, d2;
        a[0] = bflo(w0.x); a[1] = bfhi(w0.x); a[2] = bflo(w0.y); a[3] = bfhi(w0.y); b2[0] = bflo(w0.z); b2[1] = bfhi(w0.z); b2[2] = bflo(w0.w); b2[3] = bfhi(w0.w);
        c2[0] = bflo(w1.x); c2[1] = bfhi(w1.x); c2[2] = bflo(w1.y); c2[3] = bfhi(w1.y); d2[0] = bflo(w1.z); d2[1] = bfhi(w1.z); d2[2] = bflo(w1.w); d2[3] = bfhi(w1.w);
        gstore((f32x4*)(op + lane * 8), a * rs * gv[0]); gstore((f32x4*)(op + lane * 8 + 4), b2 * rs * gv[1]);
        gstore((f32x4*)(op + 512 + lane * 8), c2 * rs * gv[2]); gstore((f32x4*)(op + 512 + lane * 8 + 4), d2 * rs * gv[3]);
    }
}

enum { K_PREP = 0, K_GGU, K_DOWN, K_GZ, K_ATTN, K_APO, K_NORMT, K_DFT, K_FO, K_FINAL };
#ifndef REP_PREP
#define REP_PREP 1
#endif
__global__ void __launch_bounds__(512, 2) mega_fwd(Params p0) {
    extern __shared__ __attribute__((aligned(16))) unsigned char shm[];
    LAS unsigned char* lds = (LAS unsigned char*)shm;
    cg::grid_group grid = cg::this_grid();
    volatile LAS unsigned* xst = (volatile LAS unsigned*)(lds + (LDS_BYTES - 16));
    if (threadIdx.x == 0) { xst[0] = 0u; xst[1] = 0u; }
    __syncthreads();
    XcdBarrier xb = xcd_barrier_post((unsigned*)(p0.ws + OFF_BAR), xst);
    const int nrep = REP_PREP + (p0.out == nullptr ? 1 : 0);
#pragma unroll 1
    for (int rep = 0; rep < nrep; ++rep) { prep_phase(p0, lds); grid.sync(); }
#ifdef PROBE_SLEEP_TICKS
    { const unsigned long long t0 = __builtin_amdgcn_s_memrealtime(); while (__builtin_amdgcn_s_memrealtime() - t0 < (unsigned long long)PROBE_SLEEP_TICKS) __builtin_amdgcn_s_sleep(32); }
#endif
    PW p; p.ws = p0.ws; p.out = p0.out;
    { unsigned long long w = (unsigned long long)p.ws, o = (unsigned long long)p.out; asm volatile("" : "+s"(w), "+s"(o)); p.ws = (unsigned char*)w; p.out = (float*)o; }
#pragma unroll 1
    for (int ph = 1; ph < 16; ++ph) {
        int kind, f = 0, rbuf = 0;
        switch (ph) {
            case 0: kind = K_PREP; break;
            case 1: kind = K_GGU; f = 0; rbuf = 0; break;
            case 2: kind = K_DOWN; f = 0; rbuf = 1; break;
            case 3: kind = K_GZ; rbuf = 1; break;
            case 4: kind = K_ATTN; break;
            case 5: kind = K_APO; rbuf = 0; break;
            case 6: kind = K_GGU; f = 1; rbuf = 0; break;
            case 7: kind = K_DOWN; f = 1; rbuf = 1; break;
            case 8: kind = K_GGU; f = 2; rbuf = 1; break;
            case 9: kind = K_DOWN; f = 2; rbuf = 0; break;
            case 10: kind = K_NORMT; break;
            case 11: kind = K_DFT; break;
            case 12: kind = K_FO; rbuf = 1; break;
            case 13: kind = K_GGU; f = 3; rbuf = 1; break;
            case 14: kind = K_DOWN; f = 3; rbuf = 0; break;
            default: kind = K_FINAL; break;
        }
        const int c = (int)blockIdx.x;
        if (kind == K_PREP) {
        } else if (kind == K_GGU) {
#ifndef NO_GGU
            EpiGateUp E; E.act = (bf16_t*)(p.ws + OFF_ACT); E.rss = (const float*)(p.ws + OFF_RSS);
#ifndef REP_GGU
#define REP_GGU 1
#endif
#pragma unroll 1
            for (int rep = 0; rep < REP_GGU; ++rep) {
            run_gemm(lds, (const bf16_t*)(p.ws + OFF_HB), (const bf16_t*)(p.ws + OFF_WGU) + (size_t)f * NGU * D, TPAD, NGU, D, E, c);
            if (rep + 1 < REP_GGU) grid.sync(); }
#ifdef PROBE_KLOOP
            xcd_barrier(xb); { EpiNone EN; pg8::Gemm g; g.A = (const bf16_t*)(p.ws + OFF_HB); g.Bt = (const bf16_t*)(p.ws + OFF_WGU) + (size_t)f * NGU * D; g.M = TPAD; g.N = NGU; g.K = D; g.ld = D;
#if PROBE_KLOOP == 2
              LocalOrder S;
#else
              pg8::StaticOrder S;
#endif
              S.init(TPAD, NGU, (int)gridDim.x, c); pg8::gemm_phase<EpiNone, decltype(S), false>(lds, g, S, EN, nullptr); }
#endif
#endif
        } else if (kind == K_DOWN || kind == K_APO || kind == K_FO) {
#ifndef NO_GRES
            const bf16_t* A; const bf16_t* Bt; int K; float scale;
            if (kind == K_DOWN) { A = (const bf16_t*)(p.ws + OFF_ACT); Bt = (const bf16_t*)(p.ws + OFF_WD) + (size_t)f * D * DFF; K = DFF; scale = 0.5f; }
            else if (kind == K_APO) { A = (const bf16_t*)(p.ws + OFF_AP); Bt = (const bf16_t*)(p.ws + OFF_WO); K = D; scale = 1.0f; }
            else { A = (const bf16_t*)(p.ws + OFF_X); Bt = (const bf16_t*)(p.ws + OFF_W2T); K = 2048; scale = 1.0f; }
            { EpiResid<false> E; E.out = p.out; E.ws = p.ws; E.half = (kind == K_DOWN); E.rss4 = (float*)(p.ws + OFF_RSS); E.part = (LAS float*)(lds + 131072);
              pg8::Gemm g; g.A = A; g.Bt = Bt; g.M = TPAD; g.N = D; g.K = K; g.ld = K;
              const bool split = (int)gridDim.x == 256 && K >= 2048;
              CapOrder S; S.init2(TPAD, D, (int)gridDim.x, c, split ? TAIL_L0 : (TPAD / 256) * 4);
              pg8::gemm_phase<EpiResid<false>, CapOrder, false>(lds, g, S, E, nullptr);
              if (split) {
                  const int nsl = K / 256;
                  if (c < TAIL_UNITS * nsl) { const int tu = c / nsl, sl = c - tu * nsl;
                      EpiPartial EP; EP.P = (float*)(p.ws + OFF_PART) + (size_t)(tu * 16 + sl) * 65536;
                      pg8::Gemm g2; g2.A = A + sl * 256; g2.Bt = Bt + sl * 256; g2.M = TPAD; g2.N = D; g2.K = K / nsl; g2.ld = K;
                      TailOrder S2; S2.init2(TPAD, D, tu);
                      pg8::gemm_phase<EpiPartial, TailOrder, false>(lds, g2, S2, EP, nullptr); }
                  xcd_barrier(xb);
                  tail_fixup(p.ws, nsl, kind == K_DOWN);
              } }
#endif
        } else if (kind == K_GZ) {
#ifndef NO_GZ
            EpiScale E; E.O = (bf16_t*)(p.ws + OFF_Z); E.ldc = INDIM; E.rss = (const float*)(p.ws + OFF_RSS);
            run_gemm(lds, (const bf16_t*)(p.ws + OFF_HB), (const bf16_t*)(p.ws + OFF_WIN), TPAD, INDIM, D, E, c);
#endif
        } else if (kind == K_ATTN) {
#ifndef REP_ATTN
#define REP_ATTN 1
#endif
            for (int rep = 0; rep < REP_ATTN; ++rep) { attn_phase(p, lds); if (rep + 1 < REP_ATTN) grid.sync(); }
        } else if (kind == K_NORMT) {
#ifndef REP_NORMT
#define REP_NORMT 1
#endif
            for (int rep = 0; rep < REP_NORMT; ++rep) { normT_phase(p, lds); if (rep + 1 < REP_NORMT) grid.sync(); }
        } else if (kind == K_DFT) {
#ifndef NO_GDFT
#ifndef REP_DFT
#define REP_DFT 1
#endif
#pragma unroll 1
            for (int grp = 0; grp < 2; ++grp) {
                EpiDft E; E.X = (bf16_t*)(p.ws + OFF_X); E.L = grp ? LB : LA; E.rowbase = grp ? TA : 0;
                pg8::Gemm g; g.A = (const bf16_t*)(p.ws + (grp ? OFF_D2 : OFF_D1)); g.Bt = (const bf16_t*)(p.ws + OFF_HNT) + (grp ? HNT_B : 0); g.M = grp ? MPB : MPA; g.N = (grp ? NBB : NBA) * D; g.K = grp ? LPB : LPA; g.ld = g.K;
                const bool bal = grp && (int)gridDim.x == 256;
                DftOrder S; S.init2(g.M, g.N, (int)gridDim.x, (grp && !bal) ? (int)gridDim.x - 1 - c : c, bal ? 1 : 0);
                pg8::gemm_phase<EpiDft, DftOrder, false>(lds, g, S, E, nullptr);
            }
#endif
        } else {
#ifndef NO_FINAL
            final_phase(p);
#endif
        }
#ifdef USE_CG_SYNC
        if (ph != 15) grid.sync();
#else
        if (ph != 15) xcd_barrier(xb);
#endif
    }
}

extern "C" void kernel_launch(void* const* d_in, const int* in_sizes, int n_in, void* d_out, int out_size, void* d_ws, size_t ws_size, hipStream_t stream) {
    static int grid = 0;
    if (grid == 0) {
        if (n_in != 19 || ws_size < WS_NEED) { fprintf(stderr, "kernel_launch: need 19 inputs and %zu bytes of workspace (got %d, %zu)\n", (size_t)WS_NEED, n_in, ws_size); grid = -1; return; }
        int dev = 0, cus = 0, per_cu = 0;
        hipGetDevice(&dev); hipDeviceGetAttribute(&cus, hipDeviceAttributeMultiprocessorCount, dev);
        if (hipFuncSetAttribute((const void*)mega_fwd, hipFuncAttributeMaxDynamicSharedMemorySize, LDS_BYTES) != hipSuccess) { fprintf(stderr, "kernel_launch: hipFuncSetAttribute failed\n"); grid = -1; return; }
        if (hipOccupancyMaxActiveBlocksPerMultiprocessor(&per_cu, (const void*)mega_fwd, 512, LDS_BYTES) != hipSuccess || per_cu < 1) { fprintf(stderr, "kernel_launch: occupancy query gave %d\n", per_cu); per_cu = 1; (void)hipGetLastError(); }
        grid = cus * 1;
    }
    if (grid < 0) return;
    Params p{};
    for (int i = 0; i < 19; ++i) p.in[i] = (const float*)d_in[i];
    p.out = (float*)d_out; p.ws = (unsigned char*)d_ws;
    if (hipMemsetAsync((unsigned char*)d_ws + OFF_BAR, 0, (size_t)XCD_BAR_WORDS * 4, stream) != hipSuccess) { fprintf(stderr, "kernel_launch: memset of barrier words failed\n"); return; }
    void* args[] = {&p};
    hipError_t e = hipLaunchCooperativeKernel((const void*)mega_fwd, dim3(grid), dim3(512), args, LDS_BYTES, stream);
    if (e != hipSuccess) fprintf(stderr, "cooperative launch failed: %s (grid %d)\n", hipGetErrorString(e), grid);
}
```

```cpp
#include <hip/hip_runtime.h>
#include <hip/hip_cooperative_groups.h>
#include <cstdio>
namespace cg = cooperative_groups;
#define LAS __attribute__((address_space(3)))
namespace pg8 {
#define PG8_LAS __attribute__((address_space(3)))
typedef unsigned short bf16_t;
typedef short bf16x8 __attribute__((ext_vector_type(8)));
typedef float f32x4 __attribute__((ext_vector_type(4)));
typedef unsigned u32x4 __attribute__((ext_vector_type(4)));
constexpr int BM = 256, BK = 64, HALF = 128, HTB = HALF * BK * 2  , STAGE_BYTES = 8 * HTB, NXCD = 8, WGM = 8;

__host__ __device__ __forceinline__ int lds_byte(int r, int c) { const int st = (r >> 4) * 2 + (c >> 5), rr = r & 15, cc = c & 31, ob = rr * 64 + cc * 2; return st * 1024 + (ob ^ (((ob >> 9) & 1) << 5)); }
__host__ __device__ __forceinline__ void stage_rc(int b, int& R, int& C) { const int st = b / 1024, sb = b % 1024, swz = sb ^ (((sb >> 9) & 1) << 5); R = (st >> 1) * 16 + swz / 64; C = (st & 1) * 32 + (swz % 64) / 2; }
__host__ __device__ __forceinline__ int perm32(int rho) { const int n = rho >> 4, i = rho & 15; return 8 * (i >> 2) + 4 * n + (i & 3); }

struct Unit { int pm, pn; };
struct Gemm { const bf16_t* A; const bf16_t* Bt; int M, N, K, ld; };

struct StaticOrder {
    int nM, nN, nwg, G, c;
    __host__ __device__ void init(int M, int N, int G_, int c_) { nM = M / BM; nN = N / BM; nwg = nM * nN; G = G_; c = c_; }
    __host__ __device__ bool next(int i, Unit& u) const {
        const int L = i * G + c; if (L >= nwg) return false;
        int wgid = (int)L; { const int q = nwg / NXCD, r = nwg % NXCD, xcd = wgid % NXCD, off = wgid / NXCD; wgid = (xcd < r ? xcd * (q + 1) : r * (q + 1) + (xcd - r) * q) + off; }
        const int nig = WGM * nN, gid = wgid / nig, fm = gid * WGM, gsz = (nM - fm) < WGM ? (nM - fm) : WGM;
        u.pm = fm + ((wgid % nig) % gsz); u.pn = (wgid % nig) / gsz; return true;
    }
    __device__ __forceinline__ void a_ready(const Unit&) const {}
    __device__ __forceinline__ void done(const Unit&) const {}
};
__device__ __forceinline__ unsigned cvt_pk_bf16(float lo, float hi) { unsigned r; asm volatile("v_cvt_pk_bf16_f32 %0, %1, %2" : "=v"(r) : "v"(lo), "v"(hi)); return r; }
template <class Epi, class Sched, bool STAMP = false>
__device__ __forceinline__ void gemm_phase(PG8_LAS unsigned char* lds, const Gemm g, const Sched& S, const Epi& E, unsigned long long* stamps) {
    int tid_o = threadIdx.x; asm volatile("" : "+v"(tid_o));
    const int tid = tid_o, wid = __builtin_amdgcn_readfirstlane(tid >> 6), lane = tid & 63, wr = wid >> 2, wc = wid & 3, fr = lane & 15, fq = lane >> 4;
    const int K = g.ld, nt = g.K / BK;
    int ts_lo = 0, ts_hi = 0, nts = 0; const unsigned long long rt_entry = STAMP ? (unsigned long long)wall_clock64() : 0ull;
#define PG8_STAMP() do { if (STAMP && wid == 0 && nts < 64) { const unsigned long long _c = (unsigned long long)clock64(); \
        ts_lo = (lane == nts) ? (int)(unsigned)_c : ts_lo; ts_hi = (lane == nts) ? (int)(unsigned)(_c >> 32) : ts_hi; ++nts; } } while (0)
    PG8_STAMP();
    unsigned voffA[2], voffB[2];
#pragma unroll
    for (int i = 0; i < 2; ++i) { int R, C; stage_rc(tid * 16 + i * 8192, R, C); const int Rb = Epi::PERM ? ((R & ~31) + perm32(R & 31)) : R;
        voffA[i] = (unsigned)(R * K + C) * 2u; voffB[i] = (unsigned)(Rb * K + C) * 2u; }
    const size_t kstep = (size_t)(BK * 2);
    const size_t hstep = (size_t)HALF * K * 2;
    const size_t tstep = 2 * hstep;
    const unsigned ldsw = (unsigned)wid * 1024u;
    const int aoff = lds_byte(wr * 64 + fr, fq * 8), boff = lds_byte(wc * 32 + fr, fq * 8);
#define PG8_SA(b, h) (((b) * 2 + (h)) * HTB)
#define PG8_SB(b, h) ((4 + (b) * 2 + (h)) * HTB)
#define PG8_STAGE(bufoff, gbase, voff) do { _Pragma("unroll") for (int _i = 0; _i < 2; ++_i) \
        __builtin_amdgcn_global_load_lds((const unsigned*)((const char*)(gbase) + (voff)[_i]), (PG8_LAS unsigned*)(lds + (bufoff) + ldsw + _i * 8192), 16, 0, 0); } while (0)
#define PG8_LDA(dst, b, h) do { _Pragma("unroll") for (int m = 0; m < 4; ++m) _Pragma("unroll") for (int k = 0; k < 2; ++k) dst[m][k] = *(const PG8_LAS bf16x8*)(lds + PG8_SA(b, h) + aoff + m * 2048 + k * 1024); } while (0)
#define PG8_LDB(dst, b, h) do { _Pragma("unroll") for (int n = 0; n < 2; ++n) _Pragma("unroll") for (int k = 0; k < 2; ++k) dst[n][k] = *(const PG8_LAS bf16x8*)(lds + PG8_SB(b, h) + boff + n * 2048 + k * 1024); } while (0)
#define PG8_MMA(ai, bj, At, Bt) do { __builtin_amdgcn_s_setprio(1); _Pragma("unroll") for (int m = 0; m < 4; ++m) _Pragma("unroll") for (int n = 0; n < 2; ++n) _Pragma("unroll") for (int k = 0; k < 2; ++k) \
        acc[ai][bj][m][n] = __builtin_amdgcn_mfma_f32_16x16x32_bf16(Bt[n][k], At[m][k], acc[ai][bj][m][n], 0, 0, 0); __builtin_amdgcn_s_setprio(0); } while (0)
#define PG8_WAIT_V(n) asm volatile("s_waitcnt vmcnt(" #n ")" ::: "memory")
#define PG8_WAIT_L(n) asm volatile("s_waitcnt lgkmcnt(" #n ")" ::: "memory")
#define PG8_BAR __builtin_amdgcn_s_barrier()
#define PG8_SCHED __builtin_amdgcn_sched_barrier(0)
    Unit cur, nxt; int ui = 0;
    if (!S.next(0, cur)) return;
    f32x4 acc[2][2][4][2];
#pragma unroll
    for (int a = 0; a < 2; ++a)
#pragma unroll
        for (int b = 0; b < 2; ++b)
#pragma unroll
            for (int m = 0; m < 4; ++m)
#pragma unroll
                for (int n = 0; n < 2; ++n) acc[a][b][m][n] = (f32x4){0.f, 0.f, 0.f, 0.f};
    bf16x8 At[4][2], B0[2][2], B1[2][2];
    const char* cA = (const char*)g.A + (size_t)cur.pm * tstep; const char* cB = (const char*)g.Bt + (size_t)cur.pn * tstep;
    S.a_ready(cur);
    PG8_STAGE(PG8_SB(0, 0), cB, voffB); PG8_STAGE(PG8_SA(0, 0), cA, voffA); PG8_STAGE(PG8_SB(0, 1), cB + hstep, voffB); PG8_STAGE(PG8_SA(0, 1), cA + hstep, voffA);
    if (wr == 1) PG8_BAR;
    PG8_WAIT_V(4); PG8_BAR;
    PG8_STAGE(PG8_SB(1, 0), cB + kstep, voffB); PG8_STAGE(PG8_SA(1, 0), cA + kstep, voffA); PG8_STAGE(PG8_SB(1, 1), cB + hstep + kstep, voffB);
    PG8_WAIT_V(6); PG8_BAR;
    PG8_STAMP();
    for (;;) {
        const bool has_next = S.next(ui + 1, nxt);
        const char* nA = has_next ? (const char*)g.A + (size_t)nxt.pm * tstep : cA; const char* nB = has_next ? (const char*)g.Bt + (size_t)nxt.pn * tstep : cB;
        for (int t = 0; t < nt; t += 2) {
            const bool last = (t == nt - 2);
            const char* a1 = cA + (size_t)(t + 1) * kstep;
            const char* a2 = last ? nA : cA + (size_t)(t + 2) * kstep; const char* b2 = last ? nB : cB + (size_t)(t + 2) * kstep;
            const char* a3 = a2 + kstep; const char* b3 = b2 + kstep;
            if (last && has_next) S.a_ready(nxt);
            PG8_LDB(B0, 0, 0); PG8_SCHED; PG8_LDA(At, 0, 0); PG8_STAGE(PG8_SA(1, 1), a1 + hstep, voffA);
            PG8_WAIT_L(8); PG8_BAR; PG8_WAIT_L(0); PG8_MMA(0, 0, At, B0); PG8_BAR; PG8_SCHED;
            PG8_LDB(B1, 0, 1); PG8_STAGE(PG8_SB(0, 0), b2, voffB);
            PG8_BAR; PG8_WAIT_L(0); PG8_MMA(0, 1, At, B1); PG8_BAR;
            PG8_LDA(At, 0, 1); PG8_STAGE(PG8_SA(0, 0), a2, voffA);
            PG8_BAR; PG8_WAIT_L(0); PG8_MMA(1, 0, At, B0); PG8_BAR; PG8_SCHED;
            PG8_STAGE(PG8_SB(0, 1), b2 + hstep, voffB);
            PG8_WAIT_V(6); PG8_BAR; PG8_MMA(1, 1, At, B1); PG8_BAR;
            PG8_LDB(B0, 1, 0); PG8_SCHED; PG8_LDA(At, 1, 0); PG8_STAGE(PG8_SA(0, 1), a2 + hstep, voffA);
            PG8_WAIT_L(8); PG8_BAR; PG8_WAIT_L(0); PG8_MMA(0, 0, At, B0); PG8_BAR; PG8_SCHED;
            PG8_LDB(B1, 1, 1); PG8_STAGE(PG8_SB(1, 0), b3, voffB);
            PG8_BAR; PG8_WAIT_L(0); PG8_MMA(0, 1, At, B1); PG8_BAR;
            PG8_LDA(At, 1, 1); PG8_STAGE(PG8_SA(1, 0), a3, voffA);
            PG8_BAR; PG8_WAIT_L(0); PG8_MMA(1, 0, At, B0); PG8_BAR; PG8_SCHED;
            PG8_STAGE(PG8_SB(1, 1), b3 + hstep, voffB);
            PG8_WAIT_V(6); PG8_BAR; PG8_MMA(1, 1, At, B1); PG8_BAR;
        }
        PG8_STAMP();
        if constexpr (!Epi::AFTER_DRAIN) { E(acc, cur, wr, wc, fr, fq); S.done(cur); }
        PG8_STAMP();
        if (!has_next) break;
#pragma unroll
        for (int a = 0; a < 2; ++a)
#pragma unroll
            for (int b = 0; b < 2; ++b)
#pragma unroll
                for (int m = 0; m < 4; ++m)
#pragma unroll
                    for (int n = 0; n < 2; ++n) acc[a][b][m][n] = (f32x4){0.f, 0.f, 0.f, 0.f};
        cur = nxt; cA = nA; cB = nB; ++ui;
    }
    PG8_WAIT_V(0);
    if (wr == 0) PG8_BAR;
    PG8_BAR;
    if constexpr (Epi::AFTER_DRAIN) { E.fused(acc, cur, wr, wc, fr, fq, lds, wid, lane); S.done(cur); }
    PG8_STAMP();
    if (STAMP && wid == 0) { stamps[lane] = lane < nts ? (((unsigned long long)(unsigned)ts_hi << 32) | (unsigned)ts_lo) : 0ull;
        if (lane == 62) stamps[62] = rt_entry; if (lane == 63) stamps[63] = (unsigned long long)wall_clock64(); }
#undef PG8_STAMP
#undef PG8_SA
#undef PG8_SB
#undef PG8_STAGE
#undef PG8_LDA
#undef PG8_LDB
#undef PG8_MMA
#undef PG8_WAIT_V
#undef PG8_WAIT_L
#undef PG8_BAR
#undef PG8_SCHED
}
}
#define XB_TMO      128
#define XB_XCNT(j)  (256  + 64 * (j))
#define XB_XSUB(j)  (1280 + 64 * (j))
#define XB_XGEN(j)  (2304 + 64 * (j))
#define XB_TOP      3328
#define XB_TOPGEN   3392
#define XCD_BAR_WORDS 3456
#define XB_SPIN_CAP (1u << 18)

__device__ __forceinline__ unsigned xb_ld(unsigned* p)              { return __hip_atomic_load(p, __ATOMIC_RELAXED, __HIP_MEMORY_SCOPE_AGENT); }
__device__ __forceinline__ unsigned xb_add(unsigned* p, unsigned v) { return __hip_atomic_fetch_add(p, v, __ATOMIC_RELAXED, __HIP_MEMORY_SCOPE_AGENT); }
__device__ __forceinline__ unsigned xb_xcc_id() { return (unsigned)__builtin_amdgcn_s_getreg((3 << 11) | 20) & 0xFu; }
#define XB_SPIN(cond, bar) do { unsigned _sp = 0; while (cond) { __builtin_amdgcn_s_sleep(1); \
    if ((++_sp & 255u) == 0u) { if (xb_ld(&(bar)[XB_TMO])) break; if (_sp > XB_SPIN_CAP) { atomicAdd(&(bar)[XB_TMO], 1u); break; } } } } while (0)

struct XcdBarrier {
    unsigned* bar; unsigned x;
    volatile LAS unsigned* st;
};

__device__ __forceinline__ XcdBarrier xcd_barrier_post(unsigned* bar, volatile LAS unsigned* st) {
    XcdBarrier b; b.bar = bar; b.x = xb_xcc_id(); b.st = st;
    if (threadIdx.x == 0) (void)xb_add(&bar[XB_XCNT(b.x)], 1u);
    return b;
}
__device__ __forceinline__ void xcd_barrier_complete(unsigned* bar, unsigned x, unsigned& nloc, unsigned& nx) {
    const unsigned G = gridDim.x * gridDim.y * gridDim.z;
    unsigned sum, cnt, mine, sp = 0u;
    for (;;) {
        sum = 0u; cnt = 0u; mine = 0u;
#pragma unroll
        for (unsigned j = 0; j < 16; ++j) { const unsigned c = xb_ld(&bar[XB_XCNT(j)]); sum += c; cnt += (c > 0u) ? 1u : 0u; mine = (j == x) ? c : mine; }
        if (sum == G) break;
        __builtin_amdgcn_s_sleep(1);
        if ((++sp & 255u) == 0u) { if (xb_ld(&bar[XB_TMO])) break; if (sp > XB_SPIN_CAP) { atomicAdd(&bar[XB_TMO], 1u); break; } }
    }
    nloc = mine > 0u ? mine : 1u; nx = cnt > 0u ? cnt : 1u;
}

__device__ __forceinline__ void xcd_barrier(const XcdBarrier& b) {
    asm volatile("s_waitcnt vmcnt(0)" ::: "memory");
    __syncthreads();
    if (threadIdx.x == 0) {
        unsigned* bar = b.bar;
        __builtin_amdgcn_s_waitcnt(0);
        unsigned nloc = b.st[0], nx = b.st[1];
        if (nloc == 0u) { xcd_barrier_complete(bar, b.x, nloc, nx); b.st[0] = nloc; b.st[1] = nx; }
        const unsigned old = xb_add(&bar[XB_XSUB(b.x)], 1u);
        const unsigned gen = old / nloc;
        if (old + 1u == (gen + 1u) * nloc) {
            __builtin_amdgcn_fence(__ATOMIC_RELEASE, "agent");
            asm volatile("s_waitcnt vmcnt(0)" ::: "memory");
            const unsigned og = xb_add(&bar[XB_TOP], 1u);
            const unsigned tg = og / nx;
            if (og + 1u == (tg + 1u) * nx) xb_add(&bar[XB_TOPGEN], 1u);
            else XB_SPIN(xb_ld(&bar[XB_TOPGEN]) == tg, bar);
            __builtin_amdgcn_fence(__ATOMIC_ACQUIRE, "agent");
            xb_add(&bar[XB_XGEN(b.x)], 1u);
            asm volatile("s_waitcnt vmcnt(0)" ::: "memory");
        } else {
            XB_SPIN(xb_ld(&bar[XB_XGEN(b.x)]) == gen, bar);
            __builtin_amdgcn_fence(__ATOMIC_ACQUIRE, "agent");
            asm volatile("s_waitcnt vmcnt(0)" ::: "memory");
        }
    }
    __syncthreads();
}

using pg8::bf16_t; using pg8::bf16x8; using pg8::f32x4; using pg8::u32x4; using pg8::Unit; using pg8::cvt_pk_bf16;
typedef unsigned u32x2 __attribute__((ext_vector_type(2)));
typedef float f32x2 __attribute__((ext_vector_type(2)));

#define GAS __attribute__((address_space(1)))
template <class T> __device__ __forceinline__ T gload(const T* p) { return *(const GAS T*)p; }
template <class T> __device__ __forceinline__ void gstore(T* p, const T& v) { *(GAS T*)p = v; }
constexpr int D = 1024, DFF = 2816, NGU = 5632, INDIM = 1280;
constexpr int LA = 4112, LB = 2064, NBA = 8, NBB = 32;
constexpr int TA = NBA * LA;
constexpr int T = TA + NBB * LB;
constexpr int TPAD = 99072;
constexpr int LPA = 4224, LPB = 2176;
constexpr int MPA = 4352, MPB = 2304;
constexpr int LDS_BYTES = 147456;

constexpr size_t al256(size_t x) { return (x + 255) & ~(size_t)255; }
constexpr size_t OFF_WGU = 0;
constexpr size_t OFF_WD = al256(OFF_WGU + (size_t)4 * NGU * D * 2);
constexpr size_t OFF_WIN = al256(OFF_WD + (size_t)4 * D * DFF * 2);
constexpr size_t OFF_WO = al256(OFF_WIN + (size_t)INDIM * D * 2);
constexpr size_t OFF_W2T = al256(OFF_WO + (size_t)D * D * 2);
constexpr size_t OFF_D1 = al256(OFF_W2T + (size_t)D * 2048 * 2);
constexpr size_t OFF_D2 = al256(OFF_D1 + (size_t)MPA * LPA * 2);
constexpr size_t OFF_HMETA = al256(OFF_D2 + (size_t)MPB * LPB * 2);
constexpr size_t OFF_RSS = al256(OFF_HMETA + (size_t)640 * D * 4);
constexpr size_t OFF_HB = al256(OFF_RSS + (size_t)TPAD * 16 * 4);
constexpr size_t OFF_BIG = al256(OFF_HB + (size_t)TPAD * D * 2);
constexpr size_t OFF_ACT = OFF_BIG;
constexpr size_t OFF_Z = OFF_BIG;
constexpr size_t OFF_AP = al256(OFF_Z + (size_t)TPAD * INDIM * 2);
constexpr size_t OFF_HNT = OFF_BIG;
constexpr size_t HNT_B = (size_t)NBA * D * LPA;
constexpr size_t OFF_X = al256(OFF_HNT + ((size_t)NBA * D * LPA + (size_t)NBB * D * LPB) * 2);
constexpr size_t OFF_SMALL = al256(OFF_X + (size_t)TPAD * 2048 * 2);
constexpr size_t OFF_BAR = al256(OFF_SMALL + 3072 * 4);
constexpr size_t OFF_PART = al256(OFF_BAR + (size_t)XCD_BAR_WORDS * 4);
constexpr size_t WS_NEED = al256(OFF_PART + (size_t)12 * 16 * 256 * 256 * 4);
static_assert(OFF_AP + (size_t)TPAD * D * 2 <= WS_NEED && OFF_ACT + (size_t)TPAD * DFF * 2 <= WS_NEED, "big region");

struct Params { const float* in[19]; float* out; unsigned char* ws; };

__device__ __forceinline__ void row_decode(int r, int& gb, int& l, int& L, int& rb) {
    if (r < TA) { gb = r / LA; l = r - gb * LA; L = LA; rb = gb * LA; }
    else { const int q = r - TA, b = q / LB; l = q - b * LB; gb = NBA + b; L = LB; rb = TA + b * LB; }
}
__device__ __forceinline__ float* hptr2(float* out, unsigned char* ws, int r) {
    int gb, l, L, rb; row_decode(r, gb, l, L, rb);
    if (l < 16) return (float*)(ws + OFF_HMETA) + (size_t)(gb * 16 + l) * D;
    return out + (size_t)(r - 16 * (gb + 1)) * D;
}
__device__ __forceinline__ float* hptr(const Params& p, int r) {
    int gb, l, L, rb; row_decode(r, gb, l, L, rb);
    if (l < 16) return (float*)(p.ws + OFF_HMETA) + (size_t)(gb * 16 + l) * D;
    return p.out + (size_t)(r - 16 * (gb + 1)) * D;
}
__device__ __forceinline__ int otid() { int t = threadIdx.x; asm volatile("" : "+v"(t)); return t; }
__device__ __forceinline__ bf16_t f2bf(float f) { unsigned u = __float_as_uint(f); u += 0x7FFFu + ((u >> 16) & 1u); return (bf16_t)(u >> 16); }
__device__ __forceinline__ float bflo(unsigned w) { return __uint_as_float(w << 16); }
__device__ __forceinline__ float bfhi(unsigned w) { return __uint_as_float(w & 0xFFFF0000u); }
__device__ __forceinline__ float wave_sum(float v) {
#pragma unroll
    for (int o = 1; o < 64; o <<= 1) v += __shfl_xor(v, o);
    return v;
}
__device__ __forceinline__ float rstd_of(float ss) { return __builtin_amdgcn_rsqf(ss * (1.0f / 1024.0f) + 1e-6f); }

struct EpiGateUp {
    static constexpr bool PERM = true, AFTER_DRAIN = false;
    bf16_t* act; const float* rss;
    __device__ __forceinline__ void operator()(const f32x4 (&acc)[2][2][4][2], const Unit& u, int wr, int wc, int fr, int fq) const {
        const int col = u.pn * 128 + wc * 32 + fq * 8;
        float rsc[2][4];
#pragma unroll
        for (int ai = 0; ai < 2; ++ai)
#pragma unroll
            for (int m = 0; m < 4; ++m) { const int r = u.pm * 256 + ai * 128 + wr * 64 + m * 16 + fr; const f32x4 q4 = gload((const f32x4*)(rss + (size_t)min(r, T - 1) * 4)); rsc[ai][m] = (q4[0] + q4[1]) + (q4[2] + q4[3]); }
#pragma unroll
        for (int ai = 0; ai < 2; ++ai)
#pragma unroll
            for (int m = 0; m < 4; ++m) rsc[ai][m] = rstd_of(rsc[ai][m]);
#pragma unroll
        for (int ai = 0; ai < 2; ++ai)
#pragma unroll
            for (int m = 0; m < 4; ++m) {
                const int r = u.pm * 256 + ai * 128 + wr * 64 + m * 16 + fr;
                const float rs = rsc[ai][m]; const f32x2 rs2 = {rs * rs, rs * rs}, nrl = {rs * -1.4426950408889634f, rs * -1.4426950408889634f}, one = {1.0f, 1.0f};
                unsigned w[4];
#pragma unroll
                for (int n = 0; n < 2; ++n)
#pragma unroll
                    for (int e = 0; e < 4; e += 2) {
                        const f32x2 g = {acc[ai][0][m][n][e], acc[ai][0][m][n][e + 1]}, uu = {acc[ai][1][m][n][e], acc[ai][1][m][n][e + 1]};
                        const f32x2 t = g * nrl; f32x2 ex; ex.x = __builtin_amdgcn_exp2f(t.x); ex.y = __builtin_amdgcn_exp2f(t.y);
                        const f32x2 dn = ex + one; f32x2 rc; rc.x = __builtin_amdgcn_rcpf(dn.x); rc.y = __builtin_amdgcn_rcpf(dn.y);
                        const f32x2 o2 = ((g * uu) * rs2) * rc;
                        w[n * 2 + (e >> 1)] = cvt_pk_bf16(o2.x, o2.y);
                    }
                u32x4 o; o.x = w[0]; o.y = w[1]; o.z = w[2]; o.w = w[3];
                if (r < T) gstore((u32x4*)(act + (size_t)r * DFF + col), o);
            }
    }
};
struct EpiScale {
    static constexpr bool PERM = true, AFTER_DRAIN = false;
    bf16_t* O; int ldc; const float* rss;
    __device__ __forceinline__ void operator()(const f32x4 (&acc)[2][2][4][2], const Unit& u, int wr, int wc, int fr, int fq) const {
        const int col = u.pn * 256 + wc * 32 + fq * 8;
        float rsv[2][4];
#pragma unroll
        for (int ai = 0; ai < 2; ++ai)
#pragma unroll
            for (int m = 0; m < 4; ++m) { const int r = u.pm * 256 + ai * 128 + wr * 64 + m * 16 + fr; { const f32x4 q4 = gload((const f32x4*)(rss + (size_t)min(r, T - 1) * 4)); rsv[ai][m] = (q4[0] + q4[1]) + (q4[2] + q4[3]); } }
#pragma unroll
        for (int ai = 0; ai < 2; ++ai)
#pragma unroll
            for (int m = 0; m < 4; ++m) {
                const int r = u.pm * 256 + ai * 128 + wr * 64 + m * 16 + fr;
                const float rs = rstd_of(rsv[ai][m]);
                if (r < T) {
#pragma unroll
                    for (int bj = 0; bj < 2; ++bj) {
                        const f32x4 v0 = acc[ai][bj][m][0] * rs, v1 = acc[ai][bj][m][1] * rs;
                        u32x4 o; o.x = cvt_pk_bf16(v0[0], v0[1]); o.y = cvt_pk_bf16(v0[2], v0[3]); o.z = cvt_pk_bf16(v1[0], v1[1]); o.w = cvt_pk_bf16(v1[2], v1[3]);
                        gstore((u32x4*)(O + (size_t)r * ldc + col + bj * 128), o);
                    }
                }
            }
    }
};
struct EpiNone {
    static constexpr bool PERM = true, AFTER_DRAIN = false;
    __device__ __forceinline__ void operator()(const f32x4 (&acc)[2][2][4][2], const Unit& u, int wr, int wc, int fr, int fq) const {
#pragma unroll
        for (int ai = 0; ai < 2; ++ai)
#pragma unroll
            for (int bj = 0; bj < 2; ++bj)
#pragma unroll
                for (int m = 0; m < 4; ++m)
#pragma unroll
                    for (int n = 0; n < 2; ++n) asm volatile("" :: "v"(acc[ai][bj][m][n]));
    }
};
template <bool LAST> struct EpiResid {
    static constexpr bool PERM = true, AFTER_DRAIN = false;
    float* out; unsigned char* ws; int half; float* rss4; LAS float* part;
    __device__ __forceinline__ void operator()(const f32x4 (&acc)[2][2][4][2], const Unit& u, int wr, int wc, int fr, int fq) const {
        const int col = u.pn * 256 + wc * 32 + fq * 8;
        bf16_t* hb = (bf16_t*)(ws + OFF_HB);
        u32x4 hv[2][4][2];
#pragma unroll
        for (int ai = 0; ai < 2; ++ai)
#pragma unroll
            for (int m = 0; m < 4; ++m) { const int r = u.pm * 256 + ai * 128 + wr * 64 + m * 16 + fr; const bf16_t* hp = hb + (size_t)min(r, T - 1) * D + col;
#pragma unroll
                for (int bj = 0; bj < 2; ++bj) hv[ai][m][bj] = gload((const u32x4*)(hp + bj * 128)); }
#pragma unroll
        for (int ai = 0; ai < 2; ++ai)
#pragma unroll
            for (int m = 0; m < 4; ++m) {
                const int r = u.pm * 256 + ai * 128 + wr * 64 + m * 16 + fr;
                f32x2 ss2 = {0.f, 0.f}; const float scale = half ? 0.5f : 1.0f; const f32x2 sc2 = {scale, scale};
#pragma unroll
                for (int bj = 0; bj < 2; ++bj) {
                    const u32x4 w = hv[ai][m][bj]; const f32x4 a0 = acc[ai][bj][m][0], a1 = acc[ai][bj][m][1];
                    f32x2 p0 = {bflo(w.x), bfhi(w.x)}, p1 = {bflo(w.y), bfhi(w.y)}, p2 = {bflo(w.z), bfhi(w.z)}, p3 = {bflo(w.w), bfhi(w.w)};
                    p0 += (f32x2){a0[0], a0[1]} * sc2; p1 += (f32x2){a0[2], a0[3]} * sc2; p2 += (f32x2){a1[0], a1[1]} * sc2; p3 += (f32x2){a1[2], a1[3]} * sc2;
                    ss2 += p0 * p0; ss2 += p1 * p1; ss2 += p2 * p2; ss2 += p3 * p3;
                    if (r < T) {
                        u32x4 o; o.x = cvt_pk_bf16(p0.x, p0.y); o.y = cvt_pk_bf16(p1.x, p1.y); o.z = cvt_pk_bf16(p2.x, p2.y); o.w = cvt_pk_bf16(p3.x, p3.y);
                        gstore((u32x4*)(hb + (size_t)r * D + col + bj * 128), o);
                    }
                }
                float ss = ss2.x + ss2.y;
                ss += __shfl_xor(ss, 16); ss += __shfl_xor(ss, 32);
                if (fq == 0) part[(ai * 128 + wr * 64 + m * 16 + fr) * 4 + wc] = ss;
            }
        asm volatile("s_waitcnt lgkmcnt(0)" ::: "memory"); __builtin_amdgcn_s_barrier(); asm volatile("" ::: "memory");
        const int lane = fq * 16 + fr;
        if (lane < 32) { const int rl = (lane >> 4) * 128 + wr * 64 + wc * 16 + (lane & 15), r = u.pm * 256 + rl;
            const f32x4 v = *(const LAS f32x4*)(part + rl * 4);
            if (r < T) gstore(rss4 + (size_t)r * 4 + u.pn, (v[0] + v[1]) + (v[2] + v[3])); }
    }
};
struct EpiDft {
    static constexpr bool PERM = true, AFTER_DRAIN = false;
    bf16_t* X; int L, rowbase;
    __device__ __forceinline__ void operator()(const f32x4 (&acc)[2][2][4][2], const Unit& u, int wr, int wc, int fr, int fq) const {
        const int b = u.pn >> 2, c0 = (u.pn & 3) * 256 + wc * 32 + fq * 8, H = L >> 1;
#pragma unroll
        for (int ai = 0; ai < 2; ++ai)
#pragma unroll
            for (int m = 0; m < 4; ++m) {
                const int kk = u.pm * 256 + ai * 128 + wr * 64 + m * 16 + fr;
                if (kk < L) {
                    const bool isc = kk <= H; const int k = isc ? kk : kk - H; const float sg = isc ? 1.f : -1.f;
                    bf16_t* x0 = X + (size_t)(rowbase + b * L + k) * 2048 + (isc ? 0 : 1024) + c0;
                    bf16_t* x1 = X + (size_t)(rowbase + b * L + (L - k)) * 2048 + (isc ? 0 : 1024) + c0;
                    const bool mir = (k >= 1) && (k < H);
#pragma unroll
                    for (int bj = 0; bj < 2; ++bj) {
                        const f32x4 v0 = acc[ai][bj][m][0] * sg, v1 = acc[ai][bj][m][1] * sg;
                        u32x4 o; o.x = cvt_pk_bf16(v0[0], v0[1]); o.y = cvt_pk_bf16(v0[2], v0[3]); o.z = cvt_pk_bf16(v1[0], v1[1]); o.w = cvt_pk_bf16(v1[2], v1[3]);
                        gstore((u32x4*)(x0 + bj * 128), o);
                        if (mir) { u32x4 q; if (isc) q = o; else { q.x = o.x ^ 0x80008000u; q.y = o.y ^ 0x80008000u; q.z = o.z ^ 0x80008000u; q.w = o.w ^ 0x80008000u; } gstore((u32x4*)(x1 + bj * 128), q); }
                        if (isc && !mir) { u32x4 zz; zz.x = 0; zz.y = 0; zz.z = 0; zz.w = 0; gstore((u32x4*)(x0 + 1024 + bj * 128), zz); }
                    }
                }
            }
    }
};

struct DftOrder : pg8::StaticOrder {
    int cc, GG, mode;
    __device__ void init2(int M, int N, int G_, int c_, int mode_) { init(M, N, 1, 0); cc = c_; GG = G_; mode = mode_; }
    __device__ bool next(int i, Unit& u) const { int L;
        if (mode == 0) { L = i * GG + cc; if (L >= nwg) return false; }
        else if (cc < 32) { if (i >= 3) return false; L = 1056 + cc * 3 + i; }
        else { const int d = cc - 32; if (i < 4) L = i * 224 + d; else if (i == 4 && d < 160) L = 896 + d; else return false; }
        return pg8::StaticOrder::next(L, u); }
};
constexpr int TAIL_L0 = 6 * 256, TAIL_UNITS = (TPAD / 256) * 4 - TAIL_L0;
struct CapOrder : pg8::StaticOrder {
    int cc, GG, cap;
    __device__ void init2(int M, int N, int G_, int c_, int cap_) { init(M, N, 1, 0); cc = c_; GG = G_; cap = cap_; }
    __device__ bool next(int i, Unit& u) const { const int L = i * GG + cc; if (L >= cap) return false; return pg8::StaticOrder::next(L, u); }
};
struct TailOrder : pg8::StaticOrder {
    int tu;
    __device__ void init2(int M, int N, int tu_) { init(M, N, 1, 0); tu = tu_; }
    __device__ bool next(int i, Unit& u) const { if (i != 0) return false; return pg8::StaticOrder::next(TAIL_L0 + tu, u); }
};
struct EpiPartial {
    static constexpr bool PERM = true, AFTER_DRAIN = false;
    float* P;
    __device__ __forceinline__ void operator()(const f32x4 (&acc)[2][2][4][2], const Unit& u, int wr, int wc, int fr, int fq) const {
#pragma unroll
        for (int ai = 0; ai < 2; ++ai)
#pragma unroll
            for (int m = 0; m < 4; ++m) { float* rowp = P + (size_t)(ai * 128 + wr * 64 + m * 16 + fr) * 256 + wc * 32 + fq * 8;
#pragma unroll
                for (int bj = 0; bj < 2; ++bj) { gstore((f32x4*)(rowp + bj * 128), acc[ai][bj][m][0]); gstore((f32x4*)(rowp + bj * 128 + 4), acc[ai][bj][m][1]); } }
    }
};
__device__ __forceinline__ void tail_fixup(unsigned char* ws, int nsl, int half) {
    const float scale = half ? 0.5f : 1.0f;
    const int tid = otid(), lane = tid & 63, gw = blockIdx.x * 8 + (tid >> 6), NGW = gridDim.x * 8;
    bf16_t* hb = (bf16_t*)(ws + OFF_HB); float* rss4 = (float*)(ws + OFF_RSS); const float* P0 = (const float*)(ws + OFF_PART);
    pg8::StaticOrder so; so.init(TPAD, D, 1, 0);
    for (int it = gw; it < TAIL_UNITS * 256; it += NGW) {
        const int tu = it >> 8, rl = it & 255; Unit u; so.next(TAIL_L0 + tu, u);
        const int r = u.pm * 256 + rl, col = u.pn * 256 + lane * 4;
        f32x4 a = {0.f, 0.f, 0.f, 0.f};
        f32x4 pv[11];
#pragma unroll
        for (int sl = 0; sl < 11; ++sl) pv[sl] = gload((const f32x4*)(P0 + ((size_t)(tu * 16 + min(sl, nsl - 1)) * 256 + rl) * 256 + lane * 4));
#pragma unroll
        for (int sl = 0; sl < 11; ++sl) { const float m = sl < nsl ? 1.0f : 0.0f; a += pv[sl] * m; }
        float ss = 0.f;
        if (r < T) { const u32x2 w = gload((const u32x2*)(hb + (size_t)r * D + col));
            f32x4 h; h[0] = bflo(w.x); h[1] = bfhi(w.x); h[2] = bflo(w.y); h[3] = bfhi(w.y); h += a * scale;
            ss = (h[0] * h[0] + h[1] * h[1]) + (h[2] * h[2] + h[3] * h[3]);
            u32x2 o; o.x = cvt_pk_bf16(h[0], h[1]); o.y = cvt_pk_bf16(h[2], h[3]); gstore((u32x2*)(hb + (size_t)r * D + col), o); }
        ss = wave_sum(ss);
        if (lane == 0 && r < T) rss4[(size_t)r * 4 + u.pn] = ss;
    }
}
struct LocalOrder : pg8::StaticOrder { __device__ bool next(int i, Unit& u) const { const bool ok = pg8::StaticOrder::next(i, u); u.pm &= 7; return ok; } };
template <class Epi>
__device__ __forceinline__ void run_gemm(LAS unsigned char* lds, const bf16_t* A, const bf16_t* Bt, int M, int N, int K, const Epi& E, int c) {
    pg8::Gemm g; g.A = A; g.Bt = Bt; g.M = M; g.N = N; g.K = K; g.ld = K;
    pg8::StaticOrder S; S.init(M, N, (int)gridDim.x, c);
    pg8::gemm_phase<Epi, pg8::StaticOrder, false>(lds, g, S, E, nullptr);
}

__device__ __forceinline__ void transpose_item(const float* W, int N, const float* gain, bf16_t* WT, int ldd, int k0, int n0, int drow0, LAS float* scr, int lane, float osc = 1.0f) {
#pragma unroll
    for (int i = 0; i < 32; ++i) { const int kk = 2 * i + (lane >> 5); f32x2 v = *(const f32x2*)(W + (size_t)(k0 + kk) * N + n0 + 2 * (lane & 31)); if (gain) v *= gain[k0 + kk] * osc; *(LAS f32x2*)(scr + kk * 66 + 2 * (lane & 31)) = v; }
    asm volatile("s_waitcnt lgkmcnt(0)" ::: "memory");
    const int c = lane & 7;
#pragma unroll
    for (int jj = 0; jj < 8; ++jj) { const int n = (lane >> 3) + 8 * jj; const LAS float* sp = scr + (8 * c) * 66 + n;
        u32x4 o; o.x = cvt_pk_bf16(sp[0 * 66], sp[1 * 66]); o.y = cvt_pk_bf16(sp[2 * 66], sp[3 * 66]); o.z = cvt_pk_bf16(sp[4 * 66], sp[5 * 66]); o.w = cvt_pk_bf16(sp[6 * 66], sp[7 * 66]);
        *(u32x4*)(WT + (size_t)(drow0 + n) * ldd + k0 + 8 * c) = o; }
    asm volatile("s_waitcnt lgkmcnt(0)" ::: "memory");
}
__device__ __forceinline__ void dft_item(bf16_t* Dm, int L, int LP, int witem, int lane) {
    const int cpr = LP >> 3, H = L >> 1; const int tix = witem * 64 + lane; const int kk = tix / cpr, c8 = tix - kk * cpr;
    const bool isc = kk <= H; const int k = isc ? kk : kk - H;
    const float sc = rsqrtf((float)L), invL = 1.0f / (float)L;
    int mm = (k * (c8 * 8)) % L;
    unsigned w[4];
#pragma unroll
    for (int e = 0; e < 8; e += 2) {
        float v[2];
#pragma unroll
        for (int q = 0; q < 2; ++q) { const int n = c8 * 8 + e + q; const float a = (float)mm * invL;
            const float x = (isc ? __builtin_amdgcn_cosf(a) : __builtin_amdgcn_sinf(a)) * sc;
            v[q] = (kk < L && n < L) ? x : 0.f;
            mm += k; mm = mm >= L ? mm - L : mm; }
        w[e >> 1] = cvt_pk_bf16(v[0], v[1]);
    }
    u32x4 o; o.x = w[0]; o.y = w[1]; o.z = w[2]; o.w = w[3];
    *(u32x4*)(Dm + (size_t)kk * LP + c8 * 8) = o;
}
__device__ __forceinline__ void prep_phase(const Params& p, LAS unsigned char* lds) {
    const int tid = otid(), lane = tid & 63, wave = __builtin_amdgcn_readfirstlane(tid >> 6);
    const int gw = blockIdx.x * 8 + wave, NGW = gridDim.x * 8;
    LAS float* scr = (LAS float*)(lds + wave * 16896);
    LAS float* tab = (LAS float*)(lds + 8 * 16896);
    if (tid < 256) { tab[tid] = cospif((float)tid * (1.0f / 128.0f)); tab[256 + tid] = sinpif((float)tid * (1.0f / 128.0f)); }
    __syncthreads();
    if (blockIdx.x == 0) { float* sm = (float*)(p.ws + OFF_SMALL); if (tid < 8) sm[tid] = p.in[9][tid]; for (int i = tid; i < 1024; i += 512) { sm[1024 + i] = p.in[7][D + i]; sm[2048 + i] = p.in[18][i]; } }
    bf16_t* Wgu = (bf16_t*)(p.ws + OFF_WGU); bf16_t* Wd = (bf16_t*)(p.ws + OFF_WD); bf16_t* Win = (bf16_t*)(p.ws + OFF_WIN);
    bf16_t* Wo = (bf16_t*)(p.ws + OFF_WO); bf16_t* W2t = (bf16_t*)(p.ws + OFF_W2T);
    constexpr int I_G = 16 * 44, I_D = 44 * 16;
    constexpr int N_TR_FFN = 4 * (2 * I_G + I_D);
    constexpr int I_IN = 16 * 20, I_WO = 8 * 16;
    constexpr int R0 = N_TR_FFN, R1 = R0 + I_IN, R2 = R1 + I_WO;
    constexpr int N_W3 = 256 * 8, N_W2 = 128 * 32;
    constexpr int R3 = R2 + N_W3, R4 = R3 + N_W2;
    constexpr int N_D1 = MPA * (LPA / 8) / 64, N_D2 = MPB * (LPB / 8) / 64;
    constexpr int R5 = R4 + N_D1, R6 = R5 + N_D2, R7 = R6 + T / 2;
    for (int it = gw; it < R7; it += NGW) {
        if (it < R0) {
            const int f = it / (2 * I_G + I_D); int r = it - f * (2 * I_G + I_D); const int layer = f >> 1, which = f & 1;
            if (r < 2 * I_G) { const int up = r >= I_G; if (up) r -= I_G;
                const float* src = p.in[which ? (up ? 16 : 15) : (up ? 5 : 4)] + (size_t)layer * D * DFF;
                const float* gain = p.in[which ? 14 : 3] + layer * D;
                const int kb = r / 44, nb = r - kb * 44, n0 = nb * 64;
                const int drow0 = (n0 >> 7) * 256 + (up ? 128 : 0) + (n0 & 127);
                transpose_item(src, DFF, gain, Wgu + (size_t)f * NGU * D, D, kb * 64, n0, drow0, scr, lane);
            } else { r -= 2 * I_G;
                const float* src = p.in[which ? 17 : 6] + (size_t)layer * DFF * D;
                const int kb = r / 16, nb = r - kb * 16;
                transpose_item(src, D, nullptr, Wd + (size_t)f * D * DFF, DFF, kb * 64, nb * 64, nb * 64, scr, lane);
            }
        } else if (it < R1) { const int r = it - R0, kb = r / 20, nb = r - kb * 20;
            transpose_item(p.in[8], INDIM, p.in[7], Win, D, kb * 64, nb * 64, nb * 64, scr, lane, nb < 8 ? 0.125f : 1.0f);
        } else if (it < R2) { const int r = it - R1, kb = r / 16, nb = r - kb * 16;
            transpose_item(p.in[12], D, nullptr, Wo, D, kb * 64, nb * 64, nb * 64, scr, lane);
        } else if (it < R3) {
            const int r = it - R2, j = (r & 255) * 4, kb = r >> 8, kk = kb * 64 + lane, g = kk >> 7, c = kk & 127;
            const float* pw = p.in[10] + (size_t)(g * 128 + c) * 128; const float* ps = p.in[11] + g * 128; const float* wo = p.in[12] + (size_t)(512 + g * 128) * D + j;
            f32x4 a = {0.f, 0.f, 0.f, 0.f};
#pragma unroll 16
            for (int d = 0; d < 128; ++d) { const f32x4 w = *(const f32x4*)(wo + (size_t)d * D); a += w * (pw[d] * ps[d]); }
#pragma unroll
            for (int q = 0; q < 4; ++q) Wo[(size_t)(j + q) * D + 512 + kk] = f2bf(a[q]);
        } else if (it < R4) {
            const int r = it - R3, j = (r & 127) * 8, kb = r >> 7, kk = kb * 64 + lane, part = kk >> 10, k2 = kk & 1023, g = k2 >> 8, c = k2 & 255;
            const float* wf = p.in[13] + (size_t)(g * 256) * D + j; const LAS float* tb = tab + part * 256;
            f32x4 a0 = {0.f, 0.f, 0.f, 0.f}, a1 = {0.f, 0.f, 0.f, 0.f};
#pragma unroll 8
            for (int d = 0; d < 256; ++d) { const f32x4 w0 = *(const f32x4*)(wf + (size_t)d * D), w1 = *(const f32x4*)(wf + (size_t)d * D + 4); const float t = tb[(c * d) & 255]; a0 += w0 * t; a1 += w1 * t; }
#pragma unroll
            for (int q = 0; q < 4; ++q) { W2t[(size_t)(j + q) * 2048 + kk] = f2bf(a0[q] * 0.0625f); W2t[(size_t)(j + 4 + q) * 2048 + kk] = f2bf(a1[q] * 0.0625f); }
        } else if (it < R5) { dft_item((bf16_t*)(p.ws + OFF_D1), LA, LPA, it - R4, lane);
        } else if (it < R6) { dft_item((bf16_t*)(p.ws + OFF_D2), LB, LPB, it - R5, lane);
        } else {
            const int r0 = (it - R6) * 2; const float* src[2]; f32x4 v[2][4];
#pragma unroll
            for (int q = 0; q < 2; ++q) { int gb, l, L, rb; row_decode(r0 + q, gb, l, L, rb);
                src[q] = (l < 16) ? p.in[2] + (size_t)l * D : (gb < NBA ? p.in[0] + ((size_t)gb * 4096 + (l - 16)) * D : p.in[1] + ((size_t)(gb - NBA) * 2048 + (l - 16)) * D); }
#pragma unroll
            for (int q = 0; q < 2; ++q)
#pragma unroll
                for (int i = 0; i < 4; ++i) v[q][i] = __builtin_nontemporal_load((const GAS f32x4*)(src[q] + (lane + 64 * i) * 4));
            float* rss0 = (float*)(p.ws + OFF_RSS);
#pragma unroll
            for (int q = 0; q < 2; ++q) { bf16_t* hb = (bf16_t*)(p.ws + OFF_HB) + (size_t)(r0 + q) * D; float ss = 0.f;
#pragma unroll
                for (int i = 0; i < 4; ++i) { ss += (v[q][i][0] * v[q][i][0] + v[q][i][1] * v[q][i][1]) + (v[q][i][2] * v[q][i][2] + v[q][i][3] * v[q][i][3]);
                    u32x2 o; o.x = cvt_pk_bf16(v[q][i][0], v[q][i][1]); o.y = cvt_pk_bf16(v[q][i][2], v[q][i][3]); *(u32x2*)(hb + (lane + 64 * i) * 4) = o; }
                ss = wave_sum(ss);
                if (lane == 0) { f32x4 q4 = {ss, 0.f, 0.f, 0.f}; *(f32x4*)(rss0 + (size_t)(r0 + q) * 4) = q4; } }
        }
    }
}

template <int HW> __device__ __forceinline__ void pool_item(const bf16_t* z, bf16_t* ap, int r, int ch) {
    int gb, l, L, rb; row_decode(r, gb, l, L, rb);
    const bf16_t* base = z + (size_t)r * INDIM + 768 + ch * 8;
    u32x4 v[2 * HW + 3];
#pragma unroll
    for (int o = 0; o < 2 * HW + 3; ++o) { const int s = l - HW + o; u32x4 t; t.x = 0; t.y = 0; t.z = 0; t.w = 0; if (s >= 0 && s < L) t = gload((const u32x4*)(base + (long)(o - HW) * INDIM)); v[o] = t; }
    float s0 = 0.f, s1 = 0.f, s2 = 0.f, s3 = 0.f, s4 = 0.f, s5 = 0.f, s6 = 0.f, s7 = 0.f;
#pragma unroll
    for (int o = 0; o < 2 * HW; ++o) { s0 += bflo(v[o].x); s1 += bfhi(v[o].x); s2 += bflo(v[o].y); s3 += bfhi(v[o].y); s4 += bflo(v[o].z); s5 += bfhi(v[o].z); s6 += bflo(v[o].w); s7 += bfhi(v[o].w); }
#pragma unroll
    for (int q = 0; q < 4; ++q) {
        const u32x4 me = v[HW + q]; const int lq = l + q;
        const float ic = 1.0f / (float)(min(lq + HW, L) - max(lq - HW, 0));
        u32x4 o; o.x = cvt_pk_bf16(s0 * ic - bflo(me.x), s1 * ic - bfhi(me.x)); o.y = cvt_pk_bf16(s2 * ic - bflo(me.y), s3 * ic - bfhi(me.y));
        o.z = cvt_pk_bf16(s4 * ic - bflo(me.z), s5 * ic - bfhi(me.z)); o.w = cvt_pk_bf16(s6 * ic - bflo(me.w), s7 * ic - bfhi(me.w));
        gstore((u32x4*)(ap + (size_t)(r + q) * D + 512 + ch * 8), o);
        if (q < 3) { const u32x4 out = v[q], in = v[q + 2 * HW];
            s0 += bflo(in.x) - bflo(out.x); s1 += bfhi(in.x) - bfhi(out.x); s2 += bflo(in.y) - bflo(out.y); s3 += bfhi(in.y) - bfhi(out.y);
            s4 += bflo(in.z) - bflo(out.z); s5 += bfhi(in.z) - bfhi(out.z); s6 += bflo(in.w) - bflo(out.w); s7 += bfhi(in.w) - bfhi(out.w); }
    }
}
struct PW { unsigned char* ws; float* out; };
__device__ __forceinline__ void attn_phase(const PW& p, LAS unsigned char* lds) {
    const bf16_t* z = (const bf16_t*)(p.ws + OFF_Z); bf16_t* ap = (bf16_t*)(p.ws + OFF_AP); const float* sink = (const float*)(p.ws + OFF_SMALL);
    const int tid = otid(), lane = tid & 63, wave = __builtin_amdgcn_readfirstlane(tid >> 6), fr = lane & 15, fq = lane >> 4;
    LAS unsigned char* Ks = lds;
    LAS unsigned char* Vt = lds + 55296;
    constexpr int NU = (NBA * 33 + NBB * 17) * 2;
    for (int unit = blockIdx.x; unit < NU; unit += gridDim.x) {
        const int kvh = unit & 1; int tt = unit >> 1; int sb, ti, L, rb;
        if (tt < NBA * 33) { sb = tt / 33; ti = tt - sb * 33; L = LA; rb = sb * LA; } else { tt -= NBA * 33; sb = tt / 17; ti = tt - sb * 17; L = LB; rb = TA + sb * LB; }
        const int l0 = ti * 128;
        __syncthreads();
        {
            typedef __attribute__((address_space(1))) const u32x4 gu32x4;
            u32x4 kreg[6], vreg[7];
#pragma unroll
            for (int i = 0; i < 6; ++i) { const int idx = tid + 512 * i, j = idx >> 3, ch = idx & 7, s = l0 - 128 + j; const bool ok = (s >= 0) && (s < L);
                kreg[i] = *(gu32x4*)(z + (size_t)(rb + (ok ? s : 0)) * INDIM + 512 + kvh * 64 + ch * 8); }
#pragma unroll
            for (int i = 0; i < 7; ++i) { const int idx = tid + 512 * i, ch = min(idx / 400, 7), j = idx - (idx / 400) * 400, s = l0 - 128 + j; const bool ok = (idx < 3200) && (j < 384) && (s >= 0) && (s < L);
                vreg[i] = *(gu32x4*)(z + (size_t)(rb + (ok ? s : 0)) * INDIM + 640 + kvh * 64 + ch * 8); }
            __builtin_amdgcn_sched_barrier(0);
#pragma unroll
            for (int i = 0; i < 6; ++i) { const int idx = tid + 512 * i, j = idx >> 3, s = l0 - 128 + j; const bool ok = (s >= 0) && (s < L);
                kreg[i].x = ok ? kreg[i].x : 0u; kreg[i].y = ok ? kreg[i].y : 0u; kreg[i].z = ok ? kreg[i].z : 0u; kreg[i].w = ok ? kreg[i].w : 0u; }
#pragma unroll
            for (int i = 0; i < 7; ++i) { const int idx = tid + 512 * i, j = idx - (idx / 400) * 400, s = l0 - 128 + j; const bool ok = (idx < 3200) && (j < 384) && (s >= 0) && (s < L);
                vreg[i].x = ok ? vreg[i].x : 0u; vreg[i].y = ok ? vreg[i].y : 0u; vreg[i].z = ok ? vreg[i].z : 0u; vreg[i].w = ok ? vreg[i].w : 0u; }
#pragma unroll
            for (int i = 0; i < 6; ++i) { const int idx = tid + 512 * i, j = idx >> 3, ch = idx & 7; *(LAS u32x4*)(Ks + j * 144 + ch * 16) = kreg[i]; }
#pragma unroll
            for (int i = 0; i < 7; ++i) { const int idx = tid + 512 * i; if (idx < 3200) { const int ch = idx / 400, j = idx - ch * 400; const u32x4 v = vreg[i];
                LAS bf16_t* dst = (LAS bf16_t*)Vt + (ch * 8) * 408 + j;
                dst[0 * 408] = (bf16_t)(v.x & 0xFFFFu); dst[1 * 408] = (bf16_t)(v.x >> 16); dst[2 * 408] = (bf16_t)(v.y & 0xFFFFu); dst[3 * 408] = (bf16_t)(v.y >> 16);
                dst[4 * 408] = (bf16_t)(v.z & 0xFFFFu); dst[5 * 408] = (bf16_t)(v.z >> 16); dst[6 * 408] = (bf16_t)(v.w & 0xFFFFu); dst[7 * 408] = (bf16_t)(v.w >> 16); } }
        }
        __syncthreads();
        const int lq0 = l0 + 16 * wave + fr;
        if (l0 + 16 * wave < L) {
#pragma unroll 1
            for (int g = 0; g < 4; ++g) {
                int lq = lq0; asm volatile("" : "+v"(lq)); const bool qok = lq < L;
                const int h = kvh * 4 + g; const float slope = exp2f(-(float)(h + 1)); const float sk = gload(sink + h);
                bf16x8 qf[2];
#pragma unroll
                for (int kk = 0; kk < 2; ++kk) { u32x4 q; q.x = 0; q.y = 0; q.z = 0; q.w = 0; if (qok) q = gload((const u32x4*)(z + (size_t)(rb + lq) * INDIM + h * 64 + kk * 32 + fq * 8)); qf[kk] = __builtin_bit_cast(bf16x8, q); }
                f32x4 sc[17];
                {
                    const LAS unsigned char* kb = Ks + (16 * wave + fr) * 144 + fq * 16;
                    bf16x8 kc0 = *(const LAS bf16x8*)(kb), kc1 = *(const LAS bf16x8*)(kb + 64);
#pragma unroll
                    for (int t = 0; t < 17; ++t) { bf16x8 kn0 = kc0, kn1 = kc1;
                        if (t < 16) { kn0 = *(const LAS bf16x8*)(kb + (t + 1) * 2304); kn1 = *(const LAS bf16x8*)(kb + (t + 1) * 2304 + 64); }
                        f32x4 a = {0.f, 0.f, 0.f, 0.f};
                        a = __builtin_amdgcn_mfma_f32_16x16x32_bf16(kc0, qf[0], a, 0, 0, 0); a = __builtin_amdgcn_mfma_f32_16x16x32_bf16(kc1, qf[1], a, 0, 0, 0);
                        sc[t] = a; kc0 = kn0; kc1 = kn1; __builtin_amdgcn_sched_barrier(0); }
                }
                float mx = -1e30f;
                int db = 128 + fr - 4 * fq, lob = 128 - l0 - 16 * wave - 4 * fq; asm volatile("" : "+v"(db), "+v"(lob));
#pragma unroll
                for (int t = 0; t < 17; ++t)
#pragma unroll
                    for (int e = 0; e < 4; ++e) { const int off = 16 * t + e; const int dist = abs(db - off);
                        bool valid = (unsigned)(off - lob) < (unsigned)L;
                        if (t == 0 || t == 16) valid = valid && (dist <= 128);
                        const float v = valid ? fmaf(-slope, (float)dist, sc[t][e]) : -1e30f; sc[t][e] = v; mx = fmaxf(mx, v); }
                mx = fmaxf(mx, __shfl_xor(mx, 16)); mx = fmaxf(mx, __shfl_xor(mx, 32)); mx = fmaxf(mx, sk);
                float sum = 0.f;
#pragma unroll
                for (int t = 0; t < 17; ++t)
#pragma unroll
                    for (int e = 0; e < 4; ++e) { const float pv = __expf(sc[t][e] - mx); sc[t][e] = pv; sum += pv; }
                sum += __shfl_xor(sum, 16); sum += __shfl_xor(sum, 32); sum += __expf(sk - mx);
                const float inv = 1.0f / sum;
                f32x4 o[4];
#pragma unroll
                for (int dt = 0; dt < 4; ++dt) o[dt] = (f32x4){0.f, 0.f, 0.f, 0.f};
                {
                    const LAS unsigned char* vb = Vt + fr * 816 + (16 * wave + 4 * fq) * 2;
                    u32x2 vlo[4], vhi[4];
#pragma unroll
                    for (int dt = 0; dt < 4; ++dt) { vlo[dt] = *(const LAS u32x2*)(vb + dt * 13056); vhi[dt] = *(const LAS u32x2*)(vb + dt * 13056 + 32); }
#pragma unroll
                    for (int u = 0; u < 9; ++u) {
                        u32x2 nlo[4], nhi[4];
#pragma unroll
                        for (int dt = 0; dt < 4; ++dt) { nlo[dt] = vlo[dt]; nhi[dt] = vhi[dt]; }
                        if (u < 8) {
#pragma unroll
                            for (int dt = 0; dt < 4; ++dt) { nlo[dt] = *(const LAS u32x2*)(vb + dt * 13056 + (u + 1) * 64); nhi[dt] = *(const LAS u32x2*)(vb + dt * 13056 + (u + 1) * 64 + 32); } }
                        u32x4 pw; pw.x = cvt_pk_bf16(sc[2 * u][0], sc[2 * u][1]); pw.y = cvt_pk_bf16(sc[2 * u][2], sc[2 * u][3]);
                        if (2 * u + 1 < 17) { pw.z = cvt_pk_bf16(sc[(2 * u + 1) % 17][0], sc[(2 * u + 1) % 17][1]); pw.w = cvt_pk_bf16(sc[(2 * u + 1) % 17][2], sc[(2 * u + 1) % 17][3]); } else { pw.z = 0; pw.w = 0; }
                        const bf16x8 pf = __builtin_bit_cast(bf16x8, pw);
#pragma unroll
                        for (int dt = 0; dt < 4; ++dt) { u32x4 vv; vv.x = vlo[dt].x; vv.y = vlo[dt].y; vv.z = vhi[dt].x; vv.w = vhi[dt].y;
                            o[dt] = __builtin_amdgcn_mfma_f32_16x16x32_bf16(__builtin_bit_cast(bf16x8, vv), pf, o[dt], 0, 0, 0); }
#pragma unroll
                        for (int dt = 0; dt < 4; ++dt) { vlo[dt] = nlo[dt]; vhi[dt] = nhi[dt]; }
                        __builtin_amdgcn_sched_barrier(0);
                    }
                }
                if (qok) {
#pragma unroll
                    for (int dt = 0; dt < 4; ++dt) { u32x2 w; w.x = cvt_pk_bf16(o[dt][0] * inv, o[dt][1] * inv); w.y = cvt_pk_bf16(o[dt][2] * inv, o[dt][3] * inv);
                        gstore((u32x2*)(ap + (size_t)(rb + lq) * D + h * 64 + 16 * dt + 4 * fq), w); }
                }
            }
        }
    }
    constexpr int PER_G = (T / 4) * 16;
    for (int it = blockIdx.x * 512 + tid; it < 4 * PER_G; it += gridDim.x * 512) {
        const int g = it / PER_G, rem = it - g * PER_G, r = (rem >> 4) * 4, ch = g * 16 + (rem & 15);
        if (g == 0) pool_item<1>(z, ap, r, ch); else if (g == 1) pool_item<2>(z, ap, r, ch); else if (g == 2) pool_item<4>(z, ap, r, ch); else pool_item<8>(z, ap, r, ch);
    }
}

__device__ __forceinline__ void normT_phase(const PW& p, LAS unsigned char* lds) {
    const int tid = otid(), lane = tid & 63, wave = __builtin_amdgcn_readfirstlane(tid >> 6);
    const float* gain = (const float*)(p.ws + OFF_SMALL) + 1024; bf16_t* HNT = (bf16_t*)(p.ws + OFF_HNT);
    LAS bf16_t* Tt = (LAS bf16_t*)lds;
    constexpr int NUA = NBA * (LPA / 64), NU = NUA + NBB * (LPB / 64);
    for (int unit = blockIdx.x; unit < NU; unit += gridDim.x) {
        int sb, ti, L, LP, rb; bf16_t* dst;
        if (unit < NUA) { sb = unit / (LPA / 64); ti = unit - sb * (LPA / 64); L = LA; LP = LPA; rb = sb * LA; dst = HNT + (size_t)sb * D * LPA; }
        else { const int uu = unit - NUA; sb = uu / (LPB / 64); ti = uu - sb * (LPB / 64); L = LB; LP = LPB; rb = TA + sb * LB; dst = HNT + HNT_B + (size_t)sb * D * LPB; }
        const int l0 = ti * 64;
        __syncthreads();
        {
            unsigned raw[8][8]; float rs[8];
#pragma unroll
            for (int rr = 0; rr < 8; ++rr) { const int l = l0 + wave * 8 + rr; const bool ok = l < L;
                const unsigned* hp = (const unsigned*)((const bf16_t*)(p.ws + OFF_HB) + (size_t)(rb + min(l, L - 1)) * D);
#pragma unroll
                for (int i = 0; i < 8; ++i) { unsigned t = gload(hp + lane + 64 * i); raw[rr][i] = ok ? t : 0u; } }
#pragma unroll
            for (int rr = 0; rr < 8; ++rr) { float ss = 0.f;
#pragma unroll
                for (int i = 0; i < 8; ++i) { const float a = bflo(raw[rr][i]), b = bfhi(raw[rr][i]); ss += a * a + b * b; }
                ss = wave_sum(ss); rs[rr] = __builtin_amdgcn_rsqf(ss * (1.0f / 1024.0f) + 1e-6f); }
            LAS unsigned* TtW = (LAS unsigned*)lds;
#pragma unroll
            for (int i = 0; i < 8; ++i) { const float g0 = gain[2 * lane + 128 * i], g1 = gain[2 * lane + 128 * i + 1]; const int c0 = 2 * lane + 128 * i;
#pragma unroll
                for (int q = 0; q < 4; ++q) {
                    TtW[c0 * 33 + wave * 4 + q] = cvt_pk_bf16(bflo(raw[2 * q][i]) * rs[2 * q] * g0, bflo(raw[2 * q + 1][i]) * rs[2 * q + 1] * g0);
                    TtW[(c0 + 1) * 33 + wave * 4 + q] = cvt_pk_bf16(bfhi(raw[2 * q][i]) * rs[2 * q] * g1, bfhi(raw[2 * q + 1][i]) * rs[2 * q + 1] * g1); } }
        }
        __syncthreads();
#pragma unroll 8
        for (int i = 0; i < 64; ++i) { const int idx = tid + 512 * i; const int c = idx >> 5, pr = idx & 31;
            const unsigned v = *(const LAS unsigned*)(Tt + c * 66 + 2 * pr); gstore((unsigned*)(dst + (size_t)c * LP + l0 + 2 * pr), v); }
    }
}

__device__ __forceinline__ void final_phase(const PW& p) {
    const int tid = otid(); const int lane = tid & 63, gw = blockIdx.x * 8 + (tid >> 6), NGW = gridDim.x * 8; const float* gf = (const float*)(p.ws + OFF_SMALL) + 2048;
    const bf16_t* hb = (const bf16_t*)(p.ws + OFF_HB); const float* rss = (const float*)(p.ws + OFF_RSS);
    f32x4 gv[4];
#pragma unroll
    for (int i = 0; i < 4; ++i) gv[i] = *(const f32x4*)(gf + lane * 8 + 512 * (i >> 1) + 4 * (i & 1));
    for (int row = gw; row < 98304; row += NGW) {
        int r; if (row < NBA * 4096) { const int gb = row >> 12; r = row + 16 * (gb + 1); } else { const int o2 = row - NBA * 4096, b = o2 >> 11; r = TA + b * LB + 16 + (o2 - (b << 11)); }
        const f32x4 q4 = gload((const f32x4*)(rss + (size_t)r * 4)); const float rs = rstd_of((q4[0] + q4[1]) + (q4[2] + q4[3]));
        const bf16_t* hp = hb + (size_t)r * D; float* op = p.out + (size_t)row * D;
        const u32x4 w0 = gload((const u32x4*)(hp + lane * 8)), w1 = gload((const u32x4*)(hp + 512 + lane * 8));
        f32x4 a, b2, c2, d2;
        a[0] = bflo(w0.x); a[1] = bfhi(w0.x); a[2] = bflo(w0.y); a[3] = bfhi(w0.y); b2[0] = bflo(w0.z); b2[1] = bfhi(w0.z); b2[2] = bflo(w0.w); b2[3] = bfhi(w0.w);
        c2[0] = bflo(w1.x); c2[1] = bfhi(w1.x); c2[2] = bflo(w1.y); c2[3] = bfhi(w1.y); d2[0] = bflo(w1.z); d2[1] = bfhi(w1.z); d2[2] = bflo(w1.w); d2[3] = bfhi(w1.w);
        gstore((f32x4*)(op + lane * 8), a * rs * gv[0]); gstore((f32x4*)(op + lane * 8 + 4), b2 * rs * gv[1]);
        gstore((f32x4*)(op + 512 + lane * 8), c2 * rs * gv[2]); gstore((f32x4*)(op + 512 + lane * 8 + 4), d2 * rs * gv[3]);
    }
}

enum { K_PREP = 0, K_GGU, K_DOWN, K_GZ, K_ATTN, K_APO, K_NORMT, K_DFT, K_FO, K_FINAL };
#ifndef REP_PREP
#define REP_PREP 1
#endif
__global__ void __launch_bounds__(512, 2) mega_fwd(Params p0) {
    extern __shared__ __attribute__((aligned(16))) unsigned char shm[];
    LAS unsigned char* lds = (LAS unsigned char*)shm;
    cg::grid_group grid = cg::this_grid();
    volatile LAS unsigned* xst = (volatile LAS unsigned*)(lds + (LDS_BYTES - 16));
    if (threadIdx.x == 0) { xst[0] = 0u; xst[1] = 0u; }
    __syncthreads();
    XcdBarrier xb = xcd_barrier_post((unsigned*)(p0.ws + OFF_BAR), xst);
    const int nrep = REP_PREP + (p0.out == nullptr ? 1 : 0);
#pragma unroll 1
    for (int rep = 0; rep < nrep; ++rep) { prep_phase(p0, lds); grid.sync(); }
#ifdef PROBE_SLEEP_TICKS
    { const unsigned long long t0 = __builtin_amdgcn_s_memrealtime(); while (__builtin_amdgcn_s_memrealtime() - t0 < (unsigned long long)PROBE_SLEEP_TICKS) __builtin_amdgcn_s_sleep(32); }
#endif
    PW p; p.ws = p0.ws; p.out = p0.out;
    { unsigned long long w = (unsigned long long)p.ws, o = (unsigned long long)p.out; asm volatile("" : "+s"(w), "+s"(o)); p.ws = (unsigned char*)w; p.out = (float*)o; }
#pragma unroll 1
    for (int ph = 1; ph < 16; ++ph) {
        int kind, f = 0, rbuf = 0;
        switch (ph) {
            case 0: kind = K_PREP; break;
            case 1: kind = K_GGU; f = 0; rbuf = 0; break;
            case 2: kind = K_DOWN; f = 0; rbuf = 1; break;
            case 3: kind = K_GZ; rbuf = 1; break;
            case 4: kind = K_ATTN; break;
            case 5: kind = K_APO; rbuf = 0; break;
            case 6: kind = K_GGU; f = 1; rbuf = 0; break;
            case 7: kind = K_DOWN; f = 1; rbuf = 1; break;
            case 8: kind = K_GGU; f = 2; rbuf = 1; break;
            case 9: kind = K_DOWN; f = 2; rbuf = 0; break;
            case 10: kind = K_NORMT; break;
            case 11: kind = K_DFT; break;
            case 12: kind = K_FO; rbuf = 1; break;
            case 13: kind = K_GGU; f = 3; rbuf = 1; break;
            case 14: kind = K_DOWN; f = 3; rbuf = 0; break;
            default: kind = K_FINAL; break;
        }
        const int c = (int)blockIdx.x;
        if (kind == K_PREP) {
        } else if (kind == K_GGU) {
#ifndef NO_GGU
            EpiGateUp E; E.act = (bf16_t*)(p.ws + OFF_ACT); E.rss = (const float*)(p.ws + OFF_RSS);
#ifndef REP_GGU
#define REP_GGU 1
#endif
#pragma unroll 1
            for (int rep = 0; rep < REP_GGU; ++rep) {
            run_gemm(lds, (const bf16_t*)(p.ws + OFF_HB), (const bf16_t*)(p.ws + OFF_WGU) + (size_t)f * NGU * D, TPAD, NGU, D, E, c);
            if (rep + 1 < REP_GGU) grid.sync(); }
#ifdef PROBE_KLOOP
            xcd_barrier(xb); { EpiNone EN; pg8::Gemm g; g.A = (const bf16_t*)(p.ws + OFF_HB); g.Bt = (const bf16_t*)(p.ws + OFF_WGU) + (size_t)f * NGU * D; g.M = TPAD; g.N = NGU; g.K = D; g.ld = D;
#if PROBE_KLOOP == 2
              LocalOrder S;
#else
              pg8::StaticOrder S;
#endif
              S.init(TPAD, NGU, (int)gridDim.x, c); pg8::gemm_phase<EpiNone, decltype(S), false>(lds, g, S, EN, nullptr); }
#endif
#endif
        } else if (kind == K_DOWN || kind == K_APO || kind == K_FO) {
#ifndef NO_GRES
            const bf16_t* A; const bf16_t* Bt; int K; float scale;
            if (kind == K_DOWN) { A = (const bf16_t*)(p.ws + OFF_ACT); Bt = (const bf16_t*)(p.ws + OFF_WD) + (size_t)f * D * DFF; K = DFF; scale = 0.5f; }
            else if (kind == K_APO) { A = (const bf16_t*)(p.ws + OFF_AP); Bt = (const bf16_t*)(p.ws + OFF_WO); K = D; scale = 1.0f; }
            else { A = (const bf16_t*)(p.ws + OFF_X); Bt = (const bf16_t*)(p.ws + OFF_W2T); K = 2048; scale = 1.0f; }
            { EpiResid<false> E; E.out = p.out; E.ws = p.ws; E.half = (kind == K_DOWN); E.rss4 = (float*)(p.ws + OFF_RSS); E.part = (LAS float*)(lds + 131072);
              pg8::Gemm g; g.A = A; g.Bt = Bt; g.M = TPAD; g.N = D; g.K = K; g.ld = K;
              const bool split = (int)gridDim.x == 256 && K >= 2048;
              CapOrder S; S.init2(TPAD, D, (int)gridDim.x, c, split ? TAIL_L0 : (TPAD / 256) * 4);
              pg8::gemm_phase<EpiResid<false>, CapOrder, false>(lds, g, S, E, nullptr);
              if (split) {
                  const int nsl = K / 256;
                  if (c < TAIL_UNITS * nsl) { const int tu = c / nsl, sl = c - tu * nsl;
                      EpiPartial EP; EP.P = (float*)(p.ws + OFF_PART) + (size_t)(tu * 16 + sl) * 65536;
                      pg8::Gemm g2; g2.A = A + sl * 256; g2.Bt = Bt + sl * 256; g2.M = TPAD; g2.N = D; g2.K = K / nsl; g2.ld = K;
                      TailOrder S2; S2.init2(TPAD, D, tu);
                      pg8::gemm_phase<EpiPartial, TailOrder, false>(lds, g2, S2, EP, nullptr); }
                  xcd_barrier(xb);
                  tail_fixup(p.ws, nsl, kind == K_DOWN);
              } }
#endif
        } else if (kind == K_GZ) {
#ifndef NO_GZ
            EpiScale E; E.O = (bf16_t*)(p.ws + OFF_Z); E.ldc = INDIM; E.rss = (const float*)(p.ws + OFF_RSS);
            run_gemm(lds, (const bf16_t*)(p.ws + OFF_HB), (const bf16_t*)(p.ws + OFF_WIN), TPAD, INDIM, D, E, c);
#endif
        } else if (kind == K_ATTN) {
#ifndef REP_ATTN
#define REP_ATTN 1
#endif
            for (int rep = 0; rep < REP_ATTN; ++rep) { attn_phase(p, lds); if (rep + 1 < REP_ATTN) grid.sync(); }
        } else if (kind == K_NORMT) {
#ifndef REP_NORMT
#define REP_NORMT 1
#endif
            for (int rep = 0; rep < REP_NORMT; ++rep) { normT_phase(p, lds); if (rep + 1 < REP_NORMT) grid.sync(); }
        } else if (kind == K_DFT) {
#ifndef NO_GDFT
#ifndef REP_DFT
#define REP_DFT 1
#endif
#pragma unroll 1
            for (int grp = 0; grp < 2; ++grp) {
                EpiDft E; E.X = (bf16_t*)(p.ws + OFF_X); E.L = grp ? LB : LA; E.rowbase = grp ? TA : 0;
                pg8::Gemm g; g.A = (const bf16_t*)(p.ws + (grp ? OFF_D2 : OFF_D1)); g.Bt = (const bf16_t*)(p.ws + OFF_HNT) + (grp ? HNT_B : 0); g.M = grp ? MPB : MPA; g.N = (grp ? NBB : NBA) * D; g.K = grp ? LPB : LPA; g.ld = g.K;
                const bool bal = grp && (int)gridDim.x == 256;
                DftOrder S; S.init2(g.M, g.N, (int)gridDim.x, (grp && !bal) ? (int)gridDim.x - 1 - c : c, bal ? 1 : 0);
                pg8::gemm_phase<EpiDft, DftOrder, false>(lds, g, S, E, nullptr);
            }
#endif
        } else {
#ifndef NO_FINAL
            final_phase(p);
#endif
        }
#ifdef USE_CG_SYNC
        if (ph != 15) grid.sync();
#else
        if (ph != 15) xcd_barrier(xb);
#endif
    }
}

extern "C" void kernel_launch(void* const* d_in, const int* in_sizes, int n_in, void* d_out, int out_size, void* d_ws, size_t ws_size, hipStream_t stream) {
    static int grid = 0;
    if (grid == 0) {
        if (n_in != 19 || ws_size < WS_NEED) { fprintf(stderr, "kernel_launch: need 19 inputs and %zu bytes of workspace (got %d, %zu)\n", (size_t)WS_NEED, n_in, ws_size); grid = -1; return; }
        int dev = 0, cus = 0, per_cu = 0;
        hipGetDevice(&dev); hipDeviceGetAttribute(&cus, hipDeviceAttributeMultiprocessorCount, dev);
        if (hipFuncSetAttribute((const void*)mega_fwd, hipFuncAttributeMaxDynamicSharedMemorySize, LDS_BYTES) != hipSuccess) { fprintf(stderr, "kernel_launch: hipFuncSetAttribute failed\n"); grid = -1; return; }
        if (hipOccupancyMaxActiveBlocksPerMultiprocessor(&per_cu, (const void*)mega_fwd, 512, LDS_BYTES) != hipSuccess || per_cu < 1) { fprintf(stderr, "kernel_launch: occupancy query gave %d\n", per_cu); per_cu = 1; (void)hipGetLastError(); }
        grid = cus * 1;
    }
    if (grid < 0) return;
    Params p{};
    for (int i = 0; i < 19; ++i) p.in[i] = (const float*)d_in[i];
    p.out = (float*)d_out; p.ws = (unsigned char*)d_ws;
    if (hipMemsetAsync((unsigned char*)d_ws + OFF_BAR, 0, (size_t)XCD_BAR_WORDS * 4, stream) != hipSuccess) { fprintf(stderr, "kernel_launch: memset of barrier words failed\n"); return; }
    void* args[] = {&p};
    hipError_t e = hipLaunchCooperativeKernel((const void*)mega_fwd, dim3(grid), dim3(512), args, LDS_BYTES, stream);
    if (e != hipSuccess) fprintf(stderr, "cooperative launch failed: %s (grid %d)\n", hipGetErrorString(e), grid);
}
```
